# Optimizing an MI355X kernel written in HIP

```python
import jax, jax.numpy as jnp
from jax import lax
import numpy as np

D_MODEL = 1024
BATCH = 2
SEQ = 8192
DEPTH = 1

DN_HEADS = 4
DN_HEAD_DIM = 128
DN_WIDTH = DN_HEADS * DN_HEAD_DIM
CONV_WIDTH = 5
CHUNK = 64
ATTN_Q_HEADS = 8
ATTN_KV_HEADS = 2
ATTN_HEAD_DIM = 64
ATTN_GROUP = ATTN_Q_HEADS // ATTN_KV_HEADS
ATTN_WIDTH = ATTN_Q_HEADS * ATTN_HEAD_DIM
WINDOW = 128
ATTN_BLOCK = 128
ROT_DIM = ATTN_HEAD_DIM // 4
ROPE_THETA = 500000.0
MIX_WIDTH = DN_WIDTH + ATTN_WIDTH
IN_SPLITS = [DN_WIDTH, DN_WIDTH, DN_WIDTH, DN_WIDTH, 2 * DN_HEADS, 2 * DN_HEADS,
             ATTN_WIDTH, ATTN_KV_HEADS * ATTN_HEAD_DIM, ATTN_KV_HEADS * ATTN_HEAD_DIM]
IN_WIDTH = sum(IN_SPLITS)
IN_OFFSETS = [int(o) for o in np.cumsum(IN_SPLITS)[:-1]]
N_GROUPS = 8
EXPERTS_PER_GROUP = 8
N_EXPERTS = N_GROUPS * EXPERTS_PER_GROUP
TOP_K = 2
EXPERT_FF = 256
EPS = 1e-6

kernel_name = "hybrid_deltanet_swa_hiermoe_encoder"


def rmsnorm(x, w):
    x32 = x.astype(jnp.float32)
    y = x32 * lax.rsqrt(jnp.mean(x32 * x32, axis=-1, keepdims=True) + EPS)
    return (y * w.astype(jnp.float32)).astype(x.dtype)


def l2norm(x):
    return x * lax.rsqrt(jnp.sum(x * x, axis=-1, keepdims=True) + EPS)


def centred_depthwise_conv(x, w):
    k, c = w.shape
    return lax.conv_general_dilated(
        x, w[:, None, :].astype(x.dtype), window_strides=(1,),
        padding=[(k // 2, k // 2)], dimension_numbers=('NWC', 'WIO', 'NWC'),
        feature_group_count=c)


def gated_delta_chunked(q, k, v, g, beta):
    b, s, h, dk = q.shape
    dv = v.shape[-1]
    n = s // CHUNK

    def chunks(t):
        return jnp.moveaxis(t.reshape((b, n, CHUNK) + t.shape[2:]), 2, 3)

    qc, kc, vc = chunks(q), chunks(k), chunks(v)
    gc = jnp.cumsum(chunks(g), axis=-1)
    bc = chunks(beta)
    kb = kc * bc[..., None]
    vb = vc * bc[..., None]
    tri = jnp.tril(jnp.ones((CHUNK, CHUNK), bool))
    strict = jnp.tril(jnp.ones((CHUNK, CHUNK), bool), -1)
    diff = gc[..., :, None] - gc[..., None, :]
    decay = jnp.where(tri, jnp.exp(jnp.where(tri, diff, 0.0)), 0.0)
    a_mat = jnp.where(strict, jnp.einsum('bnhid,bnhjd->bnhij', kb, kc) * decay, 0.0)
    eye = jnp.eye(CHUNK, dtype=jnp.float32)
    t_mat = lax.linalg.triangular_solve(eye + a_mat, jnp.broadcast_to(eye, a_mat.shape),
                                        left_side=True, lower=True)
    u = jnp.einsum('bnhij,bnhje->bnhie', t_mat, vb)
    w = jnp.einsum('bnhij,bnhjd->bnhid', t_mat, kb * jnp.exp(gc)[..., None])
    attn_intra = jnp.where(tri, jnp.einsum('bnhid,bnhjd->bnhij', qc, kc) * decay, 0.0)
    q_dec = qc * jnp.exp(gc)[..., None]
    k_dec = kc * jnp.exp(gc[..., -1:] - gc)[..., None]
    chunk_decay = jnp.exp(gc[..., -1])

    def step(state, inp):
        u_n, w_n, q_n, k_n, a_n, d_n = inp
        v_new = u_n - jnp.einsum('bhcd,bhde->bhce', w_n, state)
        o = jnp.einsum('bhcd,bhde->bhce', q_n, state) + jnp.einsum('bhij,bhje->bhie', a_n, v_new)
        state = state * d_n[..., None, None] + jnp.einsum('bhcd,bhce->bhde', k_n, v_new)
        return state, o

    xs = tuple(jnp.moveaxis(t, 1, 0) for t in (u, w, q_dec, k_dec, attn_intra, chunk_decay))
    state0 = jnp.zeros((b, h, dk, dv), jnp.float32)
    _, o = lax.scan(step, state0, xs)
    o = jnp.swapaxes(jnp.moveaxis(o, 0, 1), 2, 3)
    return o.reshape(b, s, h, dv)


def deltanet_mixer(q, k, v, z, beta_in, a_in, conv_w, a_log, dt_bias, norm_w):
    bsz, s, _ = q.shape
    qkv = jax.nn.silu(centred_depthwise_conv(jnp.concatenate([q, k, v], axis=-1), conv_w))
    qkv = qkv.astype(jnp.float32)
    q, k, v = jnp.split(qkv, 3, axis=-1)
    q = l2norm(q.reshape(bsz, s, DN_HEADS, DN_HEAD_DIM)) * (DN_HEAD_DIM ** -0.5)
    k = l2norm(k.reshape(bsz, s, DN_HEADS, DN_HEAD_DIM))
    v = v.reshape(bsz, s, DN_HEADS, DN_HEAD_DIM)
    beta = jax.nn.sigmoid(beta_in.astype(jnp.float32)).reshape(bsz, s, 2, DN_HEADS)
    a = a_in.astype(jnp.float32).reshape(bsz, s, 2, DN_HEADS)
    g = -jnp.exp(a_log.astype(jnp.float32)) * jax.nn.softplus(a + dt_bias.astype(jnp.float32))
    o_fwd = gated_delta_chunked(q, k, v, g[:, :, 0], beta[:, :, 0])
    flip = lambda t: jnp.flip(t, axis=1)
    o_bwd = flip(gated_delta_chunked(flip(q), flip(k), flip(v), flip(g[:, :, 1]), flip(beta[:, :, 1])))
    o = o_fwd + o_bwd
    o = o * lax.rsqrt(jnp.mean(o * o, axis=-1, keepdims=True) + EPS) * norm_w.astype(jnp.float32)
    o = o * jax.nn.silu(z.astype(jnp.float32).reshape(bsz, s, DN_HEADS, DN_HEAD_DIM))
    return o.reshape(bsz, s, DN_WIDTH).astype(q_dtype_of(z))


def q_dtype_of(t):
    return t.dtype


def partial_rotary(x):
    s = x.shape[1]
    pos = jnp.arange(s, dtype=jnp.float32)
    inv_freq = ROPE_THETA ** (-jnp.arange(0, ROT_DIM, 2, dtype=jnp.float32) / ROT_DIM)
    ang = pos[:, None] * inv_freq[None, :]
    cos = jnp.cos(ang)[None, :, None, :]
    sin = jnp.sin(ang)[None, :, None, :]
    x32 = x.astype(jnp.float32)
    half = ROT_DIM // 2
    x1, x2, rest = x32[..., :half], x32[..., half:ROT_DIM], x32[..., ROT_DIM:]
    out = jnp.concatenate([x1 * cos - x2 * sin, x2 * cos + x1 * sin, rest], axis=-1)
    return out.astype(x.dtype)


def window_gqa_sink(q, k, v, sink):
    bsz, s, _, d = q.shape
    nb = s // ATTN_BLOCK
    qb = q.reshape(bsz, nb, ATTN_BLOCK, ATTN_KV_HEADS, ATTN_GROUP, d)

    def band(t):
        tp = jnp.pad(t, ((0, 0), (ATTN_BLOCK, ATTN_BLOCK), (0, 0), (0, 0)))
        tr = tp.reshape(bsz, nb + 2, ATTN_BLOCK, ATTN_KV_HEADS, d)
        return jnp.concatenate([tr[:, :-2], tr[:, 1:-1], tr[:, 2:]], axis=2)

    kb, vb = band(k), band(v)
    scores = jnp.einsum('bnqkgd,bnjkd->bnkgqj', qb, kb).astype(jnp.float32) * (d ** -0.5)
    blk = jnp.arange(nb)[:, None]
    qpos = blk * ATTN_BLOCK + jnp.arange(ATTN_BLOCK)[None, :]
    kpos = (blk - 1) * ATTN_BLOCK + jnp.arange(3 * ATTN_BLOCK)[None, :]
    mask = ((jnp.abs(qpos[:, :, None] - kpos[:, None, :]) <= WINDOW)
            & (kpos[:, None, :] >= 0) & (kpos[:, None, :] < s))
    scores = jnp.where(mask[None, :, None, None], scores, -jnp.inf)
    sk = sink.astype(jnp.float32).reshape(ATTN_KV_HEADS, ATTN_GROUP)[None, None, :, :, None, None]
    m = jnp.maximum(jnp.max(scores, axis=-1, keepdims=True), sk)
    p = jnp.exp(scores - m)
    probs = p / (jnp.sum(p, axis=-1, keepdims=True) + jnp.exp(sk - m))
    o = jnp.einsum('bnkgqj,bnjkd->bnqkgd', probs.astype(v.dtype), vb)
    return o.reshape(bsz, s, ATTN_Q_HEADS * d)


def hierarchical_moe(h, w_group, b_group, w_expert, b_expert, w_gate_up, w_down):
    bsz, s, d = h.shape
    t = bsz * s
    ht = h.reshape(t, d)
    glog = (ht @ w_group).astype(jnp.float32) + b_group.astype(jnp.float32)
    p_g, g_idx = lax.top_k(jax.nn.softmax(glog, axis=-1), 1)
    elog = ((ht @ w_expert).astype(jnp.float32) + b_expert.astype(jnp.float32))
    elog = elog.reshape(t, N_GROUPS, EXPERTS_PER_GROUP)[jnp.arange(t), g_idx[:, 0]]
    p_e, e_local = lax.top_k(jax.nn.softmax(elog, axis=-1), TOP_K)
    p_e = p_e / jnp.sum(p_e, axis=-1, keepdims=True)
    gate = (p_g * p_e).reshape(-1)
    expert_ids = (g_idx * EXPERTS_PER_GROUP + e_local).reshape(-1)
    order = jnp.argsort(expert_ids)
    token_of = order // TOP_K
    sizes = jax.ops.segment_sum(jnp.ones_like(expert_ids), expert_ids,
                                num_segments=N_EXPERTS).astype(jnp.int32)
    xs = ht[token_of]
    gu = lax.ragged_dot(xs, w_gate_up, sizes)
    g_part, u_part = jnp.split(gu, 2, axis=-1)
    y = lax.ragged_dot(jax.nn.silu(g_part) * u_part, w_down, sizes)
    y = y.astype(jnp.float32) * gate[order][:, None]
    out = jax.ops.segment_sum(y, token_of, num_segments=t)
    return out.reshape(bsz, s, d).astype(h.dtype)


def hybrid_layer(x, ln_mix, w_in, dn_conv, dn_A_log, dn_dt_bias, dn_norm, attn_sink, w_out,
                 ln_ffn, w_group, b_group, w_expert, b_expert, w_gate_up, w_down):
    bsz, s, _ = x.shape
    h = rmsnorm(x, ln_mix)
    proj = h @ w_in
    dq, dk_, dv_, dz, dbeta, da, aq, ak, av = jnp.split(proj, IN_OFFSETS, axis=-1)
    out_a = deltanet_mixer(dq, dk_, dv_, dz, dbeta, da, dn_conv, dn_A_log, dn_dt_bias, dn_norm)
    aq = partial_rotary(aq.reshape(bsz, s, ATTN_Q_HEADS, ATTN_HEAD_DIM))
    ak = partial_rotary(ak.reshape(bsz, s, ATTN_KV_HEADS, ATTN_HEAD_DIM))
    av = av.reshape(bsz, s, ATTN_KV_HEADS, ATTN_HEAD_DIM)
    out_b = window_gqa_sink(aq, ak, av, attn_sink)
    x = x + jnp.concatenate([out_a.astype(x.dtype), out_b.astype(x.dtype)], axis=-1) @ w_out
    x = x + hierarchical_moe(rmsnorm(x, ln_ffn), w_group, b_group, w_expert, b_expert, w_gate_up, w_down)
    return x


def setup_inputs(seed: int = 0) -> dict:
    key = jax.random.key(seed)
    ks = jax.random.split(key, 20)
    f32 = jnp.float32
    nrm = lambda k, shape, scale: jax.random.normal(k, shape, f32) * scale
    dt = jnp.exp(jax.random.uniform(ks[5], (DEPTH, 2, DN_HEADS), f32, np.log(1e-3), np.log(1e-1)))
    return {
        'x': nrm(ks[0], (BATCH, SEQ, D_MODEL), 1.0),
        'ln_mix': 1.0 + nrm(ks[1], (DEPTH, D_MODEL), 0.02),
        'w_in': nrm(ks[2], (DEPTH, D_MODEL, IN_WIDTH), D_MODEL ** -0.5),
        'dn_conv': nrm(ks[3], (DEPTH, CONV_WIDTH, 3 * DN_WIDTH), CONV_WIDTH ** -0.5),
        'dn_A_log': jnp.log(jax.random.uniform(ks[4], (DEPTH, 2, DN_HEADS), f32, 1.0, 16.0)),
        'dn_dt_bias': dt + jnp.log(-jnp.expm1(-dt)),
        'dn_norm': 1.0 + nrm(ks[6], (DEPTH, DN_HEAD_DIM), 0.02),
        'attn_sink': nrm(ks[7], (DEPTH, ATTN_Q_HEADS), 0.5),
        'w_out': nrm(ks[8], (DEPTH, MIX_WIDTH, D_MODEL), MIX_WIDTH ** -0.5),
        'ln_ffn': 1.0 + nrm(ks[9], (DEPTH, D_MODEL), 0.02),
        'w_group': nrm(ks[10], (DEPTH, D_MODEL, N_GROUPS), D_MODEL ** -0.5),
        'b_group': nrm(ks[11], (DEPTH, N_GROUPS), 0.01),
        'w_expert': nrm(ks[12], (DEPTH, D_MODEL, N_EXPERTS), D_MODEL ** -0.5),
        'b_expert': nrm(ks[13], (DEPTH, N_EXPERTS), 0.01),
        'w_gate_up': nrm(ks[14], (DEPTH, N_EXPERTS, D_MODEL, 2 * EXPERT_FF), D_MODEL ** -0.5),
        'w_down': nrm(ks[15], (DEPTH, N_EXPERTS, EXPERT_FF, D_MODEL), EXPERT_FF ** -0.5),
        'ln_final': 1.0 + nrm(ks[16], (D_MODEL,), 0.02),
    }


def reference(x, ln_mix, w_in, dn_conv, dn_A_log, dn_dt_bias, dn_norm, attn_sink, w_out,
              ln_ffn, w_group, b_group, w_expert, b_expert, w_gate_up, w_down, ln_final):
    for l in range(DEPTH):
        x = hybrid_layer(x, ln_mix[l], w_in[l], dn_conv[l], dn_A_log[l], dn_dt_bias[l], dn_norm[l],
                         attn_sink[l], w_out[l], ln_ffn[l], w_group[l], b_group[l], w_expert[l],
                         b_expert[l], w_gate_up[l], w_down[l])
    return rmsnorm(x, ln_final)
```

```cpp
#include <hip/hip_runtime.h>
#include <cstdint>
#include <cstdio>
namespace pg8 {
#define PG8_LAS __attribute__((address_space(3)))
typedef unsigned short bf16_t;
typedef short bf16x8 __attribute__((ext_vector_type(8)));
typedef float f32x4 __attribute__((ext_vector_type(4)));
typedef unsigned u32x4 __attribute__((ext_vector_type(4)));
constexpr int BM = 256, BK = 64, HALF = 128, HTB = HALF * BK * 2  , STAGE_BYTES = 8 * HTB, NXCD = 8, WGM = 8;

__host__ __device__ __forceinline__ int lds_byte(int r, int c) { const int st = (r >> 4) * 2 + (c >> 5), rr = r & 15, cc = c & 31, ob = rr * 64 + cc * 2; return st * 1024 + (ob ^ (((ob >> 9) & 1) << 5)); }
__host__ __device__ __forceinline__ void stage_rc(int b, int& R, int& C) { const int st = b / 1024, sb = b % 1024, swz = sb ^ (((sb >> 9) & 1) << 5); R = (st >> 1) * 16 + swz / 64; C = (st & 1) * 32 + (swz % 64) / 2; }
__host__ __device__ __forceinline__ int perm32(int rho) { const int n = rho >> 4, i = rho & 15; return 8 * (i >> 2) + 4 * n + (i & 3); }

struct Unit { int pm, pn; };
struct Gemm { const bf16_t* A; const bf16_t* Bt; int M, N, K; };

struct StaticOrder {
    static constexpr bool GATHER = false;
    int nM, nN, nwg, G, c;
    __device__ __forceinline__ unsigned row_off(const Unit&, int) const { return 0u; }
    __host__ __device__ void init(int M, int N, int G_, int c_) { nM = M / BM; nN = N / BM; nwg = nM * nN; G = G_; c = c_; }
    __host__ __device__ bool next(int i, Unit& u) const {
        const long L = (long)i * G + c; if (L >= nwg) return false;
        int wgid = (int)L; { const int q = nwg / NXCD, r = nwg % NXCD, xcd = wgid % NXCD, off = wgid / NXCD; wgid = (xcd < r ? xcd * (q + 1) : r * (q + 1) + (xcd - r) * q) + off; }
        const int nig = WGM * nN, gid = wgid / nig, fm = gid * WGM, gsz = (nM - fm) < WGM ? (nM - fm) : WGM;
        u.pm = fm + ((wgid % nig) % gsz); u.pn = (wgid % nig) / gsz; return true;
    }
    __device__ __forceinline__ void a_ready(const Unit&) const {}
    __device__ __forceinline__ void done(const Unit&) const {}
};

__device__ __forceinline__ unsigned cvt_pk_bf16(float lo, float hi) { unsigned r; asm volatile("v_cvt_pk_bf16_f32 %0, %1, %2" : "=v"(r) : "v"(lo), "v"(hi)); return r; }
typedef float f32x2 __attribute__((ext_vector_type(2)));
__device__ __forceinline__ f32x2 gelu_pk(f32x2 v) {
    const f32x2 av = __builtin_elementwise_abs(v), d = av * 0.2316418882f + 1.0f;
    f32x2 t; t.x = __builtin_amdgcn_rcpf(d.x); t.y = __builtin_amdgcn_rcpf(d.y);
    f32x2 q = t * 0.5307027145f + (-0.7265760135f); q = q * t + 0.7107068705f; q = q * t + (-0.142248368f); q = q * t + 0.127414796f; q = q * t;
    const f32x2 s = (v * v) * (-0.72134752044f);
    f32x2 e; e.x = __builtin_amdgcn_exp2f(s.x); e.y = __builtin_amdgcn_exp2f(s.y);
    const f32x2 m = v * (q * e), r = v - m;
    f32x2 o; o.x = v.x < 0.f ? m.x : r.x; o.y = v.y < 0.f ? m.y : r.y; return o;
}

template <int ACT  > struct EpiBf16 {
    static constexpr bool PERM = true, AFTER_DRAIN = false; static_assert(ACT == 0 || ACT == 1, "EpiBf16: ACT is 0 (none) or 1 (gelu_pk)");
    bf16_t* O; int ldc; const float* bias; int split_cols; size_t split_stride; float scale0;
    __device__ __forceinline__ void operator()(const f32x4 (&acc)[2][2][4][2], const Unit& u, int wr, int wc, int fr, int fq) const {
        const int row0 = u.pm * BM + wr * 64 + fr; int colt = u.pn * BM; bf16_t* base = O;
        float sc = 1.f; if (split_cols) { const int t = colt / split_cols; base += (size_t)t * split_stride; colt -= t * split_cols; if (t == 0) sc = scale0; }
        const int col0 = colt + wc * 32 + 8 * fq, bcol0 = u.pn * BM + wc * 32 + 8 * fq;
        f32x4 bv[2][2];
#pragma unroll
        for (int bj = 0; bj < 2; ++bj)
#pragma unroll
            for (int n = 0; n < 2; ++n) bv[bj][n] = bias ? *(const f32x4*)(bias + bcol0 + bj * HALF + 4 * n) : (f32x4){0.f, 0.f, 0.f, 0.f};
#pragma unroll
        for (int ai = 0; ai < 2; ++ai)
#pragma unroll
            for (int m = 0; m < 4; ++m) { bf16_t* rowp = base + (size_t)(row0 + ai * HALF + m * 16) * ldc + col0;
#pragma unroll
                for (int bj = 0; bj < 2; ++bj) { f32x4 v0 = acc[ai][bj][m][0] + bv[bj][0], v1 = acc[ai][bj][m][1] + bv[bj][1];
                    if (ACT == 1) { f32x2 a = gelu_pk((f32x2){v0[0], v0[1]}), b = gelu_pk((f32x2){v0[2], v0[3]}), c = gelu_pk((f32x2){v1[0], v1[1]}), d = gelu_pk((f32x2){v1[2], v1[3]});
                        v0 = (f32x4){a.x, a.y, b.x, b.y}; v1 = (f32x4){c.x, c.y, d.x, d.y}; }
                    v0 = v0 * sc; v1 = v1 * sc; u32x4 w; w.x = cvt_pk_bf16(v0[0], v0[1]); w.y = cvt_pk_bf16(v0[2], v0[3]); w.z = cvt_pk_bf16(v1[0], v1[1]); w.w = cvt_pk_bf16(v1[2], v1[3]);
                    *(u32x4*)(rowp + bj * HALF) = w; } }
    }
};
template <class Epi, class Sched, bool ALIGN_EPI = false, bool SP2 = false>
__device__ __forceinline__ void gemm_phase(PG8_LAS unsigned char* lds, const Gemm g, const Sched& S, const Epi& E) {
    const int tid = threadIdx.x, wid = __builtin_amdgcn_readfirstlane(tid >> 6), lane = tid & 63, wr = wid >> 2, wc = wid & 3, fr = lane & 15, fq = lane >> 4;
    const int K = g.K, nt = K / BK;
    unsigned voffA[2], voffB[2];
    constexpr bool GATHER = Sched::GATHER;
    unsigned gA[2][2], nGA[2][2]; int rowA[2], colA[2];
#pragma unroll
    for (int i = 0; i < 2; ++i) { int R, C; stage_rc(tid * 16 + i * 8192, R, C); const int Rb = Epi::PERM ? ((R & ~31) + perm32(R & 31)) : R;
        voffA[i] = (unsigned)(R * K + C) * 2u; voffB[i] = (unsigned)(Rb * K + C) * 2u; rowA[i] = R; colA[i] = C; }
    const size_t kstep = (size_t)(BK * 2);
    const size_t hstep = (size_t)HALF * K * 2;
    const size_t tstep = 2 * hstep;
    const size_t hstepA = GATHER ? 0 : hstep, tstepA = GATHER ? 0 : tstep;
    const unsigned ldsw = (unsigned)wid * 1024u;
    const int aoff = lds_byte(wr * 64 + fr, fq * 8), boff = lds_byte(wc * 32 + fr, fq * 8);
#define PG8_SA(b, h) (((b) * 2 + (h)) * HTB)
#define PG8_SB(b, h) ((4 + (b) * 2 + (h)) * HTB)
#define PG8_STAGE(bufoff, gbase, voff) do { _Pragma("unroll") for (int _i = 0; _i < 2; ++_i) \
        __builtin_amdgcn_global_load_lds((const unsigned*)((const char*)(gbase) + (voff)[_i]), (PG8_LAS unsigned*)(lds + (bufoff) + ldsw + _i * 8192), 16, 0, 0); } while (0)
#define PG8_STAGE_A(bufoff, gbase, h, nx) do { if constexpr (GATHER) { if (nx) PG8_STAGE(bufoff, gbase, nGA[h]); else PG8_STAGE(bufoff, gbase, gA[h]); } else PG8_STAGE(bufoff, gbase, voffA); } while (0)
#define PG8_GOFF(dst, unit) do { if constexpr (GATHER) { _Pragma("unroll") for (int h_ = 0; h_ < 2; ++h_) _Pragma("unroll") for (int i_ = 0; i_ < 2; ++i_) dst[h_][i_] = S.row_off(unit, h_ * HALF + rowA[i_]) + (unsigned)colA[i_] * 2u; \
        asm volatile("s_waitcnt vmcnt(0)" : "+v"(dst[0][0]), "+v"(dst[0][1]), "+v"(dst[1][0]), "+v"(dst[1][1]) :: "memory"); } } while (0)
#define PG8_LDA(dst, b, h) do { _Pragma("unroll") for (int m = 0; m < 4; ++m) _Pragma("unroll") for (int k = 0; k < 2; ++k) dst[m][k] = *(const PG8_LAS bf16x8*)(lds + PG8_SA(b, h) + aoff + m * 2048 + k * 1024); } while (0)
#define PG8_LDB(dst, b, h) do { _Pragma("unroll") for (int n = 0; n < 2; ++n) _Pragma("unroll") for (int k = 0; k < 2; ++k) dst[n][k] = *(const PG8_LAS bf16x8*)(lds + PG8_SB(b, h) + boff + n * 2048 + k * 1024); } while (0)
#define PG8_MMA(ai, bj, At, Bt) do { __builtin_amdgcn_s_setprio(1); _Pragma("unroll") for (int m = 0; m < 4; ++m) _Pragma("unroll") for (int n = 0; n < 2; ++n) _Pragma("unroll") for (int k = 0; k < 2; ++k) \
        acc[ai][bj][m][n] = __builtin_amdgcn_mfma_f32_16x16x32_bf16(Bt[n][k], At[m][k], acc[ai][bj][m][n], 0, 0, 0); __builtin_amdgcn_s_setprio(0); } while (0)
#define PG8_WAIT_V(n) asm volatile("s_waitcnt vmcnt(" #n ")" ::: "memory")
#define PG8_WAIT_L(n) asm volatile("s_waitcnt lgkmcnt(" #n ")" ::: "memory")
#define PG8_BAR __builtin_amdgcn_s_barrier()
#define PG8_SCHED __builtin_amdgcn_sched_barrier(0)
    Unit cur, nxt; int ui = 0;
    if (!S.next(0, cur)) return;
    f32x4 acc[2][2][4][2];
#pragma unroll
    for (int a = 0; a < 2; ++a)
#pragma unroll
        for (int b = 0; b < 2; ++b)
#pragma unroll
            for (int m = 0; m < 4; ++m)
#pragma unroll
                for (int n = 0; n < 2; ++n) acc[a][b][m][n] = (f32x4){0.f, 0.f, 0.f, 0.f};
    bf16x8 At[4][2], B0[2][2], B1[2][2];
    const char* cA = (const char*)g.A + (size_t)cur.pm * tstepA; const char* cB = (const char*)g.Bt + (size_t)cur.pn * tstep;
    PG8_GOFF(gA, cur);
    S.a_ready(cur);
    if constexpr (SP2) {
        PG8_STAGE(PG8_SB(0, 0), cB, voffB); PG8_STAGE(PG8_SB(0, 1), cB + hstep, voffB); PG8_STAGE_A(PG8_SA(0, 0), cA, 0, false); PG8_STAGE_A(PG8_SA(0, 1), cA + hstepA, 1, false);
        if (wr == 1) PG8_BAR;
        PG8_WAIT_V(2); PG8_BAR;
        PG8_STAGE(PG8_SB(1, 0), cB + kstep, voffB); PG8_STAGE_A(PG8_SA(1, 0), cA + kstep, 0, false); PG8_STAGE(PG8_SB(1, 1), cB + hstep + kstep, voffB);
        PG8_WAIT_V(6); PG8_BAR;
    } else {
        PG8_STAGE(PG8_SB(0, 0), cB, voffB); PG8_STAGE_A(PG8_SA(0, 0), cA, 0, false); PG8_STAGE(PG8_SB(0, 1), cB + hstep, voffB); PG8_STAGE_A(PG8_SA(0, 1), cA + hstepA, 1, false);
        if (wr == 1) PG8_BAR;
        PG8_WAIT_V(4); PG8_BAR;
        PG8_STAGE(PG8_SB(1, 0), cB + kstep, voffB); PG8_STAGE_A(PG8_SA(1, 0), cA + kstep, 0, false); PG8_STAGE(PG8_SB(1, 1), cB + hstep + kstep, voffB);
        PG8_WAIT_V(6); PG8_BAR;
    }
    for (;;) {
        const bool has_next = S.next(ui + 1, nxt);
        if constexpr (GATHER) { if (has_next) PG8_GOFF(nGA, nxt); else { _Pragma("unroll") for (int h_ = 0; h_ < 2; ++h_) _Pragma("unroll") for (int i_ = 0; i_ < 2; ++i_) nGA[h_][i_] = gA[h_][i_]; } }
        const char* nA = has_next ? (const char*)g.A + (size_t)nxt.pm * tstepA : cA; const char* nB = has_next ? (const char*)g.Bt + (size_t)nxt.pn * tstep : cB;
        for (int t = 0; t < nt; t += 2) {
            const bool last = (t == nt - 2);
            const char* a1 = cA + (size_t)(t + 1) * kstep;
            const char* a2 = last ? nA : cA + (size_t)(t + 2) * kstep; const char* b2 = last ? nB : cB + (size_t)(t + 2) * kstep;
            const char* a3 = a2 + kstep; const char* b3 = b2 + kstep;
            if (last && has_next) S.a_ready(nxt);
            if constexpr (SP2) {
            PG8_LDB(B0, 0, 0); PG8_LDB(B1, 0, 1); PG8_SCHED; PG8_LDA(At, 0, 0); PG8_STAGE_A(PG8_SA(1, 1), a1 + hstepA, 1, false);
            PG8_WAIT_V(8); PG8_WAIT_L(0); PG8_BAR; PG8_MMA(0, 0, At, B0); PG8_MMA(0, 1, At, B1); PG8_BAR; PG8_SCHED;
            PG8_LDA(At, 0, 1); PG8_STAGE(PG8_SB(0, 0), b2, voffB); PG8_STAGE(PG8_SB(0, 1), b2 + hstep, voffB); PG8_STAGE_A(PG8_SA(0, 0), a2, 0, last);
            PG8_WAIT_V(8); PG8_WAIT_L(0); PG8_BAR; PG8_MMA(1, 0, At, B0); PG8_MMA(1, 1, At, B1); PG8_BAR; PG8_SCHED;
            PG8_LDB(B0, 1, 0); PG8_LDB(B1, 1, 1); PG8_SCHED; PG8_LDA(At, 1, 0); PG8_STAGE_A(PG8_SA(0, 1), a2 + hstepA, 1, last);
            PG8_WAIT_V(8); PG8_WAIT_L(0); PG8_BAR; PG8_MMA(0, 0, At, B0); PG8_MMA(0, 1, At, B1); PG8_BAR; PG8_SCHED;
            PG8_LDA(At, 1, 1); PG8_STAGE(PG8_SB(1, 0), b3, voffB); PG8_STAGE(PG8_SB(1, 1), b3 + hstep, voffB); PG8_STAGE_A(PG8_SA(1, 0), a3, 0, last);
            PG8_WAIT_V(8); PG8_WAIT_L(0); PG8_BAR; PG8_MMA(1, 0, At, B0); PG8_MMA(1, 1, At, B1); PG8_BAR; PG8_SCHED;
            } else {
            PG8_LDB(B0, 0, 0); PG8_SCHED; PG8_LDA(At, 0, 0); PG8_STAGE_A(PG8_SA(1, 1), a1 + hstepA, 1, false);
            PG8_WAIT_L(8); PG8_BAR; PG8_WAIT_L(0); PG8_MMA(0, 0, At, B0); PG8_BAR; PG8_SCHED;
            PG8_LDB(B1, 0, 1); PG8_STAGE(PG8_SB(0, 0), b2, voffB);
            PG8_BAR; PG8_WAIT_L(0); PG8_MMA(0, 1, At, B1); PG8_BAR;
            PG8_LDA(At, 0, 1); PG8_STAGE_A(PG8_SA(0, 0), a2, 0, last);
            PG8_BAR; PG8_WAIT_L(0); PG8_MMA(1, 0, At, B0); PG8_BAR; PG8_SCHED;
            PG8_STAGE(PG8_SB(0, 1), b2 + hstep, voffB);
            PG8_WAIT_V(6); PG8_BAR; PG8_MMA(1, 1, At, B1); PG8_BAR;
            PG8_LDB(B0, 1, 0); PG8_SCHED; PG8_LDA(At, 1, 0); PG8_STAGE_A(PG8_SA(0, 1), a2 + hstepA, 1, last);
            PG8_WAIT_L(8); PG8_BAR; PG8_WAIT_L(0); PG8_MMA(0, 0, At, B0); PG8_BAR; PG8_SCHED;
            PG8_LDB(B1, 1, 1); PG8_STAGE(PG8_SB(1, 0), b3, voffB);
            PG8_BAR; PG8_WAIT_L(0); PG8_MMA(0, 1, At, B1); PG8_BAR;
            PG8_LDA(At, 1, 1); PG8_STAGE_A(PG8_SA(1, 0), a3, 0, last);
            PG8_BAR; PG8_WAIT_L(0); PG8_MMA(1, 0, At, B0); PG8_BAR; PG8_SCHED;
            PG8_STAGE(PG8_SB(1, 1), b3 + hstep, voffB);
            PG8_WAIT_V(6); PG8_BAR; PG8_MMA(1, 1, At, B1); PG8_BAR;
            }
        }
        if constexpr (ALIGN_EPI) { if (wr == 0) PG8_BAR; }
        if constexpr (!Epi::AFTER_DRAIN) { E(acc, cur, wr, wc, fr, fq); S.done(cur); }
        if (!has_next) break;
#pragma unroll
        for (int a = 0; a < 2; ++a)
#pragma unroll
            for (int b = 0; b < 2; ++b)
#pragma unroll
                for (int m = 0; m < 4; ++m)
#pragma unroll
                    for (int n = 0; n < 2; ++n) acc[a][b][m][n] = (f32x4){0.f, 0.f, 0.f, 0.f};
        cur = nxt; cA = nA; cB = nB; ++ui;
        if constexpr (GATHER) { _Pragma("unroll") for (int h_ = 0; h_ < 2; ++h_) _Pragma("unroll") for (int i_ = 0; i_ < 2; ++i_) gA[h_][i_] = nGA[h_][i_]; }
        if constexpr (ALIGN_EPI) { if (wr == 1) PG8_BAR; }
    }
    PG8_WAIT_V(0);
    if constexpr (!ALIGN_EPI) { if (wr == 0) PG8_BAR; }
    PG8_BAR;
    if constexpr (Epi::AFTER_DRAIN) { E.fused(acc, cur, wr, wc, fr, fq, lds, wid, lane); S.done(cur); }
#undef PG8_SA
#undef PG8_SB
#undef PG8_STAGE
#undef PG8_STAGE_A
#undef PG8_GOFF
#undef PG8_LDA
#undef PG8_LDB
#undef PG8_MMA
#undef PG8_WAIT_V
#undef PG8_WAIT_L
#undef PG8_BAR
#undef PG8_SCHED
}
}
namespace mk {
constexpr int D = 1024, BATCH = 2, SEQ = 8192, T = BATCH * SEQ;
constexpr int INW = 2832, NPROJ = 2816;
constexpr int PJ_Q = 0, PJ_K = 512, PJ_V = 1024, PJ_Z = 1536, PJ_AQ = 2048, PJ_AK = 2560, PJ_AV = 2688;
constexpr int NEXP = 64, EFF = 256;
constexpr float EPS = 1e-6f;
constexpr int NWAVES = 8, NTHR = 512;
constexpr size_t MiB = 1u << 20;
constexpr size_t WS_CTL = 0, CTL_ZERO_BYTES = 1 * MiB;
constexpr size_t WS_WIN = 1 * MiB, WS_WOUT = 7 * MiB, WS_WGU = 9 * MiB, WS_WD = 73 * MiB;
constexpr size_t WS_HN = 105 * MiB, WS_BG = 137 * MiB, WS_MISC = 138 * MiB, WS_PROJ = 144 * MiB;
constexpr size_t WS_DN = 232 * MiB, WS_MIX = 456 * MiB, WS_END = 488 * MiB;
constexpr int CW_BAR = 4096;
constexpr int LDS_BYTES = 163840, RING_BYTES = 159744, LDSCTL_OFF = RING_BYTES, MISC_OFF = LDSCTL_OFF + 320;

#define GAS __attribute__((address_space(1)))
#define LAS __attribute__((address_space(3)))
typedef unsigned short bf16;
typedef unsigned v4u __attribute__((ext_vector_type(4)));
typedef float f32x4 __attribute__((ext_vector_type(4)));
typedef GAS unsigned gu32;
#define RLX_AGENT __ATOMIC_RELAXED, __HIP_MEMORY_SCOPE_AGENT
#define LDS_WAIT() asm volatile("s_waitcnt lgkmcnt(0)" ::: "memory")
#define VM_WAIT() asm volatile("s_waitcnt vmcnt(0)" ::: "memory")
__device__ __forceinline__ unsigned f2bf(float f) { unsigned u = __builtin_bit_cast(unsigned, f); return (u + 0x7fffu + ((u >> 16) & 1u)) >> 16; }
typedef float f32x2_t __attribute__((ext_vector_type(2))); typedef __bf16 bf16x2_t __attribute__((ext_vector_type(2)));
__device__ __forceinline__ unsigned pk2(float lo, float hi) { f32x2_t v = {lo, hi}; bf16x2_t b = __builtin_convertvector(v, bf16x2_t); return __builtin_bit_cast(unsigned, b); }
__device__ __forceinline__ float bf2f(unsigned short b) { return __builtin_bit_cast(float, (unsigned)b << 16); }
__device__ __forceinline__ float wave_sum(float v) {
#pragma unroll
    for (int o = 1; o < 64; o <<= 1) v += __shfl_xor(v, o);
    return v;
}
__device__ __forceinline__ float reduce16(float (&v)[16], int lane) {
    { const bool h = (lane & 32) != 0;
#pragma unroll
      for (int i = 0; i < 8; ++i) { const float keep = h ? v[i + 8] : v[i], send = h ? v[i] : v[i + 8]; v[i] = keep + __shfl_xor(send, 32); } }
    { const bool h = (lane & 16) != 0;
#pragma unroll
      for (int i = 0; i < 4; ++i) { const float keep = h ? v[i + 4] : v[i], send = h ? v[i] : v[i + 4]; v[i] = keep + __shfl_xor(send, 16); } }
    { const bool h = (lane & 8) != 0;
#pragma unroll
      for (int i = 0; i < 2; ++i) { const float keep = h ? v[i + 2] : v[i], send = h ? v[i] : v[i + 2]; v[i] = keep + __shfl_xor(send, 8); } }
    { const bool h = (lane & 4) != 0; const float keep = h ? v[1] : v[0], send = h ? v[0] : v[1]; v[0] = keep + __shfl_xor(send, 4); }
    v[0] += __shfl_xor(v[0], 2); v[0] += __shfl_xor(v[0], 1);
    return v[0];
}
__device__ __forceinline__ float silu_f(float x) { return x / (1.f + __expf(-x)); }
__device__ __forceinline__ float softplus_f(float x) { return fmaxf(x, 0.f) + log1pf(expf(-fabsf(x))); }

#define XB_TMO      128
#define XB_XCNT(j)  (256  + 64 * (j))
#define XB_XSUB(j)  (1280 + 64 * (j))
#define XB_XGEN(j)  (2304 + 64 * (j))
#define XB_TOP      3328
#define XB_TOPGEN   3392
#define XCD_BAR_WORDS 3456
#define XB_SPIN_CAP (1u << 22)
__device__ __forceinline__ unsigned xb_ld(unsigned* p)              { return __hip_atomic_load(p, __ATOMIC_RELAXED, __HIP_MEMORY_SCOPE_AGENT); }
__device__ __forceinline__ unsigned xb_add(unsigned* p, unsigned v) { return __hip_atomic_fetch_add(p, v, __ATOMIC_RELAXED, __HIP_MEMORY_SCOPE_AGENT); }
__device__ __forceinline__ unsigned xb_xcc_id() { return (unsigned)__builtin_amdgcn_s_getreg((3 << 11) | 20) & 0xFu; }
#define XB_SPIN(cond, bar) do { unsigned _sp = 0; while (cond) { __builtin_amdgcn_s_sleep(1); \
    if ((++_sp & 255u) == 0u) { if (xb_ld(&(bar)[XB_TMO])) break; if (_sp > XB_SPIN_CAP) { atomicAdd(&(bar)[XB_TMO], 1u); break; } } } } while (0)
struct XcdBarrier { unsigned* bar; unsigned x; volatile LAS unsigned* st; };
__device__ __forceinline__ XcdBarrier xcd_barrier_post(unsigned* bar, volatile LAS unsigned* st) {
    XcdBarrier b; b.bar = bar; b.x = xb_xcc_id(); b.st = st;
    if (threadIdx.x == 0) (void)xb_add(&bar[XB_XCNT(b.x)], 1u);
    return b;
}
__device__ __forceinline__ void xcd_barrier_complete(unsigned* bar, unsigned x, unsigned& nloc, unsigned& nx) {
    const unsigned G = gridDim.x * gridDim.y * gridDim.z;
    unsigned sum, cnt, mine, sp = 0u;
    for (;;) {
        sum = 0u; cnt = 0u; mine = 0u;
#pragma unroll
        for (unsigned j = 0; j < 16; ++j) { const unsigned c = xb_ld(&bar[XB_XCNT(j)]); sum += c; cnt += (c > 0u) ? 1u : 0u; mine = (j == x) ? c : mine; }
        if (sum == G) break;
        __builtin_amdgcn_s_sleep(1);
        if ((++sp & 255u) == 0u) { if (xb_ld(&bar[XB_TMO])) break; if (sp > XB_SPIN_CAP) { atomicAdd(&bar[XB_TMO], 1u); break; } }
    }
    nloc = mine > 0u ? mine : 1u; nx = cnt > 0u ? cnt : 1u;
}
__device__ __forceinline__ void xcd_barrier(const XcdBarrier& b) {
    asm volatile("s_waitcnt vmcnt(0)" ::: "memory");
    __syncthreads();
    if (threadIdx.x == 0) {
        unsigned* bar = b.bar;
        __builtin_amdgcn_s_waitcnt(0);
        unsigned nloc = b.st[0], nx = b.st[1];
        if (nloc == 0u) { xcd_barrier_complete(bar, b.x, nloc, nx); b.st[0] = nloc; b.st[1] = nx; }
        const unsigned old = xb_add(&bar[XB_XSUB(b.x)], 1u);
        const unsigned gen = old / nloc;
        if (old + 1u == (gen + 1u) * nloc) {
            __builtin_amdgcn_fence(__ATOMIC_RELEASE, "agent");
            asm volatile("s_waitcnt vmcnt(0)" ::: "memory");
            const unsigned og = xb_add(&bar[XB_TOP], 1u);
            const unsigned tg = og / nx;
            if (og + 1u == (tg + 1u) * nx) xb_add(&bar[XB_TOPGEN], 1u);
            else XB_SPIN(xb_ld(&bar[XB_TOPGEN]) == tg, bar);
            __builtin_amdgcn_fence(__ATOMIC_ACQUIRE, "agent");
            xb_add(&bar[XB_XGEN(b.x)], 1u);
            asm volatile("s_waitcnt vmcnt(0)" ::: "memory");
        } else {
            XB_SPIN(xb_ld(&bar[XB_XGEN(b.x)]) == gen, bar);
            __builtin_amdgcn_fence(__ATOMIC_ACQUIRE, "agent");
            asm volatile("s_waitcnt vmcnt(0)" ::: "memory");
        }
    }
    __syncthreads();
}

struct Frame {
    LAS unsigned char* lds;
    volatile LAS unsigned* MISC;
    gu32* ctl;
    int tid, lane, wave;
    int vcu, G, li;
    float* out; unsigned char* ws;
};
enum { I_X = 0, I_LNMIX, I_WIN, I_CONV, I_ALOG, I_DTB, I_DNNORM, I_SINK, I_WOUT, I_LNFFN, I_WG, I_BG, I_WE, I_BE, I_WGU, I_WD, I_LNF };

__device__ __forceinline__ void transpose_item(const float* W, int ldn, int src_col0, int k0, bf16* WT, int ldk, int dst_row0, LAS float* scr, int lane) {
#pragma unroll 8
    for (int i = 0; i < 32; ++i) { const int kk = 2 * i + (lane >> 5); scr[kk * 33 + (lane & 31)] = __builtin_nontemporal_load(W + (size_t)(k0 + kk) * ldn + src_col0 + (lane & 31)); }
    LDS_WAIT(); asm volatile("" ::: "memory");
    const int c = lane & 7;
#pragma unroll
    for (int j = 0; j < 4; ++j) { const int n = (lane >> 3) + 8 * j; const LAS float* s = scr + (8 * c) * 33 + n;
        v4u o; o.x = pk2(s[0 * 33], s[1 * 33]); o.y = pk2(s[2 * 33], s[3 * 33]); o.z = pk2(s[4 * 33], s[5 * 33]); o.w = pk2(s[6 * 33], s[7 * 33]);
        __builtin_nontemporal_store(o, (v4u*)(WT + (size_t)(dst_row0 + n) * ldk + k0 + 8 * c)); }
    LDS_WAIT(); asm volatile("" ::: "memory");
}
__device__ __forceinline__ void p0_prologue(Frame& F, const float* x_in, const float* lnw, const float* w_in, const float* w_out, const float* a_log, const float* dt_b) {
    LAS float* scr = (LAS float*)(F.lds + F.wave * 16384);
    const int gw = F.vcu * NWAVES + F.wave, NGW = F.G * NWAVES;
    bf16* Win_t = (bf16*)(F.ws + WS_WIN); bf16* Wout_t = (bf16*)(F.ws + WS_WOUT);
    constexpr int I_IN = 16 * 88, I_OUT = 16 * 32, NITEMS = I_IN + I_OUT;
    for (int it = gw; it < NITEMS; it += NGW) {
        int r = it;
        if (r < I_IN) { const int kb = r / 88, nb = r % 88, n0 = 32 * nb; transpose_item(w_in, INW, n0 + (n0 >= 2048 ? 16 : 0), 64 * kb, Win_t, D, n0, scr, F.lane); continue; } r -= I_IN;
        { const int kb = r / 32, nb = r % 32; transpose_item(w_out, D, 32 * nb, 64 * kb, Wout_t, D, 32 * nb, scr, F.lane); }
    }
    __syncthreads();
    LAS float* w16T = (LAS float*)F.lds;
    for (int i = F.tid; i < D * 4; i += NTHR) { const int k = i >> 2, c4 = (i & 3) * 4; const f32x4 w = *(const f32x4*)(w_in + (size_t)k * INW + 2048 + c4);
        w16T[(c4 + 0) * D + k] = w.x; w16T[(c4 + 1) * D + k] = w.y; w16T[(c4 + 2) * D + k] = w.z; w16T[(c4 + 3) * D + k] = w.w; }
    __syncthreads();
    bf16* hn = (bf16*)(F.ws + WS_HN); float* bg = (float*)(F.ws + WS_BG);
    f32x4 lw[4];
#pragma unroll
    for (int j = 0; j < 4; ++j) lw[j] = ((const f32x4*)lnw)[F.lane + 64 * j];
    for (int m = gw; m < T; m += NGW) {
        const GAS f32x4* xr = (const GAS f32x4*)(x_in + (size_t)m * D) + F.lane;
        f32x4 v[4]; float s = 0.f;
#pragma unroll
        for (int j = 0; j < 4; ++j) { v[j] = xr[64 * j]; s += (v[j].x * v[j].x + v[j].y * v[j].y) + (v[j].z * v[j].z + v[j].w * v[j].w); }
        const float rstd = rsqrtf(wave_sum(s) * (1.f / D) + EPS);
#pragma unroll
        for (int j = 0; j < 4; ++j) v[j] = v[j] * rstd * lw[j];
        GAS unsigned long long* o8 = (GAS unsigned long long*)(hn + (size_t)m * D) + F.lane;
#pragma unroll
        for (int j = 0; j < 4; ++j) o8[64 * j] = (unsigned long long)pk2(v[j].x, v[j].y) | ((unsigned long long)pk2(v[j].z, v[j].w) << 32);
        float acc[16];
#pragma unroll
        for (int c = 0; c < 16; ++c) { float a = 0.f;
#pragma unroll
            for (int j = 0; j < 4; ++j) { const f32x4 w = *(const LAS f32x4*)(w16T + c * D + 4 * F.lane + 256 * j); a += (v[j].x * w.x + v[j].y * w.y) + (v[j].z * w.z + v[j].w * w.w); }
            acc[c] = a; if ((c & 3) == 3) asm volatile("" ::: "memory"); }
        const float tot = reduce16(acc, F.lane);
        if ((F.lane & 3) == 0) { const int idx = ((F.lane >> 5) & 1) * 8 + ((F.lane >> 4) & 1) * 4 + ((F.lane >> 3) & 1) * 2 + ((F.lane >> 2) & 1);
            if (idx < 8) bg[(size_t)m * 16 + idx] = 1.f / (1.f + expf(-tot));
            else bg[(size_t)m * 16 + idx] = -expf(a_log[idx - 8]) * softplus_f(tot + dt_b[idx - 8]); }
    }
}

typedef short bf16x8 __attribute__((ext_vector_type(8)));
typedef short bf16x4 __attribute__((ext_vector_type(4)));
typedef unsigned v2u __attribute__((ext_vector_type(2)));
constexpr size_t DN_QS = WS_DN, DN_KT = WS_DN + 32 * MiB, DN_U = WS_DN + 64 * MiB, DN_W = WS_DN + 128 * MiB, DN_AT = WS_DN + 192 * MiB;
constexpr size_t DN_GV = WS_MISC;
constexpr size_t SC_KKQK = WS_WGU, SC_VT = WS_WD;
#define MFMA16(a, b, c) __builtin_amdgcn_mfma_f32_16x16x32_bf16((a), (b), (c), 0, 0, 0)
#define RAW_BAR() do { asm volatile("s_waitcnt lgkmcnt(0)" ::: "memory"); __builtin_amdgcn_s_barrier(); asm volatile("" ::: "memory"); } while (0)

__device__ __forceinline__ void p2_group(Frame& F, int grp, const float* convw, const float* bgp, int stmask = 3) {
    const int tid = F.tid, lane = F.lane, w = F.wave;
    const bf16* proj = (const bf16*)(F.ws + WS_PROJ);
    LAS bf16* XIN = (LAS bf16*)F.lds;
    LAS bf16* QL = (LAS bf16*)(F.lds + 52224);
    LAS bf16* KL = (LAS bf16*)(F.lds + 52224 + 17408);
#pragma unroll 1
    for (int ui = 0; ui < ((stmask & 1) ? 4 : 0); ++ui) {
        const int un = grp * 4 + ui, n = un & 127, bh = un >> 7, h = bh & 3, b = bh >> 2;
#pragma unroll 1
        for (int c = tid; c < 68 * 48; c += NTHR) { const int rr = c / 48, rem = c - rr * 48, p = rem >> 4, c16 = rem & 15, s = 64 * n - 2 + rr;
            v4u v = (v4u){0u, 0u, 0u, 0u};
            if (s >= 0 && s < SEQ) v = *(const GAS v4u*)(proj + (size_t)(b * SEQ + s) * NPROJ + p * 512 + h * 128 + c16 * 8);
            *(LAS v4u*)(XIN + rr * 384 + p * 128 + c16 * 8) = v; }
        __syncthreads();
        {
            float val[3][8][2];
#pragma unroll
            for (int p = 0; p < 3; ++p) {
                float cw[5][2];
#pragma unroll
                for (int j = 0; j < 5; ++j) { const float* cp = convw + j * 1536 + p * 512 + h * 128 + 2 * lane; cw[j][0] = cp[0]; cw[j][1] = cp[1]; }
                float xr[12][2];
#pragma unroll
                for (int r = 0; r < 12; ++r) { const unsigned u2 = *(const LAS unsigned*)(XIN + (8 * w + r) * 384 + p * 128 + 2 * lane); xr[r][0] = bf2f((unsigned short)(u2 & 0xffffu)); xr[r][1] = bf2f((unsigned short)(u2 >> 16)); }
#pragma unroll
                for (int i = 0; i < 8; ++i) { float a0 = 0.f, a1 = 0.f;
#pragma unroll
                    for (int j = 0; j < 5; ++j) { a0 = fmaf(xr[i + j][0], cw[j][0], a0); a1 = fmaf(xr[i + j][1], cw[j][1], a1); }
                    val[p][i][0] = silu_f(a0); val[p][i][1] = silu_f(a1); }
            }
#pragma unroll
            for (int i = 0; i < 8; ++i) {
                const float sq = wave_sum(val[0][i][0] * val[0][i][0] + val[0][i][1] * val[0][i][1]);
                const float sk = wave_sum(val[1][i][0] * val[1][i][0] + val[1][i][1] * val[1][i][1]);
                const float rq = rsqrtf(sq + EPS) * 0.08838834764831845f, rk = rsqrtf(sk + EPS);
                val[0][i][0] *= rq; val[0][i][1] *= rq; val[1][i][0] *= rk; val[1][i][1] *= rk;
                const unsigned qp = pk2(val[0][i][0], val[0][i][1]), kp = pk2(val[1][i][0], val[1][i][1]);
                *(LAS unsigned*)(QL + (8 * w + i) * 136 + 2 * lane) = qp; *(LAS unsigned*)(KL + (8 * w + i) * 136 + 2 * lane) = kp;
                *(GAS unsigned*)((bf16*)(F.ws + DN_QS) + ((size_t)un * 64 + 8 * w + i) * 128 + 2 * lane) = qp;
            }
#pragma unroll
            for (int c = 0; c < 2; ++c) {
                v4u kt, vt;
                kt.x = pk2(val[1][0][c], val[1][1][c]); kt.y = pk2(val[1][2][c], val[1][3][c]); kt.z = pk2(val[1][4][c], val[1][5][c]); kt.w = pk2(val[1][6][c], val[1][7][c]);
                vt.x = pk2(val[2][0][c], val[2][1][c]); vt.y = pk2(val[2][2][c], val[2][3][c]); vt.z = pk2(val[2][4][c], val[2][5][c]); vt.w = pk2(val[2][6][c], val[2][7][c]);
                { bf16* kp = (bf16*)(F.ws + DN_KT) + ((size_t)un * 128 + 2 * lane + c) * 64 + 32 * (w >> 2) + 16 * (w & 1) + 4 * ((w & 3) >> 1);
                  *(GAS v2u*)kp = (v2u){kt.x, kt.y}; *(GAS v2u*)(kp + 8) = (v2u){kt.z, kt.w}; }
                *(GAS v4u*)((bf16*)(F.ws + SC_VT) + ((size_t)un * 128 + 2 * lane + c) * 64 + 8 * w) = vt;
            }
        }
        __syncthreads();
        {
            const int type = w >> 2, tr = w & 3, fr = lane & 15, fq = lane >> 4;
            const LAS bf16* Asrc = type ? QL : KL;
            bf16x8 af[4];
#pragma unroll
            for (int ks = 0; ks < 4; ++ks) af[ks] = *(const LAS bf16x8*)(Asrc + (16 * tr + fr) * 136 + 32 * ks + 8 * fq);
            float* G = (float*)(F.ws + SC_KKQK) + ((size_t)un * 2 + type) * 4096;
#pragma unroll
            for (int tc = 0; tc < 4; ++tc) { f32x4 acc = (f32x4){0.f, 0.f, 0.f, 0.f};
#pragma unroll
                for (int ks = 0; ks < 4; ++ks) { const bf16x8 bfr = *(const LAS bf16x8*)(KL + (16 * tc + fr) * 136 + 32 * ks + 8 * fq); acc = MFMA16(af[ks], bfr, acc); }
#pragma unroll
                for (int r = 0; r < 4; ++r) G[(16 * tr + 4 * fq + r) * 64 + 16 * tc + fr] = acc[r]; }
        }
    }
    VM_WAIT(); __syncthreads();
    if (tid == 0) { __builtin_amdgcn_fence(__ATOMIC_ACQUIRE, "agent"); VM_WAIT(); }
    __syncthreads();
    if (stmask & 2) {
        int lane = F.lane; asm volatile("" : "+v"(lane));
        const int un = grp * 4 + (w >> 1), dir = w & 1, n = un & 127, bh = un >> 7, h = bh & 3, b = bh >> 2, item = un * 2 + dir;
        const int rl = dir ? 63 - lane : lane;
        const size_t tok = (size_t)b * SEQ + 64 * n + rl;
        const float beta = bgp[tok * 16 + dir * 4 + h], g = bgp[tok * 16 + 8 + dir * 4 + h];
        float gc = g;
#pragma unroll
        for (int o = 1; o < 64; o <<= 1) { const float t = __shfl_up(gc, o); if (lane >= o) gc += t; }
        const float gcl = __shfl(gc, 63), egc = __expf(gc), ekd = __expf(gcl - gc);
        float* gv = (float*)(F.ws + DN_GV) + (size_t)item * 128; gv[lane] = egc; gv[64 + lane] = ekd;
        const float* KKp = (const float*)(F.ws + SC_KKQK) + (size_t)un * 8192; const float* QKp = KKp + 4096;
        bf16* ATp = (bf16*)(F.ws + DN_AT) + (size_t)item * 4096;
        float Tr[64];
        float kkc[8], qkc[8];
        const char* KKb = (const char*)KKp; char* ATb = (char*)ATp;
        const int kstep = dir ? -256 : 256;
        const unsigned kk0 = (unsigned)(((dir ? 63 : 0) * 64 + rl) * 4);
        {   unsigned o2 = kk0; asm volatile("" : "+v"(o2));
#pragma unroll
            for (int r = 0; r < 8; ++r) { kkc[r] = *(const float*)(KKb + (o2 + (unsigned)(r * kstep))); qkc[r] = *(const float*)(KKb + (o2 + (unsigned)(r * kstep) + 16384u)); } }
#pragma unroll
        for (int blk = 0; blk < 8; ++blk) {
            float kkn[8], qkn[8];
            {   unsigned o2 = kk0 + (unsigned)((blk < 7 ? 8 * (blk + 1) : 0) * kstep); asm volatile("" : "+v"(o2));
#pragma unroll
                for (int r = 0; r < 8; ++r) { kkn[r] = *(const float*)(KKb + (o2 + (unsigned)(r * kstep))); qkn[r] = *(const float*)(KKb + (o2 + (unsigned)(r * kstep) + 16384u)); } }
            unsigned ao = (unsigned)(lane * 2 + blk * 1024); asm volatile("" : "+v"(ao));
            asm volatile("" ::: "memory");
#pragma unroll
            for (int r = 0; r < 8; ++r) {
                const int i = 8 * blk + r;
                const float kk = kkc[r], qk = qkc[r];
                const float gci = __builtin_bit_cast(float, __builtin_amdgcn_readlane(__builtin_bit_cast(int, gc), i));
                const float bi = __builtin_bit_cast(float, __builtin_amdgcn_readlane(__builtin_bit_cast(int, beta), i));
                const float dec = __expf(fminf(gci - gc, 0.f));
                const float arow = (lane < i) ? bi * kk * dec : 0.f;
                *(bf16*)(ATb + (ao + (unsigned)(r * 128))) = (bf16)f2bf((lane <= i) ? qk * dec : 0.f);
                float t = (lane == i) ? 1.f : 0.f;
#pragma unroll
                for (int j = 0; j < i; ++j) { const float sv = __builtin_bit_cast(float, __builtin_amdgcn_readlane(__builtin_bit_cast(int, arow), j)); t = fmaf(-sv, Tr[j], t); }
                Tr[i] = t;
            }
            asm volatile("" ::: "memory");
#pragma unroll
            for (int r = 0; r < 8; ++r) { kkc[r] = kkn[r]; qkc[r] = qkn[r]; }
        }
        LAS bf16* TB = (LAS bf16*)(F.lds + w * 16384); LAS bf16* TG = TB + 4096;
        const float cb = beta, cg = beta * egc;
        const int rp = (rl & 32) | (((rl >> 2) & 3) << 3) | (((rl >> 4) & 1) << 2) | (rl & 3);
#pragma unroll
        for (int i = 0; i < 64; ++i) { const int off = i * 64 + ((((rl >> 3) ^ (i & 7))) << 3) + (rl & 7), offg = i * 64 + ((((rp >> 3) ^ (i & 7))) << 3) + (rp & 7);
            TB[off] = (bf16)f2bf(Tr[i] * cb); TG[offg] = (bf16)f2bf(Tr[i] * cg); }
        LDS_WAIT(); asm volatile("" ::: "memory");
        const int fr = lane & 15, fq = lane >> 4;
        bf16x8 ab[4][2], ag[4][2];
#pragma unroll
        for (int m = 0; m < 4; ++m)
#pragma unroll
            for (int ks = 0; ks < 2; ++ks) { const int row = 16 * m + fr, off = row * 64 + (((4 * ks + fq) ^ (row & 7)) << 3); ab[m][ks] = *(const LAS bf16x8*)(TB + off); ag[m][ks] = *(const LAS bf16x8*)(TG + off); }
        const bf16* VTp = (const bf16*)(F.ws + SC_VT) + (size_t)un * 8192; const bf16* KTp = (const bf16*)(F.ws + DN_KT) + (size_t)un * 8192;
        bf16* Up = (bf16*)(F.ws + DN_U) + (size_t)item * 8192; bf16* Wp = (bf16*)(F.ws + DN_W) + (size_t)item * 8192;
#pragma unroll 2
        for (int nn = 0; nn < 8; ++nn) {
            bf16x8 bv[2], bk[2];
#pragma unroll
            for (int ks = 0; ks < 2; ++ks) { bv[ks] = *(const GAS bf16x8*)(VTp + (16 * nn + fr) * 64 + 32 * ks + 8 * fq); bk[ks] = *(const GAS bf16x8*)(KTp + (16 * nn + fr) * 64 + 32 * ks + 8 * fq); }
#pragma unroll
            for (int m = 0; m < 4; ++m) {
                f32x4 au = (f32x4){0.f, 0.f, 0.f, 0.f}, aw = (f32x4){0.f, 0.f, 0.f, 0.f};
#pragma unroll
                for (int ks = 0; ks < 2; ++ks) { au = MFMA16(ab[m][ks], bv[ks], au); aw = MFMA16(bk[ks], ag[m][ks], aw); }
                v2u uo; uo.x = pk2(au[0], au[1]); uo.y = pk2(au[2], au[3]);
                *(GAS v2u*)(Up + ((m * 8 + nn) * 64 + lane) * 4) = uo;
                v2u wo; wo.x = pk2(aw[0], aw[1]); wo.y = pk2(aw[2], aw[3]);
                *(GAS v2u*)(Wp + (16 * m + fr) * 128 + 32 * (nn >> 1) + 8 * fq + 4 * (nn & 1)) = wo;
            }
        }
    }
    __syncthreads();
}

constexpr int CW_PROG = 196608;
constexpr int RB_W = 0, RB_KT = 16384, RB_U = 32768, RB_GV = 36864, RB_SIZE = 37888;
static_assert(4 * RB_SIZE <= RING_BYTES, "scan ring");
constexpr size_t DN_SX0 = DN_U + 32 * MiB, DN_SX1 = DN_W + 32 * MiB, DN_VX0 = DN_QS + 16 * MiB, DN_VX1 = DN_KT + 16 * MiB;
__device__ __forceinline__ void glds16(const void* gsrc, LAS unsigned char* ldst) {
    __builtin_amdgcn_global_load_lds((const unsigned*)gsrc, (LAS unsigned*)ldst, 16, 0, 0);
}
__device__ __forceinline__ void glds16_sc1(const void* gsrc, LAS unsigned char* ldst) {
    __builtin_amdgcn_global_load_lds((const unsigned*)gsrc, (LAS unsigned*)ldst, 16, 0, 16);
}
template <int OFF>
__device__ __forceinline__ void store16_sc1(void* gdst, v4u v) {
    asm volatile("global_store_dwordx4 %0, %1, off offset:%2 sc1\n\ts_nop 1" :: "v"(gdst), "v"(v), "n"(OFF) : "memory");
}
__device__ __forceinline__ bf16x8 ld2x8(const LAS unsigned char* p0, const LAS unsigned char* p1) {
    const v2u lo = *(const LAS v2u*)p0, hi = *(const LAS v2u*)p1; v4u v; v.x = lo.x; v.y = lo.y; v.z = hi.x; v.w = hi.y; return __builtin_bit_cast(bf16x8, v);
}
struct ScanOff { unsigned w0[4], k0[2], u, gk; };
template <int DIR, int BUF>
__device__ __forceinline__ void scan_step(LAS unsigned char* L, const ScanOff& O, f32x4 (&S)[8], unsigned char*& sxp, unsigned char*& vxp, bool ex) {
    const LAS unsigned char* B = L + BUF * RB_SIZE;
    v4u sbv[4];
#pragma unroll
    for (int ks = 0; ks < 4; ++ks) { sbv[ks].x = pk2(S[2 * ks][0], S[2 * ks][1]); sbv[ks].y = pk2(S[2 * ks][2], S[2 * ks][3]); sbv[ks].z = pk2(S[2 * ks + 1][0], S[2 * ks + 1][1]); sbv[ks].w = pk2(S[2 * ks + 1][2], S[2 * ks + 1][3]); }
    if (ex) { store16_sc1<0>(sxp, sbv[0]); store16_sc1<1024>(sxp, sbv[1]); store16_sc1<2048>(sxp, sbv[2]); store16_sc1<3072>(sxp, sbv[3]); }
    bf16x8 fw[4][4]; v2u ucv[4]; f32x4 ekv[4];
#pragma unroll
    for (int it = 0; it < 4; ++it) {
#pragma unroll
        for (int ks = 0; ks < 4; ++ks) fw[it][ks] = *(const LAS bf16x8*)(B + RB_W + O.w0[ks] + it * 4096);
        ucv[it] = *(const LAS v2u*)(B + RB_U + O.u + it * 1024); ekv[it] = *(const LAS f32x4*)(B + RB_GV + O.gk + it * 64); }
    const float dch = ((const LAS float*)(B + RB_GV))[63];
    f32x4 aW[4];
#pragma unroll
    for (int it = 0; it < 4; ++it) { aW[it] = (f32x4){0.f, 0.f, 0.f, 0.f};
#pragma unroll
        for (int ks = 0; ks < 4; ++ks) aW[it] = MFMA16(fw[it][ks], __builtin_bit_cast(bf16x8, sbv[ks]), aW[it]); }
    bf16x8 fk[8][2];
#pragma unroll
    for (int dt = 0; dt < 8; ++dt)
#pragma unroll
        for (int k2 = 0; k2 < 2; ++k2) fk[dt][k2] = *(const LAS bf16x8*)(B + RB_KT + O.k0[k2] + dt * 2048);
    f32x4 vs[4]; v2u vnp[4];
#pragma unroll
    for (int it = 0; it < 4; ++it) {
        const v2u uc = ucv[it]; const f32x4 ek = ekv[it];
        f32x4 vn;
        vn[0] = bf2f((unsigned short)(uc.x & 0xffffu)) - aW[it][0]; vn[1] = bf2f((unsigned short)(uc.x >> 16)) - aW[it][1];
        vn[2] = bf2f((unsigned short)(uc.y & 0xffffu)) - aW[it][2]; vn[3] = bf2f((unsigned short)(uc.y >> 16)) - aW[it][3];
        vnp[it] = (v2u){pk2(vn[0], vn[1]), pk2(vn[2], vn[3])};
        vs[it] = vn * ek;
    }
    if (ex) { store16_sc1<0>(vxp, (v4u){vnp[0].x, vnp[0].y, vnp[1].x, vnp[1].y}); store16_sc1<1024>(vxp, (v4u){vnp[2].x, vnp[2].y, vnp[3].x, vnp[3].y}); }
    sxp += DIR ? -32768 : 32768; vxp += DIR ? -16384 : 16384;
    bf16x8 Vsb[2];
#pragma unroll
    for (int k2 = 0; k2 < 2; ++k2) { v4u t;
        if (DIR) { t.x = pk2(vs[2 * k2 + 1][3], vs[2 * k2 + 1][2]); t.y = pk2(vs[2 * k2 + 1][1], vs[2 * k2 + 1][0]); t.z = pk2(vs[2 * k2][3], vs[2 * k2][2]); t.w = pk2(vs[2 * k2][1], vs[2 * k2][0]); }
        else { t.x = pk2(vs[2 * k2][0], vs[2 * k2][1]); t.y = pk2(vs[2 * k2][2], vs[2 * k2][3]); t.z = pk2(vs[2 * k2 + 1][0], vs[2 * k2 + 1][1]); t.w = pk2(vs[2 * k2 + 1][2], vs[2 * k2 + 1][3]); }
        Vsb[k2] = __builtin_bit_cast(bf16x8, t); }
#pragma unroll
    for (int dt = 0; dt < 8; ++dt) { S[dt] = S[dt] * dch;
#pragma unroll
        for (int k2 = 0; k2 < 2; ++k2) S[dt] = MFMA16(fk[dt][k2], Vsb[k2], S[dt]); }
    asm volatile("s_waitcnt vmcnt(30) lgkmcnt(0)" ::: "memory"); __builtin_amdgcn_s_barrier(); asm volatile("" ::: "memory");
}
template <int DIR>
__device__ __forceinline__ void scan_compute(Frame& F, LAS unsigned char* L, int qt, int bh, int mode) {
    const int lane = F.lane, w = F.wave, fr = lane & 15, fq = lane >> 4, hf = qt >> 1, wt = 2 * (qt & 1) + w;
    ScanOff O;
    const int s7 = (fr >> 1) & 7;
#pragma unroll
    for (int ks = 0; ks < 4; ++ks) O.w0[ks] = (unsigned)(fr * 256 + (((4 * ks + fq) ^ fr) << 4));
#pragma unroll
    for (int k2 = 0; k2 < 2; ++k2) {
        const int ck = DIR ? 4 * (1 - k2) + (3 - fq) : 4 * k2 + fq;
        O.k0[k2] = (unsigned)(fr * 128 + ((ck ^ s7) << 4));
    }
    O.u = (unsigned)((w * 64 + lane) * 8); O.gk = (unsigned)((64 + 4 * fq) * 4);
    const int item0 = (bh * 128 + (DIR ? 127 : 0)) * 2 + DIR;
    unsigned char* sxp = F.ws + (hf ? DN_SX1 : DN_SX0) + (size_t)item0 * 16384 + wt * 4096 + lane * 16;
    unsigned char* vxp = F.ws + (hf ? DN_VX1 : DN_VX0) + (size_t)item0 * 8192 + wt * 2048 + lane * 16;
    const bool ex = !(mode & 1);
    f32x4 S[8];
#pragma unroll
    for (int t = 0; t < 8; ++t) S[t] = (f32x4){0.f, 0.f, 0.f, 0.f};
    __builtin_amdgcn_s_barrier(); asm volatile("" ::: "memory");
#pragma unroll 1
    for (int step = 0; step < 128; step += 4) { scan_step<DIR, 0>(L, O, S, sxp, vxp, ex); scan_step<DIR, 1>(L, O, S, sxp, vxp, ex); scan_step<DIR, 2>(L, O, S, sxp, vxp, ex); scan_step<DIR, 3>(L, O, S, sxp, vxp, ex); }
}
__device__ __forceinline__ void scan_loader(Frame& F, LAS unsigned char* L, int c, int qt, int dir, int bh, int mode) {
    const int lane = F.lane, lw = F.wave - 4, hf = qt >> 1;
    unsigned goff[10];
#pragma unroll
    for (int k = 0; k < 10; ++k) { const int p = lw + 4 * k, q = (p & 15) * 64 + lane;
        if (k < 4) { const int row = q >> 4, ch = (q & 15) ^ (row & 15); goff[k] = (unsigned)(row * 256 + ch * 16); }
        else if (k < 8) { const int row = q >> 3, ch = (q & 7) ^ ((row >> 1) & 7); goff[k] = (unsigned)(row * 128 + ch * 16); }
        else if (k == 8) goff[k] = (unsigned)(lw * 4096 + hf * 2048 + (qt & 1) * 1024 + lane * 16);
        else goff[k] = (unsigned)(lane * 16); }
    unsigned* prog = (unsigned*)(F.ctl + CW_PROG + 4096 * F.li + 64 * (c * 4 + qt));
    auto issue = [&](int t) {
        LAS unsigned char* B = L + (t & 3) * RB_SIZE;
        const int nc = dir ? 127 - t : t, un = bh * 128 + nc, item = un * 2 + dir;
        const unsigned char* gW = F.ws + DN_W + (size_t)item * 16384; const unsigned char* gK = F.ws + DN_KT + (size_t)un * 16384;
        const unsigned char* gU = F.ws + DN_U + (size_t)item * 16384; const unsigned char* gG = F.ws + DN_GV + (size_t)item * 512;
#pragma unroll
        for (int k = 0; k < 10; ++k) { const int p = lw + 4 * k;
            if (k < 4) glds16(gW + goff[k], B + RB_W + p * 1024);
            else if (k < 8) glds16(gK + goff[k], B + RB_KT + (p - 16) * 1024);
            else if (k == 8) glds16(gU + goff[k], B + RB_U + lw * 1024);
            else if (lw == 0) glds16(gG + goff[k], B + RB_GV); }
    };
    if (!(mode & 2)) { issue(0); issue(1); }
#pragma unroll 1
    for (int k = 0; k <= 128; ++k) {
        if (mode & 2) { }
        else if (k + 2 < 128) { issue(k + 2); if (lw == 0) asm volatile("s_waitcnt vmcnt(20)" ::: "memory"); else asm volatile("s_waitcnt vmcnt(18)" ::: "memory"); }
        else if (k + 1 < 128) { if (lw == 0) asm volatile("s_waitcnt vmcnt(10)" ::: "memory"); else asm volatile("s_waitcnt vmcnt(9)" ::: "memory"); }
        else asm volatile("s_waitcnt vmcnt(0)" ::: "memory");
        __builtin_amdgcn_s_barrier(); asm volatile("" ::: "memory");
        if (lw == 0 && lane == 0 && k >= 6 && !(mode & 1)) __hip_atomic_store(prog, (unsigned)(k - 5), RLX_AGENT);
    }
}
__device__ __forceinline__ void p3_scan(Frame& F, int c, int qt, int mode  ) {
    const int b = c >> 3, h = (c >> 1) & 3, dir = c & 1, bh = b * 4 + h;
    LAS unsigned char* L = F.lds;
    if (F.wave >= 4) scan_loader(F, L, c, qt, dir, bh, mode);
    else if (F.wave >= 2) {
#pragma unroll 1
        for (int k = 0; k <= 128; ++k) { __builtin_amdgcn_s_barrier(); asm volatile("" ::: "memory"); }
    }
    else if (dir) scan_compute<1>(F, L, qt, bh, mode); else scan_compute<0>(F, L, qt, bh, mode);
    asm volatile("s_waitcnt vmcnt(0) lgkmcnt(0)" ::: "memory"); __syncthreads();
    if (F.tid == 256 && !(mode & 1)) __hip_atomic_store((unsigned*)(F.ctl + CW_PROG + 4096 * F.li + 64 * (c * 4 + qt)), 128u, RLX_AGENT);
    __syncthreads();
}

constexpr int OL_Q = 0, OL_AT = 16384, OL_SX = 24576, OL_VX = 40960, OL_GV = 49152, OL_SIZE = 50176;
__device__ __forceinline__ void p3_out_issue(Frame& F, int j, LAS unsigned char* Lb) {
    const int lane = F.lane, w = F.wave;
    const int n = j >> 5, wg = j & 31, c = wg >> 1, hf = wg & 1, b = c >> 3, h = (c >> 1) & 3, dir = c & 1, bh = b * 4 + h;
    const int nc = dir ? 127 - n : n, un = bh * 128 + nc, item = un * 2 + dir;
    const unsigned char* gQ = F.ws + DN_QS + (size_t)un * 16384; const unsigned char* gA = F.ws + DN_AT + (size_t)item * 8192;
    const unsigned char* gS = F.ws + (hf ? DN_SX1 : DN_SX0) + (size_t)item * 16384; const unsigned char* gV = F.ws + (hf ? DN_VX1 : DN_VX0) + (size_t)item * 8192;
#pragma unroll
    for (int k = 0; k < 2; ++k) { const int p = 2 * w + k, q = p * 64 + lane, row = q >> 4, ch = (q & 15) ^ (row & 15);
        glds16(gQ + row * 256 + ch * 16, Lb + OL_Q + p * 1024); glds16_sc1(gS + p * 1024 + lane * 16, Lb + OL_SX + p * 1024); }
    { const int q = w * 64 + lane, row = q >> 3, ch = (q & 7) ^ ((row >> 1) & 7); glds16(gA + row * 128 + ch * 16, Lb + OL_AT + w * 1024); glds16_sc1(gV + w * 1024 + lane * 16, Lb + OL_VX + w * 1024); }
    if (w == 0) glds16(F.ws + DN_GV + (size_t)item * 512 + lane * 16, Lb + OL_GV);
}
__device__ __forceinline__ void p3_out_compute(Frame& F, int j, const LAS unsigned char* Lb, float* odir) {
    const int lane = F.lane, w = F.wave, fr = lane & 15, fq = lane >> 4, mi = w >> 1, eh = w & 1;
    const int n = j >> 5, wg = j & 31, c = wg >> 1, hf = wg & 1, b = c >> 3, h = (c >> 1) & 3, dir = c & 1;
    const int nc = dir ? 127 - n : n;
    const int irow = 16 * mi + fr, qrow = dir ? 63 - irow : irow;
    const int hb = 8 * (fq & 1), fh = fq >> 1;
    f32x4 aQ[2];
#pragma unroll
    for (int t = 0; t < 2; ++t) aQ[t] = (f32x4){0.f, 0.f, 0.f, 0.f};
#pragma unroll
    for (int ks = 0; ks < 4; ++ks) {
        const bf16x8 fqv = ld2x8(Lb + OL_Q + qrow * 256 + (((4 * ks + fh) ^ (qrow & 15)) << 4) + hb, Lb + OL_Q + qrow * 256 + (((4 * ks + 2 + fh) ^ (qrow & 15)) << 4) + hb);
#pragma unroll
        for (int t = 0; t < 2; ++t) { const bf16x8 fs = *(const LAS bf16x8*)(Lb + OL_SX + ((2 * eh + t) * 4 + ks) * 1024 + lane * 16); aQ[t] = MFMA16(fs, fqv, aQ[t]); }
    }
    const float egc_i = ((const LAS float*)(Lb + OL_GV))[irow];
#pragma unroll
    for (int t = 0; t < 2; ++t) aQ[t] = aQ[t] * egc_i;
#pragma unroll
    for (int ks = 0; ks < 2; ++ks) {
        const bf16x8 fa = ld2x8(Lb + OL_AT + irow * 128 + (((4 * ks + fh) ^ ((irow >> 1) & 7)) << 4) + hb, Lb + OL_AT + irow * 128 + (((4 * ks + 2 + fh) ^ ((irow >> 1) & 7)) << 4) + hb);
#pragma unroll
        for (int t = 0; t < 2; ++t) { const bf16x8 fv = *(const LAS bf16x8*)(Lb + OL_VX + ((2 * eh + t) * 2 + ks) * 1024 + lane * 16); aQ[t] = MFMA16(fv, fa, aQ[t]); }
    }
    const size_t tok = (size_t)b * SEQ + 64 * nc + qrow;
    float* op = odir + ((size_t)dir * T + tok) * 512 + h * 128 + 64 * hf + 4 * fq;
#pragma unroll
    for (int t = 0; t < 2; ++t) *(GAS f32x4*)(op + 16 * (2 * eh + t)) = aQ[t];
}
__device__ __forceinline__ void p3_out_batch(Frame& F, int j0, int cnt  , float* odir) {
    const int n = j0 >> 5;
    LAS unsigned char* L = F.lds;
    if (F.tid < 64) { unsigned sp = 0;
        for (;;) { bool ok = true; if (F.tid < 2 * cnt) ok = (int)__hip_atomic_load((unsigned*)(F.ctl + CW_PROG + 4096 * F.li + 64 * (2 * (j0 & 31) + F.tid)), RLX_AGENT) > n;
            if (__all(ok) || ++sp > (1u << 22)) break; __builtin_amdgcn_s_sleep(127); __builtin_amdgcn_s_sleep(127); } }
    __syncthreads();
    p3_out_issue(F, j0, L); p3_out_issue(F, j0 + (cnt > 1 ? 1 : 0), L + OL_SIZE);
    int bk = 0;
#pragma unroll 1
    for (int k = 0; k < cnt; ++k) {
        asm volatile("s_waitcnt vmcnt(6) lgkmcnt(0)" ::: "memory"); __builtin_amdgcn_s_barrier(); asm volatile("" ::: "memory");
        { int b2 = bk + 2; if (b2 >= 3) b2 -= 3; const int kn = k + 2 < cnt ? k + 2 : cnt - 1; p3_out_issue(F, j0 + kn, L + b2 * OL_SIZE); }
        p3_out_compute(F, j0 + k, L + bk * OL_SIZE, odir);
        if (++bk == 3) bk = 0;
    }
    asm volatile("s_waitcnt vmcnt(0) lgkmcnt(0)" ::: "memory"); __syncthreads();
}
typedef float f32x16 __attribute__((ext_vector_type(16)));
#define MFMA32(a, b, c) __builtin_amdgcn_mfma_f32_32x32x16_bf16((a), (b), (c), 0, 0, 0)
constexpr size_t WS_ROT = WS_CTL + 256 * 1024;
constexpr int VT_PITCH = 324;
constexpr int CW_WQ = 49152;
constexpr int LT_WQ = LDSCTL_OFF + 512;

__device__ __forceinline__ void p0_rot_table(Frame& F) {
    float* rot = (float*)(F.ws + WS_ROT);
    for (int i = (F.vcu * NTHR + F.tid); i < SEQ * 8; i += F.G * NTHR) { const int s = i >> 3, k = i & 7;
        const float inv = powf(500000.f, -(float)(2 * k) / 16.f); float sn, cs; sincosf((float)s * inv, &sn, &cs); rot[2 * i] = cs; rot[2 * i + 1] = sn; }
}

__device__ __forceinline__ void p3_attn_unit(Frame& F, int unit, const float* sink) {
    const int tid = F.tid, lane = F.lane, w = F.wave, r = lane & 31, hh = lane >> 5;
    const int b = unit >> 8, kvh = (unit >> 7) & 1, qt = unit & 127, k0 = 64 * qt - 128;
    const bf16* proj = (const bf16*)(F.ws + WS_PROJ); const float* rot = (const float*)(F.ws + WS_ROT);
    LAS bf16* KLs = (LAS bf16*)F.lds;
    LAS bf16* VTs = (LAS bf16*)(F.lds + 40960);
#pragma unroll 1
    for (int idx = tid; idx < 320 * 8; idx += NTHR) {
        const int key = idx >> 3, ch = idx & 7, kp = k0 + key;
        v4u kv = (v4u){0u, 0u, 0u, 0u}, vv = (v4u){0u, 0u, 0u, 0u};
        if (kp >= 0 && kp < SEQ) {
            const bf16* rowp = proj + (size_t)(b * SEQ + kp) * NPROJ;
            vv = *(const GAS v4u*)(rowp + PJ_AV + kvh * 64 + ch * 8);
            if (ch >= 2) kv = *(const GAS v4u*)(rowp + PJ_AK + kvh * 64 + ch * 8);
            else {
                const v4u a = *(const GAS v4u*)(rowp + PJ_AK + kvh * 64), c = *(const GAS v4u*)(rowp + PJ_AK + kvh * 64 + 8);
                const float* rp = rot + (size_t)kp * 16; float o[8];
#pragma unroll
                for (int i = 0; i < 8; ++i) { const unsigned ua = a[i >> 1], uc = c[i >> 1];
                    const float x1 = bf2f((unsigned short)((i & 1) ? (ua >> 16) : (ua & 0xffffu))), x2 = bf2f((unsigned short)((i & 1) ? (uc >> 16) : (uc & 0xffffu)));
                    const float cs = rp[2 * i], sn = rp[2 * i + 1]; o[i] = ch == 0 ? x1 * cs - x2 * sn : x2 * cs + x1 * sn; }
                kv.x = pk2(o[0], o[1]); kv.y = pk2(o[2], o[3]); kv.z = pk2(o[4], o[5]); kv.w = pk2(o[6], o[7]);
            }
        }
        *(LAS v4u*)(KLs + key * 64 + ((ch ^ ((key >> 1) & 7)) << 3)) = kv;
#pragma unroll
        for (int i = 0; i < 8; ++i) { const unsigned u = vv[i >> 1]; VTs[(ch * 8 + i) * VT_PITCH + key] = (bf16)((i & 1) ? (u >> 16) : (u & 0xffffu)); }
    }
    const int hq = kvh * 4 + (w >> 1), qp = 64 * qt + 32 * (w & 1) + r;
    const bf16* qrow = proj + (size_t)(b * SEQ + qp) * NPROJ + PJ_AQ + hq * 64;
    bf16x8 qf[4];
    {
        const v4u a = *(const GAS v4u*)(qrow), c = *(const GAS v4u*)(qrow + 8);
        const float* rp = rot + (size_t)qp * 16; float o[8];
#pragma unroll
        for (int i = 0; i < 8; ++i) { const unsigned ua = a[i >> 1], uc = c[i >> 1];
            const float x1 = bf2f((unsigned short)((i & 1) ? (ua >> 16) : (ua & 0xffffu))), x2 = bf2f((unsigned short)((i & 1) ? (uc >> 16) : (uc & 0xffffu)));
            const float cs = rp[2 * i], sn = rp[2 * i + 1]; o[i] = (hh == 0 ? x1 * cs - x2 * sn : x2 * cs + x1 * sn) * 0.125f; }
        v4u q0; q0.x = pk2(o[0], o[1]); q0.y = pk2(o[2], o[3]); q0.z = pk2(o[4], o[5]); q0.w = pk2(o[6], o[7]);
        qf[0] = __builtin_bit_cast(bf16x8, q0);
#pragma unroll
        for (int s = 1; s < 4; ++s) { const v4u q = *(const GAS v4u*)(qrow + 16 * s + 8 * hh); float t[8];
#pragma unroll
            for (int i = 0; i < 8; ++i) { const unsigned u = q[i >> 1]; t[i] = bf2f((unsigned short)((i & 1) ? (u >> 16) : (u & 0xffffu))) * 0.125f; }
            v4u qq; qq.x = pk2(t[0], t[1]); qq.y = pk2(t[2], t[3]); qq.z = pk2(t[4], t[5]); qq.w = pk2(t[6], t[7]); qf[s] = __builtin_bit_cast(bf16x8, qq); }
    }
    __syncthreads();
    float m = sink[hq], l = hh == 0 ? 1.f : 0.f;
    f32x16 O[2];
#pragma unroll
    for (int i = 0; i < 16; ++i) { O[0][i] = 0.f; O[1][i] = 0.f; }
#pragma unroll 1
    for (int kb = (w & 1); kb < (w & 1) + 9; ++kb) {
        f32x16 X;
#pragma unroll
        for (int i = 0; i < 16; ++i) X[i] = 0.f;
        const int krow = 32 * kb + r;
#pragma unroll
        for (int s = 0; s < 4; ++s) { const bf16x8 ka = *(const LAS bf16x8*)(KLs + krow * 64 + (((2 * s + hh) ^ ((krow >> 1) & 7)) << 3)); X = MFMA32(ka, qf[s], X); }
        float bm = -1e30f;
#pragma unroll
        for (int i = 0; i < 16; ++i) { const int kp = k0 + 32 * kb + (i & 3) + 8 * (i >> 2) + 4 * hh, dlt = qp - kp;
            const bool ok = (dlt <= 128) && (dlt >= -128) && (kp >= 0) && (kp < SEQ); X[i] = ok ? X[i] : -1e30f; bm = fmaxf(bm, X[i]); }
        bm = fmaxf(bm, __shfl_xor(bm, 32));
        const float mn = fmaxf(m, bm), alpha = __expf(m - mn); m = mn;
        float ps = 0.f;
#pragma unroll
        for (int i = 0; i < 16; ++i) { X[i] = __expf(X[i] - mn); ps += X[i]; }
        l = l * alpha + ps;
#pragma unroll
        for (int i = 0; i < 16; ++i) { O[0][i] *= alpha; O[1][i] *= alpha; }
        bf16x8 pk[2];
#pragma unroll
        for (int s = 0; s < 2; ++s) { v4u t; t.x = pk2(X[8 * s], X[8 * s + 1]); t.y = pk2(X[8 * s + 2], X[8 * s + 3]); t.z = pk2(X[8 * s + 4], X[8 * s + 5]); t.w = pk2(X[8 * s + 6], X[8 * s + 7]); pk[s] = __builtin_bit_cast(bf16x8, t); }
#pragma unroll
        for (int dt = 0; dt < 2; ++dt)
#pragma unroll
            for (int s = 0; s < 2; ++s) { const LAS bf16* vp = VTs + (32 * dt + r) * VT_PITCH + 32 * kb + 16 * s + 4 * hh;
                const v2u lo = *(const LAS v2u*)vp, hi = *(const LAS v2u*)(vp + 8); v4u va; va.x = lo.x; va.y = lo.y; va.z = hi.x; va.w = hi.y;
                O[dt] = MFMA32(__builtin_bit_cast(bf16x8, va), pk[s], O[dt]); }
    }
    l += __shfl_xor(l, 32);
    const float inv = 1.f / l;
    bf16* orow = (bf16*)(F.ws + WS_MIX) + (size_t)(b * SEQ + qp) * D + 512 + hq * 64;
#pragma unroll
    for (int dt = 0; dt < 2; ++dt)
#pragma unroll
        for (int g = 0; g < 4; ++g) { v2u o; o.x = pk2(O[dt][4 * g] * inv, O[dt][4 * g + 1] * inv); o.y = pk2(O[dt][4 * g + 2] * inv, O[dt][4 * g + 3] * inv);
            *(GAS v2u*)(orow + 32 * dt + 8 * g + 4 * hh) = o; }
    __syncthreads();
}

__device__ __forceinline__ void p3_moe_weight_items(Frame& F, int first_wave, int n_waves, int end_item, const float* w_gu, const float* w_dn) {
    LAS float* scr = (LAS float*)(F.lds + F.wave * 16384);
    bf16* Wgu_t = (bf16*)(F.ws + WS_WGU); bf16* Wd_t = (bf16*)(F.ws + WS_WD);
    constexpr int I_GU = NEXP * 16 * 16, I_DN = NEXP * 4 * 32;
#pragma unroll 1
    for (int it = first_wave; it < end_item; it += n_waves) {
        if (it < I_GU) { const int e = it >> 8, kb = (it >> 4) & 15, nb = it & 15, n0 = 32 * nb, pn = n0 >> 8, bj = (n0 >> 7) & 1, c = n0 & 127;
            transpose_item(w_gu + (size_t)e * D * 512, 512, bj * 256 + pn * 128 + c, 64 * kb, Wgu_t + (size_t)e * 512 * D, D, n0, scr, F.lane); }
        else { const int r2 = it - I_GU, e = r2 >> 7, kb = (r2 >> 5) & 3, nb = r2 & 31; transpose_item(w_dn + (size_t)e * EFF * D, D, 32 * nb, 64 * kb, Wd_t + (size_t)e * D * EFF, EFF, 32 * nb, scr, F.lane); }
    }
}

__device__ __forceinline__ void p4_combine(Frame& F, const float* odir, const float* normw) {
    const int gw = F.vcu * NWAVES + F.wave, NGW = F.G * NWAVES, lane = F.lane;
    const bf16* proj = (const bf16*)(F.ws + WS_PROJ); bf16* mix = (bf16*)(F.ws + WS_MIX);
    const f32x4 nw0 = *(const f32x4*)(normw + 8 * (lane & 15)), nw1 = *(const f32x4*)(normw + 8 * (lane & 15) + 4);
#pragma unroll 1
    for (int tok = gw; tok < T; tok += NGW) {
        const float* of = odir + (size_t)tok * 512 + 8 * lane; const float* ob = of + (size_t)T * 512;
        const f32x4 a0 = *(const GAS f32x4*)of + *(const GAS f32x4*)ob, a1 = *(const GAS f32x4*)(of + 4) + *(const GAS f32x4*)(ob + 4);
        float s = (a0.x * a0.x + a0.y * a0.y) + (a0.z * a0.z + a0.w * a0.w) + (a1.x * a1.x + a1.y * a1.y) + (a1.z * a1.z + a1.w * a1.w);
        s += __shfl_xor(s, 1); s += __shfl_xor(s, 2); s += __shfl_xor(s, 4); s += __shfl_xor(s, 8);
        const float rs = rsqrtf(s * (1.f / 128.f) + EPS);
        const v4u zz = *(const GAS v4u*)(proj + (size_t)tok * NPROJ + PJ_Z + 8 * lane);
        float z[8];
#pragma unroll
        for (int i = 0; i < 8; ++i) { const unsigned u = zz[i >> 1]; z[i] = bf2f((unsigned short)((i & 1) ? (u >> 16) : (u & 0xffffu))); }
        v4u o;
        o.x = pk2(a0.x * rs * nw0.x * silu_f(z[0]), a0.y * rs * nw0.y * silu_f(z[1])); o.y = pk2(a0.z * rs * nw0.z * silu_f(z[2]), a0.w * rs * nw0.w * silu_f(z[3]));
        o.z = pk2(a1.x * rs * nw1.x * silu_f(z[4]), a1.y * rs * nw1.y * silu_f(z[5])); o.w = pk2(a1.z * rs * nw1.z * silu_f(z[6]), a1.w * rs * nw1.w * silu_f(z[7]));
        *(GAS v4u*)(mix + (size_t)tok * D + 8 * lane) = o;
    }
}
constexpr size_t WS_RW = 488 * MiB;
constexpr size_t RW_HI = WS_RW, RW_LO = WS_RW + 256 * 1024, RW_RSTD = WS_RW + 512 * 1024, RW_GATE = WS_RW + 640 * 1024;
constexpr size_t WS_LIST = WS_MISC + 2 * MiB;
constexpr size_t WS_XS = WS_DN, WS_HMID = WS_DN + 96 * MiB, WS_Y2 = WS_DN + 120 * MiB;
constexpr int CW_CNT = 32768;
constexpr int LT_PSTART = LDSCTL_OFF + 1024, LT_PTAB = LDSCTL_OFF + 1536;

__device__ __forceinline__ void p0_router_weights(Frame& F, const float* lnw, const float* wg, const float* we) {
    bf16* hi = (bf16*)(F.ws + RW_HI); bf16* lo = (bf16*)(F.ws + RW_LO);
    for (int i = F.vcu * NTHR + F.tid; i < 80 * D; i += F.G * NTHR) { const int n = i >> 10, k = i & 1023;
        float v = 0.f; if (n < 8) v = wg[k * 8 + n] * lnw[k]; else if (n < 72) v = we[k * 64 + (n - 8)] * lnw[k];
        const unsigned h = f2bf(v); const float r = v - bf2f((unsigned short)h); hi[i] = (bf16)h; lo[i] = (bf16)f2bf(r); }
}
__device__ __forceinline__ void split8(const f32x4 a, const f32x4 b, bf16x8& h, bf16x8& l) {
    const float x[8] = {a.x, a.y, a.z, a.w, b.x, b.y, b.z, b.w}; unsigned hh[8], ll[8];
#pragma unroll
    for (int i = 0; i < 8; ++i) { hh[i] = f2bf(x[i]); ll[i] = f2bf(x[i] - bf2f((unsigned short)hh[i])); }
    v4u vh, vl; vh.x = hh[0] | (hh[1] << 16); vh.y = hh[2] | (hh[3] << 16); vh.z = hh[4] | (hh[5] << 16); vh.w = hh[6] | (hh[7] << 16);
    vl.x = ll[0] | (ll[1] << 16); vl.y = ll[2] | (ll[3] << 16); vl.z = ll[4] | (ll[5] << 16); vl.w = ll[6] | (ll[7] << 16);
    h = __builtin_bit_cast(bf16x8, vh); l = __builtin_bit_cast(bf16x8, vl);
}
__device__ __forceinline__ void p6_route(Frame& F, const float* lnw, const float* bgrp, const float* bexp, int dry) {
    const int lane = F.lane, w = F.wave, fr = lane & 15, fq = lane >> 4;
    const float* x1 = F.out; bf16* h2u = (bf16*)(F.ws + WS_HN);
    const bf16* Wh = (const bf16*)(F.ws + RW_HI); const bf16* Wl = (const bf16*)(F.ws + RW_LO);
    LAS float* PL = (LAS float*)F.lds;
    LAS float* PS = PL + 8 * 32 * 80;
    LAS float* LG = PS + 8 * 32;
    LAS float* RS = LG + 32 * 80;
    LAS int* LC = (LAS int*)(RS + 32);
    LAS int* PK = LC + 64;
    unsigned* cnt = (unsigned*)(F.ctl + CW_CNT + (dry ? 24576 : 0)); int* list = (int*)(F.ws + (dry ? WS_DN + 196 * MiB : WS_LIST)); float* pgate = (float*)(F.ws + RW_GATE); float* rstd_g = (float*)(F.ws + RW_RSTD);
#pragma unroll 1
    for (int grp = blockIdx.x; grp < T / 64; grp += F.G) {
        if (F.tid < 64) LC[F.tid] = 0;
        f32x4 acc[4][5]; float ss[4];
#pragma unroll
        for (int tl = 0; tl < 4; ++tl) { ss[tl] = 0.f;
#pragma unroll
            for (int c = 0; c < 5; ++c) acc[tl][c] = (f32x4){0.f, 0.f, 0.f, 0.f}; }
#pragma unroll 1
        for (int kk = 0; kk < 4; ++kk) {
            const int k0 = 32 * (4 * w + kk) + 8 * fq;
            bf16x8 bh[5], bl[5];
#pragma unroll
            for (int c = 0; c < 5; ++c) { bh[c] = *(const GAS bf16x8*)(Wh + (size_t)(16 * c + fr) * D + k0); bl[c] = *(const GAS bf16x8*)(Wl + (size_t)(16 * c + fr) * D + k0); }
            const f32x4 la = *(const f32x4*)(lnw + k0), lb = *(const f32x4*)(lnw + k0 + 4);
#pragma unroll
            for (int tl = 0; tl < 4; ++tl) {
                const int tok = (grp * 4 + tl) * 16 + fr;
                const f32x4 xa = *(const GAS f32x4*)(x1 + (size_t)tok * D + k0), xb = *(const GAS f32x4*)(x1 + (size_t)tok * D + k0 + 4);
                ss[tl] += (xa.x * xa.x + xa.y * xa.y) + (xa.z * xa.z + xa.w * xa.w) + (xb.x * xb.x + xb.y * xb.y) + (xb.z * xb.z + xb.w * xb.w);
                v4u ho; ho.x = pk2(xa.x * la.x, xa.y * la.y); ho.y = pk2(xa.z * la.z, xa.w * la.w); ho.z = pk2(xb.x * lb.x, xb.y * lb.y); ho.w = pk2(xb.z * lb.z, xb.w * lb.w);
                *(GAS v4u*)(h2u + (size_t)tok * D + k0) = ho;
                bf16x8 ah, al; split8(xa, xb, ah, al);
#pragma unroll
                for (int c = 0; c < 5; ++c) { acc[tl][c] = MFMA16(ah, bh[c], acc[tl][c]); acc[tl][c] = MFMA16(al, bh[c], acc[tl][c]); acc[tl][c] = MFMA16(ah, bl[c], acc[tl][c]); }
            }
        }
#pragma unroll
        for (int tl = 0; tl < 4; ++tl) { ss[tl] += __shfl_xor(ss[tl], 16); ss[tl] += __shfl_xor(ss[tl], 32); }
#pragma unroll
        for (int rd = 0; rd < 2; ++rd) {
#pragma unroll
            for (int t2 = 0; t2 < 2; ++t2) { const int tl = 2 * rd + t2;
#pragma unroll
                for (int c = 0; c < 5; ++c)
#pragma unroll
                    for (int r = 0; r < 4; ++r) PL[(w * 32 + t2 * 16 + 4 * fq + r) * 80 + 16 * c + fr] = acc[tl][c][r];
                if (lane < 16) PS[w * 32 + t2 * 16 + lane] = ss[tl]; }
            __syncthreads();
            for (int i = F.tid; i < 32 * 80; i += NTHR) { float s = 0.f;
#pragma unroll
                for (int ww = 0; ww < 8; ++ww) s += PL[ww * 2560 + i];
                LG[i] = s; }
            if (F.tid < 32) { float s = 0.f;
#pragma unroll
                for (int ww = 0; ww < 8; ++ww) s += PS[ww * 32 + F.tid];
                RS[F.tid] = rsqrtf(s * (1.f / D) + EPS); }
            __syncthreads();
            if (F.tid < 32) {
                const LAS float* lg = LG + F.tid * 80; const float rs = RS[F.tid];
                float gl[8]; int gi = 0; float gm = -1e30f;
#pragma unroll
                for (int g = 0; g < 8; ++g) { gl[g] = lg[g] * rs + bgrp[g]; if (gl[g] > gm) { gm = gl[g]; gi = g; } }
                float gs = 0.f;
#pragma unroll
                for (int g = 0; g < 8; ++g) gs += expf(gl[g] - gm);
                const float pg = 1.f / gs;
                float el[8]; int e1 = 0; float m1 = -1e30f;
#pragma unroll
                for (int e = 0; e < 8; ++e) { el[e] = lg[8 + gi * 8 + e] * rs + bexp[gi * 8 + e]; if (el[e] > m1) { m1 = el[e]; e1 = e; } }
                int e2 = 0; float m2 = -1e30f;
#pragma unroll
                for (int e = 0; e < 8; ++e) if (e != e1 && el[e] > m2) { m2 = el[e]; e2 = e; }
                const float p2 = expf(m2 - m1), inv = 1.f / (1.f + p2);
                const int E1 = gi * 8 + e1, E2 = gi * 8 + e2, lt = 32 * rd + F.tid, tk = grp * 64 + lt;
                const int r1 = __hip_atomic_fetch_add(LC + E1, 1, __ATOMIC_RELAXED, __HIP_MEMORY_SCOPE_WORKGROUP), r2 = __hip_atomic_fetch_add(LC + E2, 1, __ATOMIC_RELAXED, __HIP_MEMORY_SCOPE_WORKGROUP);
                PK[lt * 4] = E1; PK[lt * 4 + 1] = E2; PK[lt * 4 + 2] = r1; PK[lt * 4 + 3] = r2;
                pgate[tk * 2] = pg * inv; pgate[tk * 2 + 1] = pg * p2 * inv; rstd_g[tk] = rs;
            }
            __syncthreads();
        }
        if (F.tid < 64) { const int n = LC[F.tid]; LC[F.tid] = n ? (int)atomicAdd(cnt + 64 * F.tid, (unsigned)n) : 0; }
        __syncthreads();
        if (F.tid < 64) { const int E1 = PK[F.tid * 4], E2 = PK[F.tid * 4 + 1], tk = grp * 64 + F.tid;
            list[E1 * 16384 + LC[E1] + PK[F.tid * 4 + 2]] = tk * 2; list[E2 * 16384 + LC[E2] + PK[F.tid * 4 + 3]] = tk * 2 + 1; }
        __syncthreads();
    }
}
__device__ __forceinline__ int moe_tables(Frame& F) {
    LAS int* pstart = (LAS int*)(F.lds + LT_PSTART); LAS int* ptab = (LAS int*)(F.lds + LT_PTAB);
    if (F.tid < 64) { const int c = (int)__hip_atomic_load((unsigned*)(F.ctl + CW_CNT) + 64 * F.tid, RLX_AGENT); const int np = (c + 255) >> 8; int ps = np;
#pragma unroll
        for (int o = 1; o < 64; o <<= 1) { const int t = __shfl_up(ps, o); if (F.lane >= o) ps += t; }
        const int st = ps - np; pstart[F.tid] = st; if (F.tid == 63) pstart[64] = ps;
        for (int j = 0; j < np; ++j) ptab[st + j] = F.tid | (j << 8); }
    __syncthreads();
    return pstart[64];
}
__device__ __forceinline__ void p7_gather(Frame& F, int NP) {
    const LAS int* ptab = (const LAS int*)(F.lds + LT_PTAB);
    const int gw = F.vcu * NWAVES + F.wave, NGW = F.G * NWAVES, lane = F.lane;
    const bf16* h2u = (const bf16*)(F.ws + WS_HN); bf16* xs = (bf16*)(F.ws + WS_XS); const int* list = (const int*)(F.ws + WS_LIST);
    const unsigned* cnt = (const unsigned*)(F.ctl + CW_CNT);
#pragma unroll 1
    for (int rid = gw; rid < NP * 256; rid += NGW) { const int pt = ptab[rid >> 8], e = pt & 255, local = (pt >> 8) * 256 + (rid & 255);
        if (local < (int)cnt[64 * e]) { const int tok = list[e * 16384 + local] >> 1;
            const GAS v4u* src = (const GAS v4u*)(h2u + (size_t)tok * D); GAS v4u* dst = (GAS v4u*)(xs + (size_t)rid * D);
            const v4u a = src[lane], b = src[lane + 64]; dst[lane] = a; dst[lane + 64] = b; } }
}
template <bool GATHER_>
struct MoeOrderT {
    static constexpr bool GATHER = GATHER_;
    int nunits, G, c, SH; const LAS int* ptab; const int* list; const unsigned* cnt; unsigned rowbytes;
    __device__ __forceinline__ unsigned row_off(const pg8::Unit& u, int r) const {
        const int pt = ptab[u.pm], e = pt & 255, local = (pt >> 8) * 256 + r;
        return local < (int)cnt[64 * e] ? (unsigned)(list[e * 16384 + local] >> 1) * rowbytes : 0u; }
    __device__ __forceinline__ bool next(int i, pg8::Unit& u) const { const int L = i * G + c; if (L >= nunits) return false; const int p = L >> SH; u.pm = p; u.pn = ((ptab[p] & 255) << SH) + (L & ((1 << SH) - 1)); return true; }
    __device__ __forceinline__ void a_ready(const pg8::Unit&) const {}
    __device__ __forceinline__ void done(const pg8::Unit&) const {}
};
typedef MoeOrderT<false> MoeOrder; typedef MoeOrderT<true> MoeGatherOrder;
struct EpiSwiGLU {
    static constexpr bool PERM = true, AFTER_DRAIN = false;
    bf16* hmid; const int* list; const unsigned* cnt; const float* rstd; const LAS int* ptab;
    __device__ __forceinline__ void operator()(const pg8::f32x4 (&acc)[2][2][4][2], const pg8::Unit& u, int wr, int wc, int fr, int fq) const {
        const int pt = ptab[u.pm], e = pt & 255, lbase = (pt >> 8) * 256, n_e = (int)cnt[64 * e], pnl = u.pn & 1;
#pragma unroll
        for (int ai = 0; ai < 2; ++ai)
#pragma unroll
            for (int m = 0; m < 4; ++m) { const int rl = ai * 128 + wr * 64 + m * 16 + fr;
                if (lbase + rl < n_e) { const float rs = rstd[list[e * 16384 + lbase + rl] >> 1];
                    float h[8];
#pragma unroll
                    for (int n = 0; n < 2; ++n)
#pragma unroll
                        for (int k = 0; k < 4; ++k) h[4 * n + k] = silu_f(acc[ai][0][m][n][k] * rs) * (acc[ai][1][m][n][k] * rs);
                    v4u o; o.x = pk2(h[0], h[1]); o.y = pk2(h[2], h[3]); o.z = pk2(h[4], h[5]); o.w = pk2(h[6], h[7]);
                    *(GAS v4u*)(hmid + (size_t)(u.pm * 256 + rl) * EFF + pnl * 128 + wc * 32 + 8 * fq) = o; } }
    }
};
struct EpiDown {
    static constexpr bool PERM = true, AFTER_DRAIN = false;
    bf16* y2; const int* list; const unsigned* cnt; const float* gate; const LAS int* ptab;
    __device__ __forceinline__ void operator()(const pg8::f32x4 (&acc)[2][2][4][2], const pg8::Unit& u, int wr, int wc, int fr, int fq) const {
        const int pt = ptab[u.pm], e = pt & 255, lbase = (pt >> 8) * 256, n_e = (int)cnt[64 * e], pnl = u.pn & 3;
#pragma unroll
        for (int ai = 0; ai < 2; ++ai)
#pragma unroll
            for (int m = 0; m < 4; ++m) { const int rl = ai * 128 + wr * 64 + m * 16 + fr;
                if (lbase + rl < n_e) { const int pair = list[e * 16384 + lbase + rl]; const float g = gate[pair];
#pragma unroll
                    for (int bj = 0; bj < 2; ++bj) { const pg8::f32x4 v0 = acc[ai][bj][m][0] * g, v1 = acc[ai][bj][m][1] * g;
                        v4u o; o.x = pk2(v0[0], v0[1]); o.y = pk2(v0[2], v0[3]); o.z = pk2(v1[0], v1[1]); o.w = pk2(v1[2], v1[3]);
                        *(GAS v4u*)(y2 + (size_t)pair * D + pnl * 256 + bj * 128 + wc * 32 + 8 * fq) = o; } } }
    }
};
__device__ __forceinline__ void p10_final(Frame& F, const float* lnw, float* dst) {
    const int gw = F.vcu * NWAVES + F.wave, NGW = F.G * NWAVES, lane = F.lane;
    const bf16* y2 = (const bf16*)(F.ws + WS_Y2);
    f32x4 lw[4];
#pragma unroll
    for (int j = 0; j < 4; ++j) lw[j] = ((const f32x4*)lnw)[lane + 64 * j];
#pragma unroll 1
    for (int tok = gw; tok < T; tok += NGW) {
        GAS f32x4* xr = (GAS f32x4*)(F.out + (size_t)tok * D) + lane;
        const GAS v2u* ya = (const GAS v2u*)(y2 + (size_t)(2 * tok) * D) + lane; const GAS v2u* yb = (const GAS v2u*)(y2 + (size_t)(2 * tok + 1) * D) + lane;
        f32x4 v[4]; float s = 0.f;
#pragma unroll
        for (int j = 0; j < 4; ++j) { const f32x4 x = xr[64 * j]; const v2u a = ya[64 * j], b = yb[64 * j];
            v[j].x = x.x + (bf2f((unsigned short)(a.x & 0xffffu)) + bf2f((unsigned short)(b.x & 0xffffu))); v[j].y = x.y + (bf2f((unsigned short)(a.x >> 16)) + bf2f((unsigned short)(b.x >> 16)));
            v[j].z = x.z + (bf2f((unsigned short)(a.y & 0xffffu)) + bf2f((unsigned short)(b.y & 0xffffu))); v[j].w = x.w + (bf2f((unsigned short)(a.y >> 16)) + bf2f((unsigned short)(b.y >> 16)));
            s += (v[j].x * v[j].x + v[j].y * v[j].y) + (v[j].z * v[j].z + v[j].w * v[j].w); }
        const float r = rsqrtf(wave_sum(s) * (1.f / D) + EPS);
        GAS f32x4* xo = (GAS f32x4*)(dst + (size_t)tok * D) + lane;
#pragma unroll
        for (int j = 0; j < 4; ++j) xo[64 * j] = v[j] * r * lw[j];
    }
}
struct EpiResF32 {
    static constexpr bool PERM = false, AFTER_DRAIN = false;
    const float* base; float* out; int ldc;
    __device__ __forceinline__ void operator()(const pg8::f32x4 (&acc)[2][2][4][2], const pg8::Unit& u, int wr, int wc, int fr, int fq) const {
        const int col0 = u.pn * 256 + wc * 32 + 4 * fq;
#pragma unroll
        for (int ai = 0; ai < 2; ++ai)
#pragma unroll
            for (int m = 0; m < 4; ++m) { const size_t off = (size_t)(u.pm * 256 + ai * 128 + wr * 64 + m * 16 + fr) * ldc + col0;
#pragma unroll
                for (int bj = 0; bj < 2; ++bj)
#pragma unroll
                    for (int n = 0; n < 2; ++n) { const pg8::f32x4 bs = *(const pg8::f32x4*)(base + off + bj * 128 + n * 16); *(pg8::f32x4*)(out + off + bj * 128 + n * 16) = bs + acc[ai][bj][m][n]; }
                if (m & 1) asm volatile("" ::: "memory"); }
    }
};
struct Args { const float* in[17]; float* out; unsigned char* ws; int ph_lo, ph_hi, li, pad; };
__global__ void __launch_bounds__(NTHR, 2) mk_fwd(Args args) {
    extern __shared__ __attribute__((aligned(16))) unsigned char lds[];
    Frame F;
    F.lds = (LAS unsigned char*)lds;
    F.MISC = (volatile LAS unsigned*)(F.lds + MISC_OFF);
    F.tid = threadIdx.x; F.lane = F.tid & 63; F.wave = __builtin_amdgcn_readfirstlane(F.tid >> 6);
    F.G = gridDim.x; { const int bx = blockIdx.x; F.vcu = (F.G % 8 == 0) ? (bx % 8) * (F.G / 8) + bx / 8 : bx; }
    F.ws = args.ws; F.out = args.out; F.li = args.li; F.ctl = (gu32*)(args.ws + WS_CTL);
    for (int u = F.tid; u < (LDS_BYTES - LDSCTL_OFF) / 4; u += NTHR) ((LAS unsigned*)(F.lds + LDSCTL_OFF))[u] = 0u;
    __syncthreads();
    XcdBarrier bar = xcd_barrier_post((unsigned*)(F.ctl + CW_BAR) + args.li * XCD_BAR_WORDS, F.MISC + 8);
    const int lo = args.ph_lo, hi = args.ph_hi;
#define IN(k) (lo <= (k) && (k) < hi)
#define BOTH(k) (IN(k) && IN((k) + 1))
#define GRID_BAR() xcd_barrier(bar)
#define PHASE_BEGIN() do { int t_ = threadIdx.x; asm volatile("" : "+v"(t_)); F.tid = t_; F.lane = t_ & 63; } while (0)
    if (IN(0)) { PHASE_BEGIN(); p0_prologue(F, args.in[I_X], args.in[I_LNMIX], args.in[I_WIN], args.in[I_WOUT], args.in[I_ALOG], args.in[I_DTB]); p0_rot_table(F); p0_router_weights(F, args.in[I_LNFFN], args.in[I_WG], args.in[I_WE]); if (BOTH(0)) GRID_BAR(); }
    if (IN(1)) { PHASE_BEGIN();
        pg8::Gemm g{(const bf16*)(F.ws + WS_HN), (const bf16*)(F.ws + WS_WIN), T, NPROJ, D}; pg8::StaticOrder S; S.init(T, NPROJ, F.G, (int)blockIdx.x);
        pg8::EpiBf16<0> E{(bf16*)(F.ws + WS_PROJ), NPROJ, nullptr, 0, 0, 1.f};
        pg8::gemm_phase<pg8::EpiBf16<0>, pg8::StaticOrder, true, true>(F.lds, g, S, E);
        if (BOTH(1)) GRID_BAR();
    }
    if (IN(2)) { PHASE_BEGIN();
#pragma unroll 1
        for (int grp = blockIdx.x; grp < 256; grp += F.G) p2_group(F, grp, args.in[I_CONV], (const float*)(F.ws + WS_BG));
        if (BOTH(2)) GRID_BAR();
    }
    if (IN(3) || IN(17) || IN(18) || IN(19)) { PHASE_BEGIN(); const int skipq = IN(17) ? 1 : IN(18) ? 3 : IN(19) ? 4 : 0;
        const int x = blockIdx.x;
        if (x < 64 && !(skipq & 4)) p3_scan(F, (x & 7) + 8 * (x >> 5), (x >> 3) & 3, 0);
        {
            LAS int* wq = (LAS int*)(F.lds + LT_WQ);
#pragma unroll 1
            for (;;) {
                if (F.tid == 0) *wq = (int)atomicAdd((unsigned*)(F.ctl + CW_WQ + 64 * F.li), 1u);
                __syncthreads();
                const int it = *wq;
                __syncthreads();
                if (it >= ((skipq & 4) ? 512 + 384 : 512 + 384 + 480 + 256)) break;
                if (it < 384) { if (!(skipq & 1)) p3_moe_weight_items(F, it * 64 + F.wave, NWAVES, it * 64 + 64, args.in[I_WGU], args.in[I_WD]); }
                else if (it < 384 + 512) { if (!(skipq & 2)) p3_attn_unit(F, it - 384, args.in[I_SINK]); }
                else { const int ob = it - (512 + 384); if (ob < 480) p3_out_batch(F, ob * 8, 8, F.out); else p3_out_batch(F, 3840 + (ob - 480), 1, F.out); }
            }
        }
        if (BOTH(3)) GRID_BAR();
    }
    if (IN(4)) { PHASE_BEGIN(); p4_combine(F, F.out, args.in[I_DNNORM]); if (BOTH(4)) GRID_BAR(); }
    if (IN(5)) { PHASE_BEGIN();
        pg8::Gemm g{(const bf16*)(F.ws + WS_MIX), (const bf16*)(F.ws + WS_WOUT), T, D, D}; pg8::StaticOrder S; S.init(T, D, F.G, (int)blockIdx.x);
        EpiResF32 E{args.in[I_X], F.out, D};
        pg8::gemm_phase<EpiResF32, pg8::StaticOrder, true, true>(F.lds, g, S, E);
        if (BOTH(5)) GRID_BAR();
    }
    if (IN(6) || IN(12)) { PHASE_BEGIN(); p6_route(F, args.in[I_LNFFN], args.in[I_BG], args.in[I_BE], IN(12) ? 1 : 0); if (BOTH(6)) GRID_BAR(); }
    if (IN(8)) { PHASE_BEGIN();
        const int NP = moe_tables(F);
        pg8::Gemm g{(const bf16*)(F.ws + WS_HN), (const bf16*)(F.ws + WS_WGU), NP * 256, NEXP * 512, D};
        MoeGatherOrder S{NP * 2, F.G, (int)blockIdx.x, 1, (const LAS int*)(F.lds + LT_PTAB), (const int*)(F.ws + WS_LIST), (const unsigned*)(F.ctl + CW_CNT), (unsigned)(D * 2)};
        EpiSwiGLU E{(bf16*)(F.ws + WS_HMID), (const int*)(F.ws + WS_LIST), (const unsigned*)(F.ctl + CW_CNT), (const float*)(F.ws + RW_RSTD), (const LAS int*)(F.lds + LT_PTAB)};
        pg8::gemm_phase<EpiSwiGLU, MoeGatherOrder, true, true>(F.lds, g, S, E);
        if (BOTH(8)) GRID_BAR();
    }
    if (IN(9)) { PHASE_BEGIN();
        const int NP = moe_tables(F);
        pg8::Gemm g{(const bf16*)(F.ws + WS_HMID), (const bf16*)(F.ws + WS_WD), NP * 256, NEXP * D, EFF};
        MoeOrder S{NP * 4, F.G, (int)blockIdx.x, 2, (const LAS int*)(F.lds + LT_PTAB), nullptr, nullptr, 0u};
        EpiDown E{(bf16*)(F.ws + WS_Y2), (const int*)(F.ws + WS_LIST), (const unsigned*)(F.ctl + CW_CNT), (const float*)(F.ws + RW_GATE), (const LAS int*)(F.lds + LT_PTAB)};
        pg8::gemm_phase<EpiDown, MoeOrder, true, true>(F.lds, g, S, E);
        if (BOTH(9)) GRID_BAR();
    }
#ifdef PROBE_PHASES
    if (IN(11) || IN(14) || IN(15) || IN(16)) { PHASE_BEGIN(); const int x = blockIdx.x; if (x < 64) p3_scan(F, (x & 7) + 8 * (x >> 5), (x >> 3) & 3, IN(14) ? 1 : IN(15) ? 3 : IN(16) ? 2 : 0); }
#endif
    if (IN(10) || IN(13)) { PHASE_BEGIN(); p10_final(F, args.in[I_LNF], IN(13) ? (float*)(F.ws + WS_PROJ) : F.out); }
#undef IN
#undef BOTH
}

__global__ void k_shim_proj(const bf16* __restrict__ pb, float* __restrict__ pf) {
    const size_t i = (size_t)blockIdx.x * blockDim.x + threadIdx.x; if (i >= (size_t)T * NPROJ) return;
    const int tok = (int)(i / NPROJ), c = (int)(i % NPROJ);
    pf[(size_t)tok * INW + (c < 2048 ? c : c + 16)] = bf2f(pb[i]);
}
}

extern "C" void kernel_launch(void* const* d_in, const int* in_sizes, int n_in, void* d_out, int out_size, void* d_ws, size_t ws_size, hipStream_t stream) {
    using namespace mk;
    static int grid = 0;
    if (grid == 0) {
        if (n_in != 17 || out_size != T * D || ws_size < 511 * MiB) { fprintf(stderr, "kernel_launch: unexpected sizes (n_in %d out %d ws %zu)\n", n_in, out_size, ws_size); grid = -1; return; }
        int dev = 0, cus = 0, per_cu = 0;
        if (hipGetDevice(&dev) != hipSuccess || hipDeviceGetAttribute(&cus, hipDeviceAttributeMultiprocessorCount, dev) != hipSuccess) { grid = -1; return; }
        if (hipFuncSetAttribute((const void*)mk_fwd, hipFuncAttributeMaxDynamicSharedMemorySize, LDS_BYTES) != hipSuccess) { fprintf(stderr, "kernel_launch: hipFuncSetAttribute failed\n"); grid = -1; return; }
        if (hipOccupancyMaxActiveBlocksPerMultiprocessor(&per_cu, (const void*)mk_fwd, NTHR, LDS_BYTES) != hipSuccess || per_cu < 1) { fprintf(stderr, "kernel_launch: occupancy query says %d blocks/CU\n", per_cu); grid = -1; (void)hipGetLastError(); return; }
        grid = cus;
    }
    if (grid < 0) return;
    (void)hipMemsetAsync((char*)d_ws + WS_CTL, 0, CTL_ZERO_BYTES, stream);
    Args a{};
    for (int i = 0; i < 17; ++i) a.in[i] = (const float*)d_in[i];
    a.out = (float*)d_out; a.ws = (unsigned char*)d_ws; a.pad = 0;
#ifndef LAUNCH_PLAN
#define LAUNCH_PLAN {0, 11}
#endif
    const int plan[] = LAUNCH_PLAN; const int nl = (int)(sizeof(plan) / sizeof(int)) / 2;
    for (int li = 0; li < nl; ++li) {
        a.ph_lo = plan[2 * li]; a.ph_hi = plan[2 * li + 1]; a.li = li;
        void* kargs[] = {&a};
        hipError_t e = hipLaunchCooperativeKernel((const void*)mk_fwd, dim3(grid), dim3(NTHR), kargs, LDS_BYTES, stream);
        if (e != hipSuccess) { fprintf(stderr, "cooperative launch failed: %s (grid %d)\n", hipGetErrorString(e), grid); return; }
    }
}
```

```cpp
#include <hip/hip_runtime.h>
#include <cstdint>
#include <cstdio>
namespace pg8 {
#define PG8_LAS __attribute__((address_space(3)))
typedef unsigned short bf16_t;
typedef short bf16x8 __attribute__((ext_vector_type(8)));
typedef float f32x4 __attribute__((ext_vector_type(4)));
typedef unsigned u32x4 __attribute__((ext_vector_type(4)));
constexpr int BM = 256, BK = 64, HALF = 128, HTB = HALF * BK * 2  , STAGE_BYTES = 8 * HTB, NXCD = 8, WGM = 8;

__host__ __device__ __forceinline__ int lds_byte(int r, int c) { const int st = (r >> 4) * 2 + (c >> 5), rr = r & 15, cc = c & 31, ob = rr * 64 + cc * 2; return st * 1024 + (ob ^ (((ob >> 9) & 1) << 5)); }
__host__ __device__ __forceinline__ void stage_rc(int b, int& R, int& C) { const int st = b / 1024, sb = b % 1024, swz = sb ^ (((sb >> 9) & 1) << 5); R = (st >> 1) * 16 + swz / 64; C = (st & 1) * 32 + (swz % 64) / 2; }
__host__ __device__ __forceinline__ int perm32(int rho) { const int n = rho >> 4, i = rho & 15; return 8 * (i >> 2) + 4 * n + (i & 3); }

struct Unit { int pm, pn; };
struct Gemm { const bf16_t* A; const bf16_t* Bt; int M, N, K; };

struct StaticOrder {
    static constexpr bool GATHER = false;
    int nM, nN, nwg, G, c;
    __device__ __forceinline__ unsigned row_off(const Unit&, int) const { return 0u; }
    __host__ __device__ void init(int M, int N, int G_, int c_) { nM = M / BM; nN = N / BM; nwg = nM * nN; G = G_; c = c_; }
    __host__ __device__ bool next(int i, Unit& u) const {
        const long L = (long)i * G + c; if (L >= nwg) return false;
        int wgid = (int)L; { const int q = nwg / NXCD, r = nwg % NXCD, xcd = wgid % NXCD, off = wgid / NXCD; wgid = (xcd < r ? xcd * (q + 1) : r * (q + 1) + (xcd - r) * q) + off; }
        const int nig = WGM * nN, gid = wgid / nig, fm = gid * WGM, gsz = (nM - fm) < WGM ? (nM - fm) : WGM;
        u.pm = fm + ((wgid % nig) % gsz); u.pn = (wgid % nig) / gsz; return true;
    }
    __device__ __forceinline__ void a_ready(const Unit&) const {}
    __device__ __forceinline__ void done(const Unit&) const {}
};

__device__ __forceinline__ unsigned cvt_pk_bf16(float lo, float hi) { unsigned r; asm volatile("v_cvt_pk_bf16_f32 %0, %1, %2" : "=v"(r) : "v"(lo), "v"(hi)); return r; }
typedef float f32x2 __attribute__((ext_vector_type(2)));
__device__ __forceinline__ f32x2 gelu_pk(f32x2 v) {
    const f32x2 av = __builtin_elementwise_abs(v), d = av * 0.2316418882f + 1.0f;
    f32x2 t; t.x = __builtin_amdgcn_rcpf(d.x); t.y = __builtin_amdgcn_rcpf(d.y);
    f32x2 q = t * 0.5307027145f + (-0.7265760135f); q = q * t + 0.7107068705f; q = q * t + (-0.142248368f); q = q * t + 0.127414796f; q = q * t;
    const f32x2 s = (v * v) * (-0.72134752044f);
    f32x2 e; e.x = __builtin_amdgcn_exp2f(s.x); e.y = __builtin_amdgcn_exp2f(s.y);
    const f32x2 m = v * (q * e), r = v - m;
    f32x2 o; o.x = v.x < 0.f ? m.x : r.x; o.y = v.y < 0.f ? m.y : r.y; return o;
}

template <int ACT  > struct EpiBf16 {
    static constexpr bool PERM = true, AFTER_DRAIN = false; static_assert(ACT == 0 || ACT == 1, "EpiBf16: ACT is 0 (none) or 1 (gelu_pk)");
    bf16_t* O; int ldc; const float* bias; int split_cols; size_t split_stride; float scale0;
    __device__ __forceinline__ void operator()(const f32x4 (&acc)[2][2][4][2], const Unit& u, int wr, int wc, int fr, int fq) const {
        const int row0 = u.pm * BM + wr * 64 + fr; int colt = u.pn * BM; bf16_t* base = O;
        float sc = 1.f; if (split_cols) { const int t = colt / split_cols; base += (size_t)t * split_stride; colt -= t * split_cols; if (t == 0) sc = scale0; }
        const int col0 = colt + wc * 32 + 8 * fq, bcol0 = u.pn * BM + wc * 32 + 8 * fq;
        f32x4 bv[2][2];
#pragma unroll
        for (int bj = 0; bj < 2; ++bj)
#pragma unroll
            for (int n = 0; n < 2; ++n) bv[bj][n] = bias ? *(const f32x4*)(bias + bcol0 + bj * HALF + 4 * n) : (f32x4){0.f, 0.f, 0.f, 0.f};
#pragma unroll
        for (int ai = 0; ai < 2; ++ai)
#pragma unroll
            for (int m = 0; m < 4; ++m) { bf16_t* rowp = base + (size_t)(row0 + ai * HALF + m * 16) * ldc + col0;
#pragma unroll
                for (int bj = 0; bj < 2; ++bj) { f32x4 v0 = acc[ai][bj][m][0] + bv[bj][0], v1 = acc[ai][bj][m][1] + bv[bj][1];
                    if (ACT == 1) { f32x2 a = gelu_pk((f32x2){v0[0], v0[1]}), b = gelu_pk((f32x2){v0[2], v0[3]}), c = gelu_pk((f32x2){v1[0], v1[1]}), d = gelu_pk((f32x2){v1[2], v1[3]});
                        v0 = (f32x4){a.x, a.y, b.x, b.y}; v1 = (f32x4){c.x, c.y, d.x, d.y}; }
                    v0 = v0 * sc; v1 = v1 * sc; u32x4 w; w.x = cvt_pk_bf16(v0[0], v0[1]); w.y = cvt_pk_bf16(v0[2], v0[3]); w.z = cvt_pk_bf16(v1[0], v1[1]); w.w = cvt_pk_bf16(v1[2], v1[3]);
                    *(u32x4*)(rowp + bj * HALF) = w; } }
    }
};
template <class Epi, class Sched, bool ALIGN_EPI = false, bool SP2 = false>
__device__ __forceinline__ void gemm_phase(PG8_LAS unsigned char* lds, const Gemm g, const Sched& S, const Epi& E) {
    const int tid = threadIdx.x, wid = __builtin_amdgcn_readfirstlane(tid >> 6), lane = tid & 63, wr = wid >> 2, wc = wid & 3, fr = lane & 15, fq = lane >> 4;
    const int K = g.K, nt = K / BK;
    unsigned voffA[2], voffB[2];
    constexpr bool GATHER = Sched::GATHER;
    unsigned gA[2][2], nGA[2][2]; int rowA[2], colA[2];
#pragma unroll
    for (int i = 0; i < 2; ++i) { int R, C; stage_rc(tid * 16 + i * 8192, R, C); const int Rb = Epi::PERM ? ((R & ~31) + perm32(R & 31)) : R;
        voffA[i] = (unsigned)(R * K + C) * 2u; voffB[i] = (unsigned)(Rb * K + C) * 2u; rowA[i] = R; colA[i] = C; }
    const size_t kstep = (size_t)(BK * 2);
    const size_t hstep = (size_t)HALF * K * 2;
    const size_t tstep = 2 * hstep;
    const size_t hstepA = GATHER ? 0 : hstep, tstepA = GATHER ? 0 : tstep;
    const unsigned ldsw = (unsigned)wid * 1024u;
    const int aoff = lds_byte(wr * 64 + fr, fq * 8), boff = lds_byte(wc * 32 + fr, fq * 8);
#define PG8_SA(b, h) (((b) * 2 + (h)) * HTB)
#define PG8_SB(b, h) ((4 + (b) * 2 + (h)) * HTB)
#define PG8_STAGE(bufoff, gbase, voff) do { _Pragma("unroll") for (int _i = 0; _i < 2; ++_i) \
        __builtin_amdgcn_global_load_lds((const unsigned*)((const char*)(gbase) + (voff)[_i]), (PG8_LAS unsigned*)(lds + (bufoff) + ldsw + _i * 8192), 16, 0, 0); } while (0)
#define PG8_STAGE_A(bufoff, gbase, h, nx) do { if constexpr (GATHER) { if (nx) PG8_STAGE(bufoff, gbase, nGA[h]); else PG8_STAGE(bufoff, gbase, gA[h]); } else PG8_STAGE(bufoff, gbase, voffA); } while (0)
#define PG8_GOFF(dst, unit) do { if constexpr (GATHER) { _Pragma("unroll") for (int h_ = 0; h_ < 2; ++h_) _Pragma("unroll") for (int i_ = 0; i_ < 2; ++i_) dst[h_][i_] = S.row_off(unit, h_ * HALF + rowA[i_]) + (unsigned)colA[i_] * 2u; \
        asm volatile("s_waitcnt vmcnt(0)" : "+v"(dst[0][0]), "+v"(dst[0][1]), "+v"(dst[1][0]), "+v"(dst[1][1]) :: "memory"); } } while (0)
#define PG8_LDA(dst, b, h) do { _Pragma("unroll") for (int m = 0; m < 4; ++m) _Pragma("unroll") for (int k = 0; k < 2; ++k) dst[m][k] = *(const PG8_LAS bf16x8*)(lds + PG8_SA(b, h) + aoff + m * 2048 + k * 1024); } while (0)
#define PG8_LDB(dst, b, h) do { _Pragma("unroll") for (int n = 0; n < 2; ++n) _Pragma("unroll") for (int k = 0; k < 2; ++k) dst[n][k] = *(const PG8_LAS bf16x8*)(lds + PG8_SB(b, h) + boff + n * 2048 + k * 1024); } while (0)
#define PG8_MMA(ai, bj, At, Bt) do { __builtin_amdgcn_s_setprio(1); _Pragma("unroll") for (int m = 0; m < 4; ++m) _Pragma("unroll") for (int n = 0; n < 2; ++n) _Pragma("unroll") for (int k = 0; k < 2; ++k) \
        acc[ai][bj][m][n] = __builtin_amdgcn_mfma_f32_16x16x32_bf16(Bt[n][k], At[m][k], acc[ai][bj][m][n], 0, 0, 0); __builtin_amdgcn_s_setprio(0); } while (0)
#define PG8_WAIT_V(n) asm volatile("s_waitcnt vmcnt(" #n ")" ::: "memory")
#define PG8_WAIT_L(n) asm volatile("s_waitcnt lgkmcnt(" #n ")" ::: "memory")
#define PG8_BAR __builtin_amdgcn_s_barrier()
#define PG8_SCHED __builtin_amdgcn_sched_barrier(0)
    Unit cur, nxt; int ui = 0;
    if (!S.next(0, cur)) return;
    f32x4 acc[2][2][4][2];
#pragma unroll
    for (int a = 0; a < 2; ++a)
#pragma unroll
        for (int b = 0; b < 2; ++b)
#pragma unroll
            for (int m = 0; m < 4; ++m)
#pragma unroll
                for (int n = 0; n < 2; ++n) acc[a][b][m][n] = (f32x4){0.f, 0.f, 0.f, 0.f};
    bf16x8 At[4][2], B0[2][2], B1[2][2];
    const char* cA = (const char*)g.A + (size_t)cur.pm * tstepA; const char* cB = (const char*)g.Bt + (size_t)cur.pn * tstep;
    PG8_GOFF(gA, cur);
    S.a_ready(cur);
    if constexpr (SP2) {
        PG8_STAGE(PG8_SB(0, 0), cB, voffB); PG8_STAGE(PG8_SB(0, 1), cB + hstep, voffB); PG8_STAGE_A(PG8_SA(0, 0), cA, 0, false); PG8_STAGE_A(PG8_SA(0, 1), cA + hstepA, 1, false);
        if (wr == 1) PG8_BAR;
        PG8_WAIT_V(2); PG8_BAR;
        PG8_STAGE(PG8_SB(1, 0), cB + kstep, voffB); PG8_STAGE_A(PG8_SA(1, 0), cA + kstep, 0, false); PG8_STAGE(PG8_SB(1, 1), cB + hstep + kstep, voffB);
        PG8_WAIT_V(6); PG8_BAR;
    } else {
        PG8_STAGE(PG8_SB(0, 0), cB, voffB); PG8_STAGE_A(PG8_SA(0, 0), cA, 0, false); PG8_STAGE(PG8_SB(0, 1), cB + hstep, voffB); PG8_STAGE_A(PG8_SA(0, 1), cA + hstepA, 1, false);
        if (wr == 1) PG8_BAR;
        PG8_WAIT_V(4); PG8_BAR;
        PG8_STAGE(PG8_SB(1, 0), cB + kstep, voffB); PG8_STAGE_A(PG8_SA(1, 0), cA + kstep, 0, false); PG8_STAGE(PG8_SB(1, 1), cB + hstep + kstep, voffB);
        PG8_WAIT_V(6); PG8_BAR;
    }
    for (;;) {
        const bool has_next = S.next(ui + 1, nxt);
        if constexpr (GATHER) { if (has_next) PG8_GOFF(nGA, nxt); else { _Pragma("unroll") for (int h_ = 0; h_ < 2; ++h_) _Pragma("unroll") for (int i_ = 0; i_ < 2; ++i_) nGA[h_][i_] = gA[h_][i_]; } }
        const char* nA = has_next ? (const char*)g.A + (size_t)nxt.pm * tstepA : cA; const char* nB = has_next ? (const char*)g.Bt + (size_t)nxt.pn * tstep : cB;
        for (int t = 0; t < nt; t += 2) {
            const bool last = (t == nt - 2);
            const char* a1 = cA + (size_t)(t + 1) * kstep;
            const char* a2 = last ? nA : cA + (size_t)(t + 2) * kstep; const char* b2 = last ? nB : cB + (size_t)(t + 2) * kstep;
            const char* a3 = a2 + kstep; const char* b3 = b2 + kstep;
            if (last && has_next) S.a_ready(nxt);
            if constexpr (SP2) {
            PG8_LDB(B0, 0, 0); PG8_LDB(B1, 0, 1); PG8_SCHED; PG8_LDA(At, 0, 0); PG8_STAGE_A(PG8_SA(1, 1), a1 + hstepA, 1, false);
            PG8_WAIT_V(8); PG8_WAIT_L(0); PG8_BAR; PG8_MMA(0, 0, At, B0); PG8_MMA(0, 1, At, B1); PG8_BAR; PG8_SCHED;
            PG8_LDA(At, 0, 1); PG8_STAGE(PG8_SB(0, 0), b2, voffB); PG8_STAGE(PG8_SB(0, 1), b2 + hstep, voffB); PG8_STAGE_A(PG8_SA(0, 0), a2, 0, last);
            PG8_WAIT_V(8); PG8_WAIT_L(0); PG8_BAR; PG8_MMA(1, 0, At, B0); PG8_MMA(1, 1, At, B1); PG8_BAR; PG8_SCHED;
            PG8_LDB(B0, 1, 0); PG8_LDB(B1, 1, 1); PG8_SCHED; PG8_LDA(At, 1, 0); PG8_STAGE_A(PG8_SA(0, 1), a2 + hstepA, 1, last);
            PG8_WAIT_V(8); PG8_WAIT_L(0); PG8_BAR; PG8_MMA(0, 0, At, B0); PG8_MMA(0, 1, At, B1); PG8_BAR; PG8_SCHED;
            PG8_LDA(At, 1, 1); PG8_STAGE(PG8_SB(1, 0), b3, voffB); PG8_STAGE(PG8_SB(1, 1), b3 + hstep, voffB); PG8_STAGE_A(PG8_SA(1, 0), a3, 0, last);
            PG8_WAIT_V(8); PG8_WAIT_L(0); PG8_BAR; PG8_MMA(1, 0, At, B0); PG8_MMA(1, 1, At, B1); PG8_BAR; PG8_SCHED;
            } else {
            PG8_LDB(B0, 0, 0); PG8_SCHED; PG8_LDA(At, 0, 0); PG8_STAGE_A(PG8_SA(1, 1), a1 + hstepA, 1, false);
            PG8_WAIT_L(8); PG8_BAR; PG8_WAIT_L(0); PG8_MMA(0, 0, At, B0); PG8_BAR; PG8_SCHED;
            PG8_LDB(B1, 0, 1); PG8_STAGE(PG8_SB(0, 0), b2, voffB);
            PG8_BAR; PG8_WAIT_L(0); PG8_MMA(0, 1, At, B1); PG8_BAR;
            PG8_LDA(At, 0, 1); PG8_STAGE_A(PG8_SA(0, 0), a2, 0, last);
            PG8_BAR; PG8_WAIT_L(0); PG8_MMA(1, 0, At, B0); PG8_BAR; PG8_SCHED;
            PG8_STAGE(PG8_SB(0, 1), b2 + hstep, voffB);
            PG8_WAIT_V(6); PG8_BAR; PG8_MMA(1, 1, At, B1); PG8_BAR;
            PG8_LDB(B0, 1, 0); PG8_SCHED; PG8_LDA(At, 1, 0); PG8_STAGE_A(PG8_SA(0, 1), a2 + hstepA, 1, last);
            PG8_WAIT_L(8); PG8_BAR; PG8_WAIT_L(0); PG8_MMA(0, 0, At, B0); PG8_BAR; PG8_SCHED;
            PG8_LDB(B1, 1, 1); PG8_STAGE(PG8_SB(1, 0), b3, voffB);
            PG8_BAR; PG8_WAIT_L(0); PG8_MMA(0, 1, At, B1); PG8_BAR;
            PG8_LDA(At, 1, 1); PG8_STAGE_A(PG8_SA(1, 0), a3, 0, last);
            PG8_BAR; PG8_WAIT_L(0); PG8_MMA(1, 0, At, B0); PG8_BAR; PG8_SCHED;
            PG8_STAGE(PG8_SB(1, 1), b3 + hstep, voffB);
            PG8_WAIT_V(6); PG8_BAR; PG8_MMA(1, 1, At, B1); PG8_BAR;
            }
        }
        if constexpr (ALIGN_EPI) { if (wr == 0) PG8_BAR; }
        if constexpr (!Epi::AFTER_DRAIN) { E(acc, cur, wr, wc, fr, fq); S.done(cur); }
        if (!has_next) break;
#pragma unroll
        for (int a = 0; a < 2; ++a)
#pragma unroll
            for (int b = 0; b < 2; ++b)
#pragma unroll
                for (int m = 0; m < 4; ++m)
#pragma unroll
                    for (int n = 0; n < 2; ++n) acc[a][b][m][n] = (f32x4){0.f, 0.f, 0.f, 0.f};
        cur = nxt; cA = nA; cB = nB; ++ui;
        if constexpr (GATHER) { _Pragma("unroll") for (int h_ = 0; h_ < 2; ++h_) _Pragma("unroll") for (int i_ = 0; i_ < 2; ++i_) gA[h_][i_] = nGA[h_][i_]; }
        if constexpr (ALIGN_EPI) { if (wr == 1) PG8_BAR; }
    }
    PG8_WAIT_V(0);
    if constexpr (!ALIGN_EPI) { if (wr == 0) PG8_BAR; }
    PG8_BAR;
    if constexpr (Epi::AFTER_DRAIN) { E.fused(acc, cur, wr, wc, fr, fq, lds, wid, lane); S.done(cur); }
#undef PG8_SA
#undef PG8_SB
#undef PG8_STAGE
#undef PG8_STAGE_A
#undef PG8_GOFF
#undef PG8_LDA
#undef PG8_LDB
#undef PG8_MMA
#undef PG8_WAIT_V
#undef PG8_WAIT_L
#undef PG8_BAR
#undef PG8_SCHED
}
}
namespace mk {
constexpr int D = 1024, BATCH = 2, SEQ = 8192, T = BATCH * SEQ;
constexpr int INW = 2832, NPROJ = 2816;
constexpr int PJ_Q = 0, PJ_K = 512, PJ_V = 1024, PJ_Z = 1536, PJ_AQ = 2048, PJ_AK = 2560, PJ_AV = 2688;
constexpr int NEXP = 64, EFF = 256;
constexpr float EPS = 1e-6f;
constexpr int NWAVES = 8, NTHR = 512;
constexpr size_t MiB = 1u << 20;
constexpr size_t WS_CTL = 0, CTL_ZERO_BYTES = 1 * MiB;
constexpr size_t WS_WIN = 1 * MiB, WS_WOUT = 7 * MiB, WS_WGU = 9 * MiB, WS_WD = 73 * MiB;
constexpr size_t WS_HN = 105 * MiB, WS_BG = 137 * MiB, WS_MISC = 138 * MiB, WS_PROJ = 144 * MiB;
constexpr size_t WS_DN = 232 * MiB, WS_MIX = 456 * MiB, WS_END = 488 * MiB;
constexpr int CW_BAR = 4096;
constexpr int LDS_BYTES = 163840, RING_BYTES = 159744, LDSCTL_OFF = RING_BYTES, MISC_OFF = LDSCTL_OFF + 320;

#define GAS __attribute__((address_space(1)))
#define LAS __attribute__((address_space(3)))
typedef unsigned short bf16;
typedef unsigned v4u __attribute__((ext_vector_type(4)));
typedef float f32x4 __attribute__((ext_vector_type(4)));
typedef GAS unsigned gu32;
#define RLX_AGENT __ATOMIC_RELAXED, __HIP_MEMORY_SCOPE_AGENT
#define LDS_WAIT() asm volatile("s_waitcnt lgkmcnt(0)" ::: "memory")
#define VM_WAIT() asm volatile("s_waitcnt vmcnt(0)" ::: "memory")
__device__ __forceinline__ unsigned f2bf(float f) { unsigned u = __builtin_bit_cast(unsigned, f); return (u + 0x7fffu + ((u >> 16) & 1u)) >> 16; }
typedef float f32x2_t __attribute__((ext_vector_type(2))); typedef __bf16 bf16x2_t __attribute__((ext_vector_type(2)));
__device__ __forceinline__ unsigned pk2(float lo, float hi) { f32x2_t v = {lo, hi}; bf16x2_t b = __builtin_convertvector(v, bf16x2_t); return __builtin_bit_cast(unsigned, b); }
__device__ __forceinline__ float bf2f(unsigned short b) { return __builtin_bit_cast(float, (unsigned)b << 16); }
__device__ __forceinline__ float wave_sum(float v) {
#pragma unroll
    for (int o = 1; o < 64; o <<= 1) v += __shfl_xor(v, o);
    return v;
}
__device__ __forceinline__ float reduce16(float (&v)[16], int lane) {
    { const bool h = (lane & 32) != 0;
#pragma unroll
      for (int i = 0; i < 8; ++i) { const float keep = h ? v[i + 8] : v[i], send = h ? v[i] : v[i + 8]; v[i] = keep + __shfl_xor(send, 32); } }
    { const bool h = (lane & 16) != 0;
#pragma unroll
      for (int i = 0; i < 4; ++i) { const float keep = h ? v[i + 4] : v[i], send = h ? v[i] : v[i + 4]; v[i] = keep + __shfl_xor(send, 16); } }
    { const bool h = (lane & 8) != 0;
#pragma unroll
      for (int i = 0; i < 2; ++i) { const float keep = h ? v[i + 2] : v[i], send = h ? v[i] : v[i + 2]; v[i] = keep + __shfl_xor(send, 8); } }
    { const bool h = (lane & 4) != 0; const float keep = h ? v[1] : v[0], send = h ? v[0] : v[1]; v[0] = keep + __shfl_xor(send, 4); }
    v[0] += __shfl_xor(v[0], 2); v[0] += __shfl_xor(v[0], 1);
    return v[0];
}
__device__ __forceinline__ float silu_f(float x) { return x / (1.f + __expf(-x)); }
__device__ __forceinline__ float softplus_f(float x) { return fmaxf(x, 0.f) + log1pf(expf(-fabsf(x))); }

#define XB_TMO      128
#define XB_XCNT(j)  (256  + 64 * (j))
#define XB_XSUB(j)  (1280 + 64 * (j))
#define XB_XGEN(j)  (2304 + 64 * (j))
#define XB_TOP      3328
#define XB_TOPGEN   3392
#define XCD_BAR_WORDS 3456
#define XB_SPIN_CAP (1u << 22)
__device__ __forceinline__ unsigned xb_ld(unsigned* p)              { return __hip_atomic_load(p, __ATOMIC_RELAXED, __HIP_MEMORY_SCOPE_AGENT); }
__device__ __forceinline__ unsigned xb_add(unsigned* p, unsigned v) { return __hip_atomic_fetch_add(p, v, __ATOMIC_RELAXED, __HIP_MEMORY_SCOPE_AGENT); }
__device__ __forceinline__ unsigned xb_xcc_id() { return (unsigned)__builtin_amdgcn_s_getreg((3 << 11) | 20) & 0xFu; }
#define XB_SPIN(cond, bar) do { unsigned _sp = 0; while (cond) { __builtin_amdgcn_s_sleep(1); \
    if ((++_sp & 255u) == 0u) { if (xb_ld(&(bar)[XB_TMO])) break; if (_sp > XB_SPIN_CAP) { atomicAdd(&(bar)[XB_TMO], 1u); break; } } } } while (0)
struct XcdBarrier { unsigned* bar; unsigned x; volatile LAS unsigned* st; };
__device__ __forceinline__ XcdBarrier xcd_barrier_post(unsigned* bar, volatile LAS unsigned* st) {
    XcdBarrier b; b.bar = bar; b.x = xb_xcc_id(); b.st = st;
    if (threadIdx.x == 0) (void)xb_add(&bar[XB_XCNT(b.x)], 1u);
    return b;
}
__device__ __forceinline__ void xcd_barrier_complete(unsigned* bar, unsigned x, unsigned& nloc, unsigned& nx) {
    const unsigned G = gridDim.x * gridDim.y * gridDim.z;
    unsigned sum, cnt, mine, sp = 0u;
    for (;;) {
        sum = 0u; cnt = 0u; mine = 0u;
#pragma unroll
        for (unsigned j = 0; j < 16; ++j) { const unsigned c = xb_ld(&bar[XB_XCNT(j)]); sum += c; cnt += (c > 0u) ? 1u : 0u; mine = (j == x) ? c : mine; }
        if (sum == G) break;
        __builtin_amdgcn_s_sleep(1);
        if ((++sp & 255u) == 0u) { if (xb_ld(&bar[XB_TMO])) break; if (sp > XB_SPIN_CAP) { atomicAdd(&bar[XB_TMO], 1u); break; } }
    }
    nloc = mine > 0u ? mine : 1u; nx = cnt > 0u ? cnt : 1u;
}
__device__ __forceinline__ void xcd_barrier(const XcdBarrier& b) {
    asm volatile("s_waitcnt vmcnt(0)" ::: "memory");
    __syncthreads();
    if (threadIdx.x == 0) {
        unsigned* bar = b.bar;
        __builtin_amdgcn_s_waitcnt(0);
        unsigned nloc = b.st[0], nx = b.st[1];
        if (nloc == 0u) { xcd_barrier_complete(bar, b.x, nloc, nx); b.st[0] = nloc; b.st[1] = nx; }
        const unsigned old = xb_add(&bar[XB_XSUB(b.x)], 1u);
        const unsigned gen = old / nloc;
        if (old + 1u == (gen + 1u) * nloc) {
            __builtin_amdgcn_fence(__ATOMIC_RELEASE, "agent");
            asm volatile("s_waitcnt vmcnt(0)" ::: "memory");
            const unsigned og = xb_add(&bar[XB_TOP], 1u);
            const unsigned tg = og / nx;
            if (og + 1u == (tg + 1u) * nx) xb_add(&bar[XB_TOPGEN], 1u);
            else XB_SPIN(xb_ld(&bar[XB_TOPGEN]) == tg, bar);
            __builtin_amdgcn_fence(__ATOMIC_ACQUIRE, "agent");
            xb_add(&bar[XB_XGEN(b.x)], 1u);
            asm volatile("s_waitcnt vmcnt(0)" ::: "memory");
        } else {
            XB_SPIN(xb_ld(&bar[XB_XGEN(b.x)]) == gen, bar);
            __builtin_amdgcn_fence(__ATOMIC_ACQUIRE, "agent");
            asm volatile("s_waitcnt vmcnt(0)" ::: "memory");
        }
    }
    __syncthreads();
}

struct Frame {
    LAS unsigned char* lds;
    volatile LAS unsigned* MISC;
    gu32* ctl;
    int tid, lane, wave;
    int vcu, G, li;
    float* out; unsigned char* ws;
};
enum { I_X = 0, I_LNMIX, I_WIN, I_CONV, I_ALOG, I_DTB, I_DNNORM, I_SINK, I_WOUT, I_LNFFN, I_WG, I_BG, I_WE, I_BE, I_WGU, I_WD, I_LNF };

__device__ __forceinline__ void transpose_item(const float* W, int ldn, int src_col0, int k0, bf16* WT, int ldk, int dst_row0, LAS float* scr, int lane) {
#pragma unroll 8
    for (int i = 0; i < 32; ++i) { const int kk = 2 * i + (lane >> 5); scr[kk * 33 + (lane & 31)] = __builtin_nontemporal_load(W + (size_t)(k0 + kk) * ldn + src_col0 + (lane & 31)); }
    LDS_WAIT(); asm volatile("" ::: "memory");
    const int c = lane & 7;
#pragma unroll
    for (int j = 0; j < 4; ++j) { const int n = (lane >> 3) + 8 * j; const LAS float* s = scr + (8 * c) * 33 + n;
        v4u o; o.x = pk2(s[0 * 33], s[1 * 33]); o.y = pk2(s[2 * 33], s[3 * 33]); o.z = pk2(s[4 * 33], s[5 * 33]); o.w = pk2(s[6 * 33], s[7 * 33]);
        __builtin_nontemporal_store(o, (v4u*)(WT + (size_t)(dst_row0 + n) * ldk + k0 + 8 * c)); }
    LDS_WAIT(); asm volatile("" ::: "memory");
}
__device__ __forceinline__ void p0_prologue(Frame& F, const float* x_in, const float* lnw, const float* w_in, const float* w_out, const float* a_log, const float* dt_b) {
    LAS float* scr = (LAS float*)(F.lds + F.wave * 16384);
    const int gw = F.vcu * NWAVES + F.wave, NGW = F.G * NWAVES;
    bf16* Win_t = (bf16*)(F.ws + WS_WIN); bf16* Wout_t = (bf16*)(F.ws + WS_WOUT);
    constexpr int I_IN = 16 * 88, I_OUT = 16 * 32, NITEMS = I_IN + I_OUT;
    for (int it = gw; it < NITEMS; it += NGW) {
        int r = it;
        if (r < I_IN) { const int kb = r / 88, nb = r % 88, n0 = 32 * nb; transpose_item(w_in, INW, n0 + (n0 >= 2048 ? 16 : 0), 64 * kb, Win_t, D, n0, scr, F.lane); continue; } r -= I_IN;
        { const int kb = r / 32, nb = r % 32; transpose_item(w_out, D, 32 * nb, 64 * kb, Wout_t, D, 32 * nb, scr, F.lane); }
    }
    __syncthreads();
    LAS float* w16T = (LAS float*)F.lds;
    for (int i = F.tid; i < D * 4; i += NTHR) { const int k = i >> 2, c4 = (i & 3) * 4; const f32x4 w = *(const f32x4*)(w_in + (size_t)k * INW + 2048 + c4);
        w16T[(c4 + 0) * D + k] = w.x; w16T[(c4 + 1) * D + k] = w.y; w16T[(c4 + 2) * D + k] = w.z; w16T[(c4 + 3) * D + k] = w.w; }
    __syncthreads();
    bf16* hn = (bf16*)(F.ws + WS_HN); float* bg = (float*)(F.ws + WS_BG);
    f32x4 lw[4];
#pragma unroll
    for (int j = 0; j < 4; ++j) lw[j] = ((const f32x4*)lnw)[F.lane + 64 * j];
    for (int m = gw; m < T; m += NGW) {
        const GAS f32x4* xr = (const GAS f32x4*)(x_in + (size_t)m * D) + F.lane;
        f32x4 v[4]; float s = 0.f;
#pragma unroll
        for (int j = 0; j < 4; ++j) { v[j] = xr[64 * j]; s += (v[j].x * v[j].x + v[j].y * v[j].y) + (v[j].z * v[j].z + v[j].w * v[j].w); }
        const float rstd = rsqrtf(wave_sum(s) * (1.f / D) + EPS);
#pragma unroll
        for (int j = 0; j < 4; ++j) v[j] = v[j] * rstd * lw[j];
        GAS unsigned long long* o8 = (GAS unsigned long long*)(hn + (size_t)m * D) + F.lane;
#pragma unroll
        for (int j = 0; j < 4; ++j) o8[64 * j] = (unsigned long long)pk2(v[j].x, v[j].y) | ((unsigned long long)pk2(v[j].z, v[j].w) << 32);
        float acc[16];
#pragma unroll
        for (int c = 0; c < 16; ++c) { float a = 0.f;
#pragma unroll
            for (int j = 0; j < 4; ++j) { const f32x4 w = *(const LAS f32x4*)(w16T + c * D + 4 * F.lane + 256 * j); a += (v[j].x * w.x + v[j].y * w.y) + (v[j].z * w.z + v[j].w * w.w); }
            acc[c] = a; if ((c & 3) == 3) asm volatile("" ::: "memory"); }
        const float tot = reduce16(acc, F.lane);
        if ((F.lane & 3) == 0) { const int idx = ((F.lane >> 5) & 1) * 8 + ((F.lane >> 4) & 1) * 4 + ((F.lane >> 3) & 1) * 2 + ((F.lane >> 2) & 1);
            if (idx < 8) bg[(size_t)m * 16 + idx] = 1.f / (1.f + expf(-tot));
            else bg[(size_t)m * 16 + idx] = -expf(a_log[idx - 8]) * softplus_f(tot + dt_b[idx - 8]); }
    }
}

typedef short bf16x8 __attribute__((ext_vector_type(8)));
typedef short bf16x4 __attribute__((ext_vector_type(4)));
typedef unsigned v2u __attribute__((ext_vector_type(2)));
constexpr size_t DN_QS = WS_DN, DN_KT = WS_DN + 32 * MiB, DN_U = WS_DN + 64 * MiB, DN_W = WS_DN + 128 * MiB, DN_AT = WS_DN + 192 * MiB;
constexpr size_t DN_GV = WS_MISC;
constexpr size_t SC_KKQK = WS_WGU, SC_VT = WS_WD;
#define MFMA16(a, b, c) __builtin_amdgcn_mfma_f32_16x16x32_bf16((a), (b), (c), 0, 0, 0)
#define RAW_BAR() do { asm volatile("s_waitcnt lgkmcnt(0)" ::: "memory"); __builtin_amdgcn_s_barrier(); asm volatile("" ::: "memory"); } while (0)

__device__ __forceinline__ void glds16(const void* gsrc, LAS unsigned char* ldst) {
    __builtin_amdgcn_global_load_lds((const unsigned*)gsrc, (LAS unsigned*)ldst, 16, 0, 0);
}
__device__ __forceinline__ void p2_group(Frame& F, int grp, const float* convw, const float* bgp, int stmask = 3) {
    const int tid = F.tid, lane = F.lane, w = F.wave;
    const bf16* proj = (const bf16*)(F.ws + WS_PROJ);
    LAS bf16* QL = (LAS bf16*)(F.lds + 52224);
    LAS bf16* KL = (LAS bf16*)(F.lds + 52224 + 17408);
    LAS float* CWL = (LAS float*)(F.lds + 139264);
    auto xin_issue = [&](int ui, LAS unsigned char* XB) {
        const int un = grp * 4 + ui, n = un & 127, bh = un >> 7, h = bh & 3, b = bh >> 2;
#pragma unroll 1
        for (int k = 0; k < 7; ++k) { const int pc = k * 8 + w;
            if (pc < 51) { const int c = pc * 64 + lane, rr = c / 48, rem = c - rr * 48, p = rem >> 4, c16 = rem & 15, s = 64 * n - 2 + rr;
                if (s >= 0 && s < SEQ) glds16(proj + (size_t)(b * SEQ + s) * NPROJ + p * 512 + h * 128 + c16 * 8, XB + pc * 1024);
                else *(LAS v4u*)(XB + c * 16) = (v4u){0u, 0u, 0u, 0u}; } }
    };
    if (stmask & 1) {
        xin_issue(0, F.lds);
        if (tid < 480) { const int pj = tid >> 5, c4 = tid & 31, p = pj / 5, j = pj - p * 5, h = ((grp * 4) >> 7) & 3;
            *(LAS f32x4*)(CWL + pj * 128 + 4 * c4) = *(const f32x4*)(convw + j * 1536 + p * 512 + h * 128 + 4 * c4); }
    }
#pragma unroll 1
    for (int ui = 0; ui < ((stmask & 1) ? 4 : 0); ++ui) {
        const int un = grp * 4 + ui, n = un & 127, bh = un >> 7, h = bh & 3, b = bh >> 2;
        LAS bf16* XIN = (LAS bf16*)(F.lds + (ui & 1) * 87040);
        asm volatile("s_waitcnt vmcnt(0) lgkmcnt(0)" ::: "memory"); __syncthreads();
        if (ui + 1 < 4) xin_issue(ui + 1, F.lds + ((ui + 1) & 1) * 87040);
        {
            float val[3][8][2];
#pragma unroll
            for (int p = 0; p < 3; ++p) {
                float cw[5][2];
#pragma unroll
                for (int j = 0; j < 5; ++j) { const LAS float* cp = CWL + (p * 5 + j) * 128 + 2 * lane; cw[j][0] = cp[0]; cw[j][1] = cp[1]; }
                float xr[12][2];
#pragma unroll
                for (int r = 0; r < 12; ++r) { const unsigned u2 = *(const LAS unsigned*)(XIN + (8 * w + r) * 384 + p * 128 + 2 * lane); xr[r][0] = bf2f((unsigned short)(u2 & 0xffffu)); xr[r][1] = bf2f((unsigned short)(u2 >> 16)); }
#pragma unroll
                for (int i = 0; i < 8; ++i) { float a0 = 0.f, a1 = 0.f;
#pragma unroll
                    for (int j = 0; j < 5; ++j) { a0 = fmaf(xr[i + j][0], cw[j][0], a0); a1 = fmaf(xr[i + j][1], cw[j][1], a1); }
                    val[p][i][0] = silu_f(a0); val[p][i][1] = silu_f(a1); }
            }
#pragma unroll
            for (int i = 0; i < 8; ++i) {
                const float sq = wave_sum(val[0][i][0] * val[0][i][0] + val[0][i][1] * val[0][i][1]);
                const float sk = wave_sum(val[1][i][0] * val[1][i][0] + val[1][i][1] * val[1][i][1]);
                const float rq = rsqrtf(sq + EPS) * 0.08838834764831845f, rk = rsqrtf(sk + EPS);
                val[0][i][0] *= rq; val[0][i][1] *= rq; val[1][i][0] *= rk; val[1][i][1] *= rk;
                const unsigned qp = pk2(val[0][i][0], val[0][i][1]), kp = pk2(val[1][i][0], val[1][i][1]);
                *(LAS unsigned*)(QL + (8 * w + i) * 136 + 2 * lane) = qp; *(LAS unsigned*)(KL + (8 * w + i) * 136 + 2 * lane) = kp;
                *(GAS unsigned*)((bf16*)(F.ws + DN_QS) + ((size_t)un * 64 + 8 * w + i) * 128 + 2 * lane) = qp;
            }
#pragma unroll
            for (int c = 0; c < 2; ++c) {
                v4u kt, vt;
                kt.x = pk2(val[1][0][c], val[1][1][c]); kt.y = pk2(val[1][2][c], val[1][3][c]); kt.z = pk2(val[1][4][c], val[1][5][c]); kt.w = pk2(val[1][6][c], val[1][7][c]);
                vt.x = pk2(val[2][0][c], val[2][1][c]); vt.y = pk2(val[2][2][c], val[2][3][c]); vt.z = pk2(val[2][4][c], val[2][5][c]); vt.w = pk2(val[2][6][c], val[2][7][c]);
                { bf16* kp = (bf16*)(F.ws + DN_KT) + ((size_t)un * 128 + 2 * lane + c) * 64 + 32 * (w >> 2) + 16 * (w & 1) + 4 * ((w & 3) >> 1);
                  *(GAS v2u*)kp = (v2u){kt.x, kt.y}; *(GAS v2u*)(kp + 8) = (v2u){kt.z, kt.w}; }
                *(GAS v4u*)((bf16*)(F.ws + SC_VT) + ((size_t)un * 128 + 2 * lane + c) * 64 + 8 * w) = vt;
            }
        }
        __syncthreads();
        {
            const int type = w >> 2, tr = w & 3, fr = lane & 15, fq = lane >> 4;
            const LAS bf16* Asrc = type ? QL : KL;
            bf16x8 af[4];
#pragma unroll
            for (int ks = 0; ks < 4; ++ks) af[ks] = *(const LAS bf16x8*)(Asrc + (16 * tr + fr) * 136 + 32 * ks + 8 * fq);
            float* G = (float*)(F.ws + SC_KKQK) + ((size_t)un * 2 + type) * 4096;
#pragma unroll
            for (int tc = 0; tc < 4; ++tc) { f32x4 acc = (f32x4){0.f, 0.f, 0.f, 0.f};
#pragma unroll
                for (int ks = 0; ks < 4; ++ks) { const bf16x8 bfr = *(const LAS bf16x8*)(KL + (16 * tc + fr) * 136 + 32 * ks + 8 * fq); acc = MFMA16(af[ks], bfr, acc); }
#pragma unroll
                for (int r = 0; r < 4; ++r) G[(16 * tr + 4 * fq + r) * 64 + 16 * tc + fr] = acc[r]; }
        }
    }
    VM_WAIT(); __syncthreads();
    if (tid == 0) { __builtin_amdgcn_fence(__ATOMIC_ACQUIRE, "agent"); VM_WAIT(); }
    __syncthreads();
    if (stmask & 2) {
        int lane = F.lane; asm volatile("" : "+v"(lane));
        const int un = grp * 4 + (w >> 1), dir = w & 1, n = un & 127, bh = un >> 7, h = bh & 3, b = bh >> 2, item = un * 2 + dir;
        const int rl = dir ? 63 - lane : lane;
        const size_t tok = (size_t)b * SEQ + 64 * n + rl;
        const float beta = bgp[tok * 16 + dir * 4 + h], g = bgp[tok * 16 + 8 + dir * 4 + h];
        float gc = g;
#pragma unroll
        for (int o = 1; o < 64; o <<= 1) { const float t = __shfl_up(gc, o); if (lane >= o) gc += t; }
        const float gcl = __shfl(gc, 63), egc = __expf(gc), ekd = __expf(gcl - gc);
        float* gv = (float*)(F.ws + DN_GV) + (size_t)item * 128; gv[lane] = egc; gv[64 + lane] = ekd;
        const float* KKp = (const float*)(F.ws + SC_KKQK) + (size_t)un * 8192; const float* QKp = KKp + 4096;
        bf16* ATp = (bf16*)(F.ws + DN_AT) + (size_t)item * 4096;
        float Tr[64];
        float kkc[8], qkc[8];
        const char* KKb = (const char*)KKp; char* ATb = (char*)ATp;
        const int kstep = dir ? -256 : 256;
        const unsigned kk0 = (unsigned)(((dir ? 63 : 0) * 64 + rl) * 4);
        {   unsigned o2 = kk0; asm volatile("" : "+v"(o2));
#pragma unroll
            for (int r = 0; r < 8; ++r) { kkc[r] = *(const float*)(KKb + (o2 + (unsigned)(r * kstep))); qkc[r] = *(const float*)(KKb + (o2 + (unsigned)(r * kstep) + 16384u)); } }
#pragma unroll
        for (int blk = 0; blk < 8; ++blk) {
            float kkn[8], qkn[8];
            {   unsigned o2 = kk0 + (unsigned)((blk < 7 ? 8 * (blk + 1) : 0) * kstep); asm volatile("" : "+v"(o2));
#pragma unroll
                for (int r = 0; r < 8; ++r) { kkn[r] = *(const float*)(KKb + (o2 + (unsigned)(r * kstep))); qkn[r] = *(const float*)(KKb + (o2 + (unsigned)(r * kstep) + 16384u)); } }
            unsigned ao = (unsigned)(lane * 2 + blk * 1024); asm volatile("" : "+v"(ao));
            asm volatile("" ::: "memory");
#pragma unroll
            for (int r = 0; r < 8; ++r) {
                const int i = 8 * blk + r;
                const float kk = kkc[r], qk = qkc[r];
                const float gci = __builtin_bit_cast(float, __builtin_amdgcn_readlane(__builtin_bit_cast(int, gc), i));
                const float bi = __builtin_bit_cast(float, __builtin_amdgcn_readlane(__builtin_bit_cast(int, beta), i));
                const float dec = __expf(fminf(gci - gc, 0.f));
                const float arow = (lane < i) ? bi * kk * dec : 0.f;
                *(bf16*)(ATb + (ao + (unsigned)(r * 128))) = (bf16)f2bf((lane <= i) ? qk * dec : 0.f);
                float t = (lane == i) ? 1.f : 0.f;
#pragma unroll
                for (int j = 0; j < i; ++j) { const float sv = __builtin_bit_cast(float, __builtin_amdgcn_readlane(__builtin_bit_cast(int, arow), j)); t = fmaf(-sv, Tr[j], t); }
                Tr[i] = t;
            }
            asm volatile("" ::: "memory");
#pragma unroll
            for (int r = 0; r < 8; ++r) { kkc[r] = kkn[r]; qkc[r] = qkn[r]; }
        }
        LAS bf16* TB = (LAS bf16*)(F.lds + w * 16384); LAS bf16* TG = TB + 4096;
        const float cb = beta, cg = beta * egc;
        const int rp = (rl & 32) | (((rl >> 2) & 3) << 3) | (((rl >> 4) & 1) << 2) | (rl & 3);
#pragma unroll
        for (int i = 0; i < 64; ++i) { const int off = i * 64 + ((((rl >> 3) ^ (i & 7))) << 3) + (rl & 7), offg = i * 64 + ((((rp >> 3) ^ (i & 7))) << 3) + (rp & 7);
            TB[off] = (bf16)f2bf(Tr[i] * cb); TG[offg] = (bf16)f2bf(Tr[i] * cg); }
        LDS_WAIT(); asm volatile("" ::: "memory");
        const int fr = lane & 15, fq = lane >> 4;
        bf16x8 ab[4][2], ag[4][2];
#pragma unroll
        for (int m = 0; m < 4; ++m)
#pragma unroll
            for (int ks = 0; ks < 2; ++ks) { const int row = 16 * m + fr, off = row * 64 + (((4 * ks + fq) ^ (row & 7)) << 3); ab[m][ks] = *(const LAS bf16x8*)(TB + off); ag[m][ks] = *(const LAS bf16x8*)(TG + off); }
        const bf16* VTp = (const bf16*)(F.ws + SC_VT) + (size_t)un * 8192; const bf16* KTp = (const bf16*)(F.ws + DN_KT) + (size_t)un * 8192;
        bf16* Up = (bf16*)(F.ws + DN_U) + (size_t)item * 8192; bf16* Wp = (bf16*)(F.ws + DN_W) + (size_t)item * 8192;
#pragma unroll 2
        for (int nn = 0; nn < 8; ++nn) {
            bf16x8 bv[2], bk[2];
#pragma unroll
            for (int ks = 0; ks < 2; ++ks) { bv[ks] = *(const GAS bf16x8*)(VTp + (16 * nn + fr) * 64 + 32 * ks + 8 * fq); bk[ks] = *(const GAS bf16x8*)(KTp + (16 * nn + fr) * 64 + 32 * ks + 8 * fq); }
#pragma unroll
            for (int m = 0; m < 4; ++m) {
                f32x4 au = (f32x4){0.f, 0.f, 0.f, 0.f}, aw = (f32x4){0.f, 0.f, 0.f, 0.f};
#pragma unroll
                for (int ks = 0; ks < 2; ++ks) { au = MFMA16(ab[m][ks], bv[ks], au); aw = MFMA16(bk[ks], ag[m][ks], aw); }
                v2u uo; uo.x = pk2(au[0], au[1]); uo.y = pk2(au[2], au[3]);
                *(GAS v2u*)(Up + ((m * 8 + nn) * 64 + lane) * 4) = uo;
                v2u wo; wo.x = pk2(aw[0], aw[1]); wo.y = pk2(aw[2], aw[3]);
                *(GAS v2u*)(Wp + (16 * m + fr) * 128 + 32 * (nn >> 1) + 8 * fq + 4 * (nn & 1)) = wo;
            }
        }
    }
    __syncthreads();
}

constexpr int CW_PROG = 36864;
constexpr int RB_W = 0, RB_KT = 16384, RB_U = 32768, RB_GV = 40960, RB_SIZE = 41984;
static_assert(3 * RB_SIZE <= RING_BYTES, "scan ring");
constexpr size_t DN_SX0 = DN_U + 32 * MiB, DN_SX1 = DN_W + 32 * MiB, DN_VX0 = DN_QS + 16 * MiB, DN_VX1 = DN_KT + 16 * MiB;
__device__ __forceinline__ void glds16_sc1(const void* gsrc, LAS unsigned char* ldst) {
    __builtin_amdgcn_global_load_lds((const unsigned*)gsrc, (LAS unsigned*)ldst, 16, 0, 16);
}
template <int OFF>
__device__ __forceinline__ void store16_sc1(void* gdst, v4u v) {
    asm volatile("global_store_dwordx4 %0, %1, off offset:%2 sc1\n\ts_nop 1" :: "v"(gdst), "v"(v), "n"(OFF) : "memory");
}
__device__ __forceinline__ bf16x8 ld2x8(const LAS unsigned char* p0, const LAS unsigned char* p1) {
    const v2u lo = *(const LAS v2u*)p0, hi = *(const LAS v2u*)p1; v4u v; v.x = lo.x; v.y = lo.y; v.z = hi.x; v.w = hi.y; return __builtin_bit_cast(bf16x8, v);
}
struct ScanOff { unsigned w0[4], k0[2], u, gk; };
template <int DIR, int BUF>
__device__ __forceinline__ void scan_step(LAS unsigned char* L, const ScanOff& O, f32x4 (&S)[8], unsigned char*& sxp, unsigned char*& vxp, bool ex) {
    const LAS unsigned char* B = L + BUF * RB_SIZE;
    v4u sbv[4];
#pragma unroll
    for (int ks = 0; ks < 4; ++ks) { sbv[ks].x = pk2(S[2 * ks][0], S[2 * ks][1]); sbv[ks].y = pk2(S[2 * ks][2], S[2 * ks][3]); sbv[ks].z = pk2(S[2 * ks + 1][0], S[2 * ks + 1][1]); sbv[ks].w = pk2(S[2 * ks + 1][2], S[2 * ks + 1][3]); }
    if (ex) { store16_sc1<0>(sxp, sbv[0]); store16_sc1<1024>(sxp, sbv[1]); store16_sc1<2048>(sxp, sbv[2]); store16_sc1<3072>(sxp, sbv[3]); }
    bf16x8 fw[4][4]; v2u ucv[4]; f32x4 ekv[4];
#pragma unroll
    for (int it = 0; it < 4; ++it) {
#pragma unroll
        for (int ks = 0; ks < 4; ++ks) fw[it][ks] = *(const LAS bf16x8*)(B + RB_W + O.w0[ks] + it * 4096);
        ucv[it] = *(const LAS v2u*)(B + RB_U + O.u + it * 2048); ekv[it] = *(const LAS f32x4*)(B + RB_GV + O.gk + it * 64); }
    const float dch = ((const LAS float*)(B + RB_GV))[63];
    f32x4 aW[4];
#pragma unroll
    for (int it = 0; it < 4; ++it) { aW[it] = (f32x4){0.f, 0.f, 0.f, 0.f};
#pragma unroll
        for (int ks = 0; ks < 4; ++ks) aW[it] = MFMA16(fw[it][ks], __builtin_bit_cast(bf16x8, sbv[ks]), aW[it]); }
    bf16x8 fk[8][2];
#pragma unroll
    for (int dt = 0; dt < 8; ++dt)
#pragma unroll
        for (int k2 = 0; k2 < 2; ++k2) fk[dt][k2] = *(const LAS bf16x8*)(B + RB_KT + O.k0[k2] + dt * 2048);
    f32x4 vs[4]; v2u vnp[4];
#pragma unroll
    for (int it = 0; it < 4; ++it) {
        const v2u uc = ucv[it]; const f32x4 ek = ekv[it];
        f32x4 vn;
        vn[0] = bf2f((unsigned short)(uc.x & 0xffffu)) - aW[it][0]; vn[1] = bf2f((unsigned short)(uc.x >> 16)) - aW[it][1];
        vn[2] = bf2f((unsigned short)(uc.y & 0xffffu)) - aW[it][2]; vn[3] = bf2f((unsigned short)(uc.y >> 16)) - aW[it][3];
        vnp[it] = (v2u){pk2(vn[0], vn[1]), pk2(vn[2], vn[3])};
        vs[it] = vn * ek;
    }
    if (ex) { store16_sc1<0>(vxp, (v4u){vnp[0].x, vnp[0].y, vnp[1].x, vnp[1].y}); store16_sc1<1024>(vxp, (v4u){vnp[2].x, vnp[2].y, vnp[3].x, vnp[3].y}); }
    sxp += DIR ? -32768 : 32768; vxp += DIR ? -16384 : 16384;
    bf16x8 Vsb[2];
#pragma unroll
    for (int k2 = 0; k2 < 2; ++k2) { v4u t;
        if (DIR) { t.x = pk2(vs[2 * k2 + 1][3], vs[2 * k2 + 1][2]); t.y = pk2(vs[2 * k2 + 1][1], vs[2 * k2 + 1][0]); t.z = pk2(vs[2 * k2][3], vs[2 * k2][2]); t.w = pk2(vs[2 * k2][1], vs[2 * k2][0]); }
        else { t.x = pk2(vs[2 * k2][0], vs[2 * k2][1]); t.y = pk2(vs[2 * k2][2], vs[2 * k2][3]); t.z = pk2(vs[2 * k2 + 1][0], vs[2 * k2 + 1][1]); t.w = pk2(vs[2 * k2 + 1][2], vs[2 * k2 + 1][3]); }
        Vsb[k2] = __builtin_bit_cast(bf16x8, t); }
#pragma unroll
    for (int dt = 0; dt < 8; ++dt) { S[dt] = S[dt] * dch;
#pragma unroll
        for (int k2 = 0; k2 < 2; ++k2) S[dt] = MFMA16(fk[dt][k2], Vsb[k2], S[dt]); }
    asm volatile("s_waitcnt vmcnt(12) lgkmcnt(0)" ::: "memory"); __builtin_amdgcn_s_barrier(); asm volatile("" ::: "memory");
}
template <int DIR>
__device__ __forceinline__ void scan_compute(Frame& F, LAS unsigned char* L, int hf, int bh, int mode) {
    const int lane = F.lane, w = F.wave, fr = lane & 15, fq = lane >> 4;
    ScanOff O;
    const int s7 = (fr >> 1) & 7;
#pragma unroll
    for (int ks = 0; ks < 4; ++ks) O.w0[ks] = (unsigned)(fr * 256 + (((4 * ks + fq) ^ fr) << 4));
#pragma unroll
    for (int k2 = 0; k2 < 2; ++k2) {
        const int ck = DIR ? 4 * (1 - k2) + (3 - fq) : 4 * k2 + fq;
        O.k0[k2] = (unsigned)(fr * 128 + ((ck ^ s7) << 4));
    }
    O.u = (unsigned)((w * 64 + lane) * 8); O.gk = (unsigned)((64 + 4 * fq) * 4);
    const int item0 = (bh * 128 + (DIR ? 127 : 0)) * 2 + DIR;
    unsigned char* sxp = F.ws + (hf ? DN_SX1 : DN_SX0) + (size_t)item0 * 16384 + w * 4096 + lane * 16;
    unsigned char* vxp = F.ws + (hf ? DN_VX1 : DN_VX0) + (size_t)item0 * 8192 + w * 2048 + lane * 16;
    const bool ex = !(mode & 1);
    f32x4 S[8];
#pragma unroll
    for (int t = 0; t < 8; ++t) S[t] = (f32x4){0.f, 0.f, 0.f, 0.f};
    __builtin_amdgcn_s_barrier(); asm volatile("" ::: "memory");
#pragma unroll 1
    for (int step = 0; step < 126; step += 3) { scan_step<DIR, 0>(L, O, S, sxp, vxp, ex); scan_step<DIR, 1>(L, O, S, sxp, vxp, ex); scan_step<DIR, 2>(L, O, S, sxp, vxp, ex); }
    scan_step<DIR, 0>(L, O, S, sxp, vxp, ex); scan_step<DIR, 1>(L, O, S, sxp, vxp, ex);
}
__device__ __forceinline__ void scan_loader(Frame& F, LAS unsigned char* L, int c, int hf, int dir, int bh, int mode) {
    const int lane = F.lane, lw = F.wave - 4;
    unsigned goff[11];
#pragma unroll
    for (int k = 0; k < 11; ++k) { const int p = lw + 4 * k, q = (p & 15) * 64 + lane;
        if (p < 16) { const int row = q >> 4, ch = (q & 15) ^ (row & 15); goff[k] = (unsigned)(row * 256 + ch * 16); }
        else if (p < 32) { const int row = q >> 3, ch = (q & 7) ^ ((row >> 1) & 7); goff[k] = (unsigned)(row * 128 + ch * 16); }
        else if (p < 40) { const int pu = p - 32; goff[k] = (unsigned)((((pu >> 1) * 8 + 4 * hf) * 512) + (pu & 1) * 1024 + lane * 16); }
        else goff[k] = (unsigned)(lane * 16); }
    unsigned* prog = (unsigned*)(F.ctl + CW_PROG + 2048 * F.li + 64 * (c * 2 + hf));
    auto issue = [&](int t, LAS unsigned char* B) {
        const int nc = dir ? 127 - t : t, un = bh * 128 + nc, item = un * 2 + dir;
        const unsigned char* gW = F.ws + DN_W + (size_t)item * 16384; const unsigned char* gK = F.ws + DN_KT + (size_t)un * 16384;
        const unsigned char* gU = F.ws + DN_U + (size_t)item * 16384; const unsigned char* gG = F.ws + DN_GV + (size_t)item * 512;
#pragma unroll
        for (int k = 0; k < 11; ++k) { const int p = lw + 4 * k;
            if (k < 4) glds16(gW + goff[k], B + RB_W + p * 1024);
            else if (k < 8) glds16(gK + goff[k], B + RB_KT + (p - 16) * 1024);
            else if (k < 10) glds16(gU + goff[k], B + RB_U + (p - 32) * 1024);
            else if (lw == 0) glds16(gG + goff[k], B + RB_GV); }
    };
    if (!(mode & 2)) issue(0, L);
    int nb = 1;
#pragma unroll 1
    for (int k = 0; k <= 128; ++k) {
        if (k + 1 < 128 && !(mode & 2)) { issue(k + 1, L + nb * RB_SIZE);
            if (lw == 0) asm volatile("s_waitcnt vmcnt(11)" ::: "memory"); else asm volatile("s_waitcnt vmcnt(10)" ::: "memory"); }
        else asm volatile("s_waitcnt vmcnt(0)" ::: "memory");
        if (++nb == 3) nb = 0;
        __builtin_amdgcn_s_barrier(); asm volatile("" ::: "memory");
        if (lw == 0 && lane == 0 && k >= 3 && !(mode & 1)) __hip_atomic_store(prog, (unsigned)(k - 2), RLX_AGENT);
    }
}
__device__ __forceinline__ void p3_scan(Frame& F, int c, int hf, int mode  ) {
    const int b = c >> 3, h = (c >> 1) & 3, dir = c & 1, bh = b * 4 + h;
    LAS unsigned char* L = F.lds;
    if (F.wave >= 4) scan_loader(F, L, c, hf, dir, bh, mode);
    else if (dir) scan_compute<1>(F, L, hf, bh, mode); else scan_compute<0>(F, L, hf, bh, mode);
    asm volatile("s_waitcnt vmcnt(0) lgkmcnt(0)" ::: "memory"); __syncthreads();
    if (F.tid == 256 && !(mode & 1)) __hip_atomic_store((unsigned*)(F.ctl + CW_PROG + 2048 * F.li + 64 * (c * 2 + hf)), 128u, RLX_AGENT);
    __syncthreads();
}

constexpr int OL_Q = 0, OL_AT = 16384, OL_SX = 24576, OL_VX = 40960, OL_GV = 49152, OL_SIZE = 50176;
__device__ __forceinline__ void p3_out_issue(Frame& F, int j, LAS unsigned char* Lb) {
    const int lane = F.lane, w = F.wave;
    const int n = j >> 5, wg = j & 31, c = wg >> 1, hf = wg & 1, b = c >> 3, h = (c >> 1) & 3, dir = c & 1, bh = b * 4 + h;
    const int nc = dir ? 127 - n : n, un = bh * 128 + nc, item = un * 2 + dir;
    const unsigned char* gQ = F.ws + DN_QS + (size_t)un * 16384; const unsigned char* gA = F.ws + DN_AT + (size_t)item * 8192;
    const unsigned char* gS = F.ws + (hf ? DN_SX1 : DN_SX0) + (size_t)item * 16384; const unsigned char* gV = F.ws + (hf ? DN_VX1 : DN_VX0) + (size_t)item * 8192;
#pragma unroll
    for (int k = 0; k < 2; ++k) { const int p = 2 * w + k, q = p * 64 + lane, row = q >> 4, ch = (q & 15) ^ (row & 15);
        glds16(gQ + row * 256 + ch * 16, Lb + OL_Q + p * 1024); glds16_sc1(gS + p * 1024 + lane * 16, Lb + OL_SX + p * 1024); }
    { const int q = w * 64 + lane, row = q >> 3, ch = (q & 7) ^ ((row >> 1) & 7); glds16(gA + row * 128 + ch * 16, Lb + OL_AT + w * 1024); glds16_sc1(gV + w * 1024 + lane * 16, Lb + OL_VX + w * 1024); }
    if (w == 0) glds16(F.ws + DN_GV + (size_t)item * 512 + lane * 16, Lb + OL_GV);
}
__device__ __forceinline__ void p3_out_compute(Frame& F, int j, const LAS unsigned char* Lb, float* odir) {
    const int lane = F.lane, w = F.wave, fr = lane & 15, fq = lane >> 4, mi = w >> 1, eh = w & 1;
    const int n = j >> 5, wg = j & 31, c = wg >> 1, hf = wg & 1, b = c >> 3, h = (c >> 1) & 3, dir = c & 1;
    const int nc = dir ? 127 - n : n;
    const int irow = 16 * mi + fr, qrow = dir ? 63 - irow : irow;
    const int hb = 8 * (fq & 1), fh = fq >> 1;
    f32x4 aQ[2];
#pragma unroll
    for (int t = 0; t < 2; ++t) aQ[t] = (f32x4){0.f, 0.f, 0.f, 0.f};
#pragma unroll
    for (int ks = 0; ks < 4; ++ks) {
        const bf16x8 fqv = ld2x8(Lb + OL_Q + qrow * 256 + (((4 * ks + fh) ^ (qrow & 15)) << 4) + hb, Lb + OL_Q + qrow * 256 + (((4 * ks + 2 + fh) ^ (qrow & 15)) << 4) + hb);
#pragma unroll
        for (int t = 0; t < 2; ++t) { const bf16x8 fs = *(const LAS bf16x8*)(Lb + OL_SX + ((2 * eh + t) * 4 + ks) * 1024 + lane * 16); aQ[t] = MFMA16(fs, fqv, aQ[t]); }
    }
    const float egc_i = ((const LAS float*)(Lb + OL_GV))[irow];
#pragma unroll
    for (int t = 0; t < 2; ++t) aQ[t] = aQ[t] * egc_i;
#pragma unroll
    for (int ks = 0; ks < 2; ++ks) {
        const bf16x8 fa = ld2x8(Lb + OL_AT + irow * 128 + (((4 * ks + fh) ^ ((irow >> 1) & 7)) << 4) + hb, Lb + OL_AT + irow * 128 + (((4 * ks + 2 + fh) ^ ((irow >> 1) & 7)) << 4) + hb);
#pragma unroll
        for (int t = 0; t < 2; ++t) { const bf16x8 fv = *(const LAS bf16x8*)(Lb + OL_VX + ((2 * eh + t) * 2 + ks) * 1024 + lane * 16); aQ[t] = MFMA16(fv, fa, aQ[t]); }
    }
    const size_t tok = (size_t)b * SEQ + 64 * nc + qrow;
    float* op = odir + ((size_t)dir * T + tok) * 512 + h * 128 + 64 * hf + 4 * fq;
#pragma unroll
    for (int t = 0; t < 2; ++t) *(GAS f32x4*)(op + 16 * (2 * eh + t)) = aQ[t];
}
__device__ __forceinline__ void p3_out_batch(Frame& F, int j0, int cnt  , float* odir) {
    const int n = j0 >> 5;
    LAS unsigned char* L = F.lds;
    if (F.tid < 64) { unsigned sp = 0;
        for (;;) { bool ok = true; if (F.tid < cnt) ok = (int)__hip_atomic_load((unsigned*)(F.ctl + CW_PROG + 2048 * F.li + 64 * ((j0 & 31) + F.tid)), RLX_AGENT) > n;
            if (__all(ok) || ++sp > (1u << 22)) break; __builtin_amdgcn_s_sleep(127); __builtin_amdgcn_s_sleep(127); } }
    __syncthreads();
    p3_out_issue(F, j0, L); p3_out_issue(F, j0 + (cnt > 1 ? 1 : 0), L + OL_SIZE);
    int bk = 0;
#pragma unroll 1
    for (int k = 0; k < cnt; ++k) {
        asm volatile("s_waitcnt vmcnt(6) lgkmcnt(0)" ::: "memory"); __builtin_amdgcn_s_barrier(); asm volatile("" ::: "memory");
        { int b2 = bk + 2; if (b2 >= 3) b2 -= 3; const int kn = k + 2 < cnt ? k + 2 : cnt - 1; p3_out_issue(F, j0 + kn, L + b2 * OL_SIZE); }
        p3_out_compute(F, j0 + k, L + bk * OL_SIZE, odir);
        if (++bk == 3) bk = 0;
    }
    asm volatile("s_waitcnt vmcnt(0) lgkmcnt(0)" ::: "memory"); __syncthreads();
}
typedef float f32x16 __attribute__((ext_vector_type(16)));
#define MFMA32(a, b, c) __builtin_amdgcn_mfma_f32_32x32x16_bf16((a), (b), (c), 0, 0, 0)
constexpr size_t WS_ROT = WS_CTL + 256 * 1024;
constexpr int VT_PITCH = 324;
constexpr int CW_WQ = 49152;
constexpr int LT_WQ = LDSCTL_OFF + 512;

__device__ __forceinline__ void p0_rot_table(Frame& F) {
    float* rot = (float*)(F.ws + WS_ROT);
    for (int i = (F.vcu * NTHR + F.tid); i < SEQ * 8; i += F.G * NTHR) { const int s = i >> 3, k = i & 7;
        const float inv = powf(500000.f, -(float)(2 * k) / 16.f); float sn, cs; sincosf((float)s * inv, &sn, &cs); rot[2 * i] = cs; rot[2 * i + 1] = sn; }
}

__device__ __forceinline__ void p3_attn_unit(Frame& F, int unit, const float* sink) {
    const int tid = F.tid, lane = F.lane, w = F.wave, r = lane & 31, hh = lane >> 5;
    const int b = unit >> 8, kvh = (unit >> 7) & 1, qt = unit & 127, k0 = 64 * qt - 128;
    const bf16* proj = (const bf16*)(F.ws + WS_PROJ); const float* rot = (const float*)(F.ws + WS_ROT);
    LAS bf16* KLs = (LAS bf16*)F.lds;
    LAS bf16* VTs = (LAS bf16*)(F.lds + 40960);
#pragma unroll 1
    for (int idx = tid; idx < 320 * 8; idx += NTHR) {
        const int key = idx >> 3, ch = idx & 7, kp = k0 + key;
        v4u kv = (v4u){0u, 0u, 0u, 0u}, vv = (v4u){0u, 0u, 0u, 0u};
        if (kp >= 0 && kp < SEQ) {
            const bf16* rowp = proj + (size_t)(b * SEQ + kp) * NPROJ;
            vv = *(const GAS v4u*)(rowp + PJ_AV + kvh * 64 + ch * 8);
            if (ch >= 2) kv = *(const GAS v4u*)(rowp + PJ_AK + kvh * 64 + ch * 8);
            else {
                const v4u a = *(const GAS v4u*)(rowp + PJ_AK + kvh * 64), c = *(const GAS v4u*)(rowp + PJ_AK + kvh * 64 + 8);
                const float* rp = rot + (size_t)kp * 16; float o[8];
#pragma unroll
                for (int i = 0; i < 8; ++i) { const unsigned ua = a[i >> 1], uc = c[i >> 1];
                    const float x1 = bf2f((unsigned short)((i & 1) ? (ua >> 16) : (ua & 0xffffu))), x2 = bf2f((unsigned short)((i & 1) ? (uc >> 16) : (uc & 0xffffu)));
                    const float cs = rp[2 * i], sn = rp[2 * i + 1]; o[i] = ch == 0 ? x1 * cs - x2 * sn : x2 * cs + x1 * sn; }
                kv.x = pk2(o[0], o[1]); kv.y = pk2(o[2], o[3]); kv.z = pk2(o[4], o[5]); kv.w = pk2(o[6], o[7]);
            }
        }
        *(LAS v4u*)(KLs + key * 64 + ((ch ^ ((key >> 1) & 7)) << 3)) = kv;
#pragma unroll
        for (int i = 0; i < 8; ++i) { const unsigned u = vv[i >> 1]; VTs[(ch * 8 + i) * VT_PITCH + key] = (bf16)((i & 1) ? (u >> 16) : (u & 0xffffu)); }
    }
    const int hq = kvh * 4 + (w >> 1), qp = 64 * qt + 32 * (w & 1) + r;
    const bf16* qrow = proj + (size_t)(b * SEQ + qp) * NPROJ + PJ_AQ + hq * 64;
    bf16x8 qf[4];
    {
        const v4u a = *(const GAS v4u*)(qrow), c = *(const GAS v4u*)(qrow + 8);
        const float* rp = rot + (size_t)qp * 16; float o[8];
#pragma unroll
        for (int i = 0; i < 8; ++i) { const unsigned ua = a[i >> 1], uc = c[i >> 1];
            const float x1 = bf2f((unsigned short)((i & 1) ? (ua >> 16) : (ua & 0xffffu))), x2 = bf2f((unsigned short)((i & 1) ? (uc >> 16) : (uc & 0xffffu)));
            const float cs = rp[2 * i], sn = rp[2 * i + 1]; o[i] = (hh == 0 ? x1 * cs - x2 * sn : x2 * cs + x1 * sn) * 0.125f; }
        v4u q0; q0.x = pk2(o[0], o[1]); q0.y = pk2(o[2], o[3]); q0.z = pk2(o[4], o[5]); q0.w = pk2(o[6], o[7]);
        qf[0] = __builtin_bit_cast(bf16x8, q0);
#pragma unroll
        for (int s = 1; s < 4; ++s) { const v4u q = *(const GAS v4u*)(qrow + 16 * s + 8 * hh); float t[8];
#pragma unroll
            for (int i = 0; i < 8; ++i) { const unsigned u = q[i >> 1]; t[i] = bf2f((unsigned short)((i & 1) ? (u >> 16) : (u & 0xffffu))) * 0.125f; }
            v4u qq; qq.x = pk2(t[0], t[1]); qq.y = pk2(t[2], t[3]); qq.z = pk2(t[4], t[5]); qq.w = pk2(t[6], t[7]); qf[s] = __builtin_bit_cast(bf16x8, qq); }
    }
    __syncthreads();
    float m = sink[hq], l = hh == 0 ? 1.f : 0.f;
    f32x16 O[2];
#pragma unroll
    for (int i = 0; i < 16; ++i) { O[0][i] = 0.f; O[1][i] = 0.f; }
#pragma unroll 1
    for (int kb = (w & 1); kb < (w & 1) + 9; ++kb) {
        f32x16 X;
#pragma unroll
        for (int i = 0; i < 16; ++i) X[i] = 0.f;
        const int krow = 32 * kb + r;
#pragma unroll
        for (int s = 0; s < 4; ++s) { const bf16x8 ka = *(const LAS bf16x8*)(KLs + krow * 64 + (((2 * s + hh) ^ ((krow >> 1) & 7)) << 3)); X = MFMA32(ka, qf[s], X); }
        float bm = -1e30f;
#pragma unroll
        for (int i = 0; i < 16; ++i) { const int kp = k0 + 32 * kb + (i & 3) + 8 * (i >> 2) + 4 * hh, dlt = qp - kp;
            const bool ok = (dlt <= 128) && (dlt >= -128) && (kp >= 0) && (kp < SEQ); X[i] = ok ? X[i] : -1e30f; bm = fmaxf(bm, X[i]); }
        bm = fmaxf(bm, __shfl_xor(bm, 32));
        const float mn = fmaxf(m, bm), alpha = __expf(m - mn); m = mn;
        float ps = 0.f;
#pragma unroll
        for (int i = 0; i < 16; ++i) { X[i] = __expf(X[i] - mn); ps += X[i]; }
        l = l * alpha + ps;
#pragma unroll
        for (int i = 0; i < 16; ++i) { O[0][i] *= alpha; O[1][i] *= alpha; }
        bf16x8 pk[2];
#pragma unroll
        for (int s = 0; s < 2; ++s) { v4u t; t.x = pk2(X[8 * s], X[8 * s + 1]); t.y = pk2(X[8 * s + 2], X[8 * s + 3]); t.z = pk2(X[8 * s + 4], X[8 * s + 5]); t.w = pk2(X[8 * s + 6], X[8 * s + 7]); pk[s] = __builtin_bit_cast(bf16x8, t); }
#pragma unroll
        for (int dt = 0; dt < 2; ++dt)
#pragma unroll
            for (int s = 0; s < 2; ++s) { const LAS bf16* vp = VTs + (32 * dt + r) * VT_PITCH + 32 * kb + 16 * s + 4 * hh;
                const v2u lo = *(const LAS v2u*)vp, hi = *(const LAS v2u*)(vp + 8); v4u va; va.x = lo.x; va.y = lo.y; va.z = hi.x; va.w = hi.y;
                O[dt] = MFMA32(__builtin_bit_cast(bf16x8, va), pk[s], O[dt]); }
    }
    l += __shfl_xor(l, 32);
    const float inv = 1.f / l;
    bf16* orow = (bf16*)(F.ws + WS_MIX) + (size_t)(b * SEQ + qp) * D + 512 + hq * 64;
#pragma unroll
    for (int dt = 0; dt < 2; ++dt)
#pragma unroll
        for (int g = 0; g < 4; ++g) { v2u o; o.x = pk2(O[dt][4 * g] * inv, O[dt][4 * g + 1] * inv); o.y = pk2(O[dt][4 * g + 2] * inv, O[dt][4 * g + 3] * inv);
            *(GAS v2u*)(orow + 32 * dt + 8 * g + 4 * hh) = o; }
    __syncthreads();
}

__device__ __forceinline__ void p3_moe_weight_items(Frame& F, int first_wave, int n_waves, int end_item, const float* w_gu, const float* w_dn) {
    LAS float* scr = (LAS float*)(F.lds + F.wave * 16384);
    bf16* Wgu_t = (bf16*)(F.ws + WS_WGU); bf16* Wd_t = (bf16*)(F.ws + WS_WD);
    constexpr int I_GU = NEXP * 16 * 16, I_DN = NEXP * 4 * 32;
#pragma unroll 1
    for (int it = first_wave; it < end_item; it += n_waves) {
        if (it < I_GU) { const int e = it >> 8, kb = (it >> 4) & 15, nb = it & 15, n0 = 32 * nb, pn = n0 >> 8, bj = (n0 >> 7) & 1, c = n0 & 127;
            transpose_item(w_gu + (size_t)e * D * 512, 512, bj * 256 + pn * 128 + c, 64 * kb, Wgu_t + (size_t)e * 512 * D, D, n0, scr, F.lane); }
        else { const int r2 = it - I_GU, e = r2 >> 7, kb = (r2 >> 5) & 3, nb = r2 & 31; transpose_item(w_dn + (size_t)e * EFF * D, D, 32 * nb, 64 * kb, Wd_t + (size_t)e * D * EFF, EFF, 32 * nb, scr, F.lane); }
    }
}

__device__ __forceinline__ void p4_combine(Frame& F, const float* odir, const float* normw) {
    const int gw = F.vcu * NWAVES + F.wave, NGW = F.G * NWAVES, lane = F.lane;
    const bf16* proj = (const bf16*)(F.ws + WS_PROJ); bf16* mix = (bf16*)(F.ws + WS_MIX);
    const f32x4 nw0 = *(const f32x4*)(normw + 8 * (lane & 15)), nw1 = *(const f32x4*)(normw + 8 * (lane & 15) + 4);
#pragma unroll 1
    for (int tok = gw; tok < T; tok += NGW) {
        const float* of = odir + (size_t)tok * 512 + 8 * lane; const float* ob = of + (size_t)T * 512;
        const f32x4 a0 = *(const GAS f32x4*)of + *(const GAS f32x4*)ob, a1 = *(const GAS f32x4*)(of + 4) + *(const GAS f32x4*)(ob + 4);
        float s = (a0.x * a0.x + a0.y * a0.y) + (a0.z * a0.z + a0.w * a0.w) + (a1.x * a1.x + a1.y * a1.y) + (a1.z * a1.z + a1.w * a1.w);
        s += __shfl_xor(s, 1); s += __shfl_xor(s, 2); s += __shfl_xor(s, 4); s += __shfl_xor(s, 8);
        const float rs = rsqrtf(s * (1.f / 128.f) + EPS);
        const v4u zz = *(const GAS v4u*)(proj + (size_t)tok * NPROJ + PJ_Z + 8 * lane);
        float z[8];
#pragma unroll
        for (int i = 0; i < 8; ++i) { const unsigned u = zz[i >> 1]; z[i] = bf2f((unsigned short)((i & 1) ? (u >> 16) : (u & 0xffffu))); }
        v4u o;
        o.x = pk2(a0.x * rs * nw0.x * silu_f(z[0]), a0.y * rs * nw0.y * silu_f(z[1])); o.y = pk2(a0.z * rs * nw0.z * silu_f(z[2]), a0.w * rs * nw0.w * silu_f(z[3]));
        o.z = pk2(a1.x * rs * nw1.x * silu_f(z[4]), a1.y * rs * nw1.y * silu_f(z[5])); o.w = pk2(a1.z * rs * nw1.z * silu_f(z[6]), a1.w * rs * nw1.w * silu_f(z[7]));
        *(GAS v4u*)(mix + (size_t)tok * D + 8 * lane) = o;
    }
}
constexpr size_t WS_RW = 488 * MiB;
constexpr size_t RW_HI = WS_RW, RW_LO = WS_RW + 256 * 1024, RW_RSTD = WS_RW + 512 * 1024, RW_GATE = WS_RW + 640 * 1024;
constexpr size_t WS_LIST = WS_MISC + 2 * MiB;
constexpr size_t WS_XS = WS_DN, WS_HMID = WS_DN + 96 * MiB, WS_Y2 = WS_DN + 120 * MiB;
constexpr int CW_CNT = 32768;
constexpr int LT_PSTART = LDSCTL_OFF + 1024, LT_PTAB = LDSCTL_OFF + 1536;

__device__ __forceinline__ void p0_router_weights(Frame& F, const float* lnw, const float* wg, const float* we) {
    bf16* hi = (bf16*)(F.ws + RW_HI); bf16* lo = (bf16*)(F.ws + RW_LO);
    for (int i = F.vcu * NTHR + F.tid; i < 80 * D; i += F.G * NTHR) { const int n = i >> 10, k = i & 1023;
        float v = 0.f; if (n < 8) v = wg[k * 8 + n] * lnw[k]; else if (n < 72) v = we[k * 64 + (n - 8)] * lnw[k];
        const unsigned h = f2bf(v); const float r = v - bf2f((unsigned short)h); hi[i] = (bf16)h; lo[i] = (bf16)f2bf(r); }
}
__device__ __forceinline__ void split8(const f32x4 a, const f32x4 b, bf16x8& h, bf16x8& l) {
    const float x[8] = {a.x, a.y, a.z, a.w, b.x, b.y, b.z, b.w}; unsigned hh[8], ll[8];
#pragma unroll
    for (int i = 0; i < 8; ++i) { hh[i] = f2bf(x[i]); ll[i] = f2bf(x[i] - bf2f((unsigned short)hh[i])); }
    v4u vh, vl; vh.x = hh[0] | (hh[1] << 16); vh.y = hh[2] | (hh[3] << 16); vh.z = hh[4] | (hh[5] << 16); vh.w = hh[6] | (hh[7] << 16);
    vl.x = ll[0] | (ll[1] << 16); vl.y = ll[2] | (ll[3] << 16); vl.z = ll[4] | (ll[5] << 16); vl.w = ll[6] | (ll[7] << 16);
    h = __builtin_bit_cast(bf16x8, vh); l = __builtin_bit_cast(bf16x8, vl);
}
__device__ __forceinline__ void p6_route(Frame& F, const float* lnw, const float* bgrp, const float* bexp, int dry) {
    const int lane = F.lane, w = F.wave, fr = lane & 15, fq = lane >> 4;
    const float* x1 = F.out; bf16* h2u = (bf16*)(F.ws + WS_HN);
    const bf16* Wh = (const bf16*)(F.ws + RW_HI); const bf16* Wl = (const bf16*)(F.ws + RW_LO);
    LAS float* PL = (LAS float*)F.lds;
    LAS float* PS = PL + 8 * 32 * 80;
    LAS float* LG = PS + 8 * 32;
    LAS float* RS = LG + 32 * 80;
    LAS int* LC = (LAS int*)(RS + 32);
    LAS int* PK = LC + 64;
    unsigned* cnt = (unsigned*)(F.ctl + CW_CNT + (dry ? 24576 : 0)); int* list = (int*)(F.ws + (dry ? WS_DN + 196 * MiB : WS_LIST)); float* pgate = (float*)(F.ws + RW_GATE); float* rstd_g = (float*)(F.ws + RW_RSTD);
#pragma unroll 1
    for (int grp = blockIdx.x; grp < T / 64; grp += F.G) {
        if (F.tid < 64) LC[F.tid] = 0;
        f32x4 acc[4][5]; float ss[4];
#pragma unroll
        for (int tl = 0; tl < 4; ++tl) { ss[tl] = 0.f;
#pragma unroll
            for (int c = 0; c < 5; ++c) acc[tl][c] = (f32x4){0.f, 0.f, 0.f, 0.f}; }
#pragma unroll 1
        for (int kk = 0; kk < 4; ++kk) {
            const int k0 = 32 * (4 * w + kk) + 8 * fq;
            bf16x8 bh[5], bl[5];
#pragma unroll
            for (int c = 0; c < 5; ++c) { bh[c] = *(const GAS bf16x8*)(Wh + (size_t)(16 * c + fr) * D + k0); bl[c] = *(const GAS bf16x8*)(Wl + (size_t)(16 * c + fr) * D + k0); }
            const f32x4 la = *(const f32x4*)(lnw + k0), lb = *(const f32x4*)(lnw + k0 + 4);
#pragma unroll
            for (int tl = 0; tl < 4; ++tl) {
                const int tok = (grp * 4 + tl) * 16 + fr;
                const f32x4 xa = *(const GAS f32x4*)(x1 + (size_t)tok * D + k0), xb = *(const GAS f32x4*)(x1 + (size_t)tok * D + k0 + 4);
                ss[tl] += (xa.x * xa.x + xa.y * xa.y) + (xa.z * xa.z + xa.w * xa.w) + (xb.x * xb.x + xb.y * xb.y) + (xb.z * xb.z + xb.w * xb.w);
                v4u ho; ho.x = pk2(xa.x * la.x, xa.y * la.y); ho.y = pk2(xa.z * la.z, xa.w * la.w); ho.z = pk2(xb.x * lb.x, xb.y * lb.y); ho.w = pk2(xb.z * lb.z, xb.w * lb.w);
                *(GAS v4u*)(h2u + (size_t)tok * D + k0) = ho;
                bf16x8 ah, al; split8(xa, xb, ah, al);
#pragma unroll
                for (int c = 0; c < 5; ++c) { acc[tl][c] = MFMA16(ah, bh[c], acc[tl][c]); acc[tl][c] = MFMA16(al, bh[c], acc[tl][c]); acc[tl][c] = MFMA16(ah, bl[c], acc[tl][c]); }
            }
        }
#pragma unroll
        for (int tl = 0; tl < 4; ++tl) { ss[tl] += __shfl_xor(ss[tl], 16); ss[tl] += __shfl_xor(ss[tl], 32); }
#pragma unroll
        for (int rd = 0; rd < 2; ++rd) {
#pragma unroll
            for (int t2 = 0; t2 < 2; ++t2) { const int tl = 2 * rd + t2;
#pragma unroll
                for (int c = 0; c < 5; ++c)
#pragma unroll
                    for (int r = 0; r < 4; ++r) PL[(w * 32 + t2 * 16 + 4 * fq + r) * 80 + 16 * c + fr] = acc[tl][c][r];
                if (lane < 16) PS[w * 32 + t2 * 16 + lane] = ss[tl]; }
            __syncthreads();
            for (int i = F.tid; i < 32 * 80; i += NTHR) { float s = 0.f;
#pragma unroll
                for (int ww = 0; ww < 8; ++ww) s += PL[ww * 2560 + i];
                LG[i] = s; }
            if (F.tid < 32) { float s = 0.f;
#pragma unroll
                for (int ww = 0; ww < 8; ++ww) s += PS[ww * 32 + F.tid];
                RS[F.tid] = rsqrtf(s * (1.f / D) + EPS); }
            __syncthreads();
            if (F.tid < 32) {
                const LAS float* lg = LG + F.tid * 80; const float rs = RS[F.tid];
                float gl[8]; int gi = 0; float gm = -1e30f;
#pragma unroll
                for (int g = 0; g < 8; ++g) { gl[g] = lg[g] * rs + bgrp[g]; if (gl[g] > gm) { gm = gl[g]; gi = g; } }
                float gs = 0.f;
#pragma unroll
                for (int g = 0; g < 8; ++g) gs += expf(gl[g] - gm);
                const float pg = 1.f / gs;
                float el[8]; int e1 = 0; float m1 = -1e30f;
#pragma unroll
                for (int e = 0; e < 8; ++e) { el[e] = lg[8 + gi * 8 + e] * rs + bexp[gi * 8 + e]; if (el[e] > m1) { m1 = el[e]; e1 = e; } }
                int e2 = 0; float m2 = -1e30f;
#pragma unroll
                for (int e = 0; e < 8; ++e) if (e != e1 && el[e] > m2) { m2 = el[e]; e2 = e; }
                const float p2 = expf(m2 - m1), inv = 1.f / (1.f + p2);
                const int E1 = gi * 8 + e1, E2 = gi * 8 + e2, lt = 32 * rd + F.tid, tk = grp * 64 + lt;
                const int r1 = __hip_atomic_fetch_add(LC + E1, 1, __ATOMIC_RELAXED, __HIP_MEMORY_SCOPE_WORKGROUP), r2 = __hip_atomic_fetch_add(LC + E2, 1, __ATOMIC_RELAXED, __HIP_MEMORY_SCOPE_WORKGROUP);
                PK[lt * 4] = E1; PK[lt * 4 + 1] = E2; PK[lt * 4 + 2] = r1; PK[lt * 4 + 3] = r2;
                pgate[tk * 2] = pg * inv; pgate[tk * 2 + 1] = pg * p2 * inv; rstd_g[tk] = rs;
            }
            __syncthreads();
        }
        if (F.tid < 64) { const int n = LC[F.tid]; LC[F.tid] = n ? (int)atomicAdd(cnt + 64 * F.tid, (unsigned)n) : 0; }
        __syncthreads();
        if (F.tid < 64) { const int E1 = PK[F.tid * 4], E2 = PK[F.tid * 4 + 1], tk = grp * 64 + F.tid;
            list[E1 * 16384 + LC[E1] + PK[F.tid * 4 + 2]] = tk * 2; list[E2 * 16384 + LC[E2] + PK[F.tid * 4 + 3]] = tk * 2 + 1; }
        __syncthreads();
    }
}
__device__ __forceinline__ int moe_tables(Frame& F) {
    LAS int* pstart = (LAS int*)(F.lds + LT_PSTART); LAS int* ptab = (LAS int*)(F.lds + LT_PTAB);
    if (F.tid < 64) { const int c = (int)__hip_atomic_load((unsigned*)(F.ctl + CW_CNT) + 64 * F.tid, RLX_AGENT); const int np = (c + 255) >> 8; int ps = np;
#pragma unroll
        for (int o = 1; o < 64; o <<= 1) { const int t = __shfl_up(ps, o); if (F.lane >= o) ps += t; }
        const int st = ps - np; pstart[F.tid] = st; if (F.tid == 63) pstart[64] = ps;
        for (int j = 0; j < np; ++j) ptab[st + j] = F.tid | (j << 8); }
    __syncthreads();
    return pstart[64];
}
__device__ __forceinline__ void p7_gather(Frame& F, int NP) {
    const LAS int* ptab = (const LAS int*)(F.lds + LT_PTAB);
    const int gw = F.vcu * NWAVES + F.wave, NGW = F.G * NWAVES, lane = F.lane;
    const bf16* h2u = (const bf16*)(F.ws + WS_HN); bf16* xs = (bf16*)(F.ws + WS_XS); const int* list = (const int*)(F.ws + WS_LIST);
    const unsigned* cnt = (const unsigned*)(F.ctl + CW_CNT);
#pragma unroll 1
    for (int rid = gw; rid < NP * 256; rid += NGW) { const int pt = ptab[rid >> 8], e = pt & 255, local = (pt >> 8) * 256 + (rid & 255);
        if (local < (int)cnt[64 * e]) { const int tok = list[e * 16384 + local] >> 1;
            const GAS v4u* src = (const GAS v4u*)(h2u + (size_t)tok * D); GAS v4u* dst = (GAS v4u*)(xs + (size_t)rid * D);
            const v4u a = src[lane], b = src[lane + 64]; dst[lane] = a; dst[lane + 64] = b; } }
}
template <bool GATHER_>
struct MoeOrderT {
    static constexpr bool GATHER = GATHER_;
    int nunits, G, c, SH; const LAS int* ptab; const int* list; const unsigned* cnt; unsigned rowbytes;
    __device__ __forceinline__ unsigned row_off(const pg8::Unit& u, int r) const {
        const int pt = ptab[u.pm], e = pt & 255, local = (pt >> 8) * 256 + r;
        return local < (int)cnt[64 * e] ? (unsigned)(list[e * 16384 + local] >> 1) * rowbytes : 0u; }
    __device__ __forceinline__ bool next(int i, pg8::Unit& u) const { const int L = i * G + c; if (L >= nunits) return false; const int p = L >> SH; u.pm = p; u.pn = ((ptab[p] & 255) << SH) + (L & ((1 << SH) - 1)); return true; }
    __device__ __forceinline__ void a_ready(const pg8::Unit&) const {}
    __device__ __forceinline__ void done(const pg8::Unit&) const {}
};
typedef MoeOrderT<false> MoeOrder; typedef MoeOrderT<true> MoeGatherOrder;
struct EpiSwiGLU {
    static constexpr bool PERM = true, AFTER_DRAIN = false;
    bf16* hmid; const int* list; const unsigned* cnt; const float* rstd; const LAS int* ptab;
    __device__ __forceinline__ void operator()(const pg8::f32x4 (&acc)[2][2][4][2], const pg8::Unit& u, int wr, int wc, int fr, int fq) const {
        const int pt = ptab[u.pm], e = pt & 255, lbase = (pt >> 8) * 256, n_e = (int)cnt[64 * e], pnl = u.pn & 1;
#pragma unroll
        for (int ai = 0; ai < 2; ++ai)
#pragma unroll
            for (int m = 0; m < 4; ++m) { const int rl = ai * 128 + wr * 64 + m * 16 + fr;
                if (lbase + rl < n_e) { const float rs = rstd[list[e * 16384 + lbase + rl] >> 1];
                    float h[8];
#pragma unroll
                    for (int n = 0; n < 2; ++n)
#pragma unroll
                        for (int k = 0; k < 4; ++k) h[4 * n + k] = silu_f(acc[ai][0][m][n][k] * rs) * (acc[ai][1][m][n][k] * rs);
                    v4u o; o.x = pk2(h[0], h[1]); o.y = pk2(h[2], h[3]); o.z = pk2(h[4], h[5]); o.w = pk2(h[6], h[7]);
                    *(GAS v4u*)(hmid + (size_t)(u.pm * 256 + rl) * EFF + pnl * 128 + wc * 32 + 8 * fq) = o; } }
    }
};
struct EpiDown {
    static constexpr bool PERM = true, AFTER_DRAIN = false;
    bf16* y2; const int* list; const unsigned* cnt; const float* gate; const LAS int* ptab;
    __device__ __forceinline__ void operator()(const pg8::f32x4 (&acc)[2][2][4][2], const pg8::Unit& u, int wr, int wc, int fr, int fq) const {
        const int pt = ptab[u.pm], e = pt & 255, lbase = (pt >> 8) * 256, n_e = (int)cnt[64 * e], pnl = u.pn & 3;
#pragma unroll
        for (int ai = 0; ai < 2; ++ai)
#pragma unroll
            for (int m = 0; m < 4; ++m) { const int rl = ai * 128 + wr * 64 + m * 16 + fr;
                if (lbase + rl < n_e) { const int pair = list[e * 16384 + lbase + rl]; const float g = gate[pair];
#pragma unroll
                    for (int bj = 0; bj < 2; ++bj) { const pg8::f32x4 v0 = acc[ai][bj][m][0] * g, v1 = acc[ai][bj][m][1] * g;
                        v4u o; o.x = pk2(v0[0], v0[1]); o.y = pk2(v0[2], v0[3]); o.z = pk2(v1[0], v1[1]); o.w = pk2(v1[2], v1[3]);
                        *(GAS v4u*)(y2 + (size_t)pair * D + pnl * 256 + bj * 128 + wc * 32 + 8 * fq) = o; } } }
    }
};
__device__ __forceinline__ void p10_final(Frame& F, const float* lnw, float* dst) {
    const int gw = F.vcu * NWAVES + F.wave, NGW = F.G * NWAVES, lane = F.lane;
    const bf16* y2 = (const bf16*)(F.ws + WS_Y2);
    f32x4 lw[4];
#pragma unroll
    for (int j = 0; j < 4; ++j) lw[j] = ((const f32x4*)lnw)[lane + 64 * j];
#pragma unroll 1
    for (int tok = gw; tok < T; tok += NGW) {
        GAS f32x4* xr = (GAS f32x4*)(F.out + (size_t)tok * D) + lane;
        const GAS v2u* ya = (const GAS v2u*)(y2 + (size_t)(2 * tok) * D) + lane; const GAS v2u* yb = (const GAS v2u*)(y2 + (size_t)(2 * tok + 1) * D) + lane;
        f32x4 v[4]; float s = 0.f;
#pragma unroll
        for (int j = 0; j < 4; ++j) { const f32x4 x = xr[64 * j]; const v2u a = ya[64 * j], b = yb[64 * j];
            v[j].x = x.x + (bf2f((unsigned short)(a.x & 0xffffu)) + bf2f((unsigned short)(b.x & 0xffffu))); v[j].y = x.y + (bf2f((unsigned short)(a.x >> 16)) + bf2f((unsigned short)(b.x >> 16)));
            v[j].z = x.z + (bf2f((unsigned short)(a.y & 0xffffu)) + bf2f((unsigned short)(b.y & 0xffffu))); v[j].w = x.w + (bf2f((unsigned short)(a.y >> 16)) + bf2f((unsigned short)(b.y >> 16)));
            s += (v[j].x * v[j].x + v[j].y * v[j].y) + (v[j].z * v[j].z + v[j].w * v[j].w); }
        const float r = rsqrtf(wave_sum(s) * (1.f / D) + EPS);
        GAS f32x4* xo = (GAS f32x4*)(dst + (size_t)tok * D) + lane;
#pragma unroll
        for (int j = 0; j < 4; ++j) xo[64 * j] = v[j] * r * lw[j];
    }
}
struct EpiResF32 {
    static constexpr bool PERM = false, AFTER_DRAIN = false;
    const float* base; float* out; int ldc;
    __device__ __forceinline__ void operator()(const pg8::f32x4 (&acc)[2][2][4][2], const pg8::Unit& u, int wr, int wc, int fr, int fq) const {
        const int col0 = u.pn * 256 + wc * 32 + 4 * fq;
#pragma unroll
        for (int ai = 0; ai < 2; ++ai)
#pragma unroll
            for (int m = 0; m < 4; ++m) { const size_t off = (size_t)(u.pm * 256 + ai * 128 + wr * 64 + m * 16 + fr) * ldc + col0;
#pragma unroll
                for (int bj = 0; bj < 2; ++bj)
#pragma unroll
                    for (int n = 0; n < 2; ++n) { const pg8::f32x4 bs = *(const pg8::f32x4*)(base + off + bj * 128 + n * 16); *(pg8::f32x4*)(out + off + bj * 128 + n * 16) = bs + acc[ai][bj][m][n]; }
                if (m & 1) asm volatile("" ::: "memory"); }
    }
};
struct Args { const float* in[17]; float* out; unsigned char* ws; int ph_lo, ph_hi, li, pad; };
__global__ void __launch_bounds__(NTHR, 2) mk_fwd(Args args) {
    extern __shared__ __attribute__((aligned(16))) unsigned char lds[];
    Frame F;
    F.lds = (LAS unsigned char*)lds;
    F.MISC = (volatile LAS unsigned*)(F.lds + MISC_OFF);
    F.tid = threadIdx.x; F.lane = F.tid & 63; F.wave = __builtin_amdgcn_readfirstlane(F.tid >> 6);
    F.G = gridDim.x; { const int bx = blockIdx.x; F.vcu = (F.G % 8 == 0) ? (bx % 8) * (F.G / 8) + bx / 8 : bx; }
    F.ws = args.ws; F.out = args.out; F.li = args.li; F.ctl = (gu32*)(args.ws + WS_CTL);
    for (int u = F.tid; u < (LDS_BYTES - LDSCTL_OFF) / 4; u += NTHR) ((LAS unsigned*)(F.lds + LDSCTL_OFF))[u] = 0u;
    __syncthreads();
    XcdBarrier bar = xcd_barrier_post((unsigned*)(F.ctl + CW_BAR) + args.li * XCD_BAR_WORDS, F.MISC + 8);
    const int lo = args.ph_lo, hi = args.ph_hi;
#define IN(k) (lo <= (k) && (k) < hi)
#define BOTH(k) (IN(k) && IN((k) + 1))
#define GRID_BAR() xcd_barrier(bar)
#define PHASE_BEGIN() do { int t_ = threadIdx.x; asm volatile("" : "+v"(t_)); F.tid = t_; F.lane = t_ & 63; } while (0)
    if (IN(0)) { PHASE_BEGIN(); p0_prologue(F, args.in[I_X], args.in[I_LNMIX], args.in[I_WIN], args.in[I_WOUT], args.in[I_ALOG], args.in[I_DTB]); p0_rot_table(F); p0_router_weights(F, args.in[I_LNFFN], args.in[I_WG], args.in[I_WE]); if (BOTH(0)) GRID_BAR(); }
    if (IN(1)) { PHASE_BEGIN();
        pg8::Gemm g{(const bf16*)(F.ws + WS_HN), (const bf16*)(F.ws + WS_WIN), T, NPROJ, D}; pg8::StaticOrder S; S.init(T, NPROJ, F.G, (int)blockIdx.x);
        pg8::EpiBf16<0> E{(bf16*)(F.ws + WS_PROJ), NPROJ, nullptr, 0, 0, 1.f};
        pg8::gemm_phase<pg8::EpiBf16<0>, pg8::StaticOrder, true, true>(F.lds, g, S, E);
        if (BOTH(1)) GRID_BAR();
    }
    if (IN(2)) { PHASE_BEGIN();
#pragma unroll 1
        for (int grp = blockIdx.x; grp < 256; grp += F.G) p2_group(F, grp, args.in[I_CONV], (const float*)(F.ws + WS_BG));
        if (BOTH(2)) GRID_BAR();
    }
    if (IN(3) || IN(17) || IN(18)) { PHASE_BEGIN(); const int skipq = IN(17) ? 1 : IN(18) ? 3 : 0;
        const int x = blockIdx.x;
        if (x < 32) p3_scan(F, (x & 7) + 8 * (x >> 4), (x >> 3) & 1, 0);
        {
            LAS int* wq = (LAS int*)(F.lds + LT_WQ);
#pragma unroll 1
            for (;;) {
                if (F.tid == 0) *wq = (int)atomicAdd((unsigned*)(F.ctl + CW_WQ + 64 * F.li), 1u);
                __syncthreads();
                const int it = *wq;
                __syncthreads();
                if (it >= 512 + 384 + 480 + 256) break;
                if (it < 384) { if (!(skipq & 1)) p3_moe_weight_items(F, it * 64 + F.wave, NWAVES, it * 64 + 64, args.in[I_WGU], args.in[I_WD]); }
                else if (it < 384 + 512) { if (!(skipq & 2)) p3_attn_unit(F, it - 384, args.in[I_SINK]); }
                else { const int ob = it - (512 + 384); if (ob < 480) p3_out_batch(F, ob * 8, 8, F.out); else p3_out_batch(F, 3840 + (ob - 480), 1, F.out); }
            }
        }
        if (BOTH(3)) GRID_BAR();
    }
    if (IN(4)) { PHASE_BEGIN(); p4_combine(F, F.out, args.in[I_DNNORM]); if (BOTH(4)) GRID_BAR(); }
    if (IN(5)) { PHASE_BEGIN();
        pg8::Gemm g{(const bf16*)(F.ws + WS_MIX), (const bf16*)(F.ws + WS_WOUT), T, D, D}; pg8::StaticOrder S; S.init(T, D, F.G, (int)blockIdx.x);
        EpiResF32 E{args.in[I_X], F.out, D};
        pg8::gemm_phase<EpiResF32, pg8::StaticOrder, true, true>(F.lds, g, S, E);
        if (BOTH(5)) GRID_BAR();
    }
    if (IN(6) || IN(12)) { PHASE_BEGIN(); p6_route(F, args.in[I_LNFFN], args.in[I_BG], args.in[I_BE], IN(12) ? 1 : 0); if (BOTH(6)) GRID_BAR(); }
    if (IN(8)) { PHASE_BEGIN();
        const int NP = moe_tables(F);
        pg8::Gemm g{(const bf16*)(F.ws + WS_HN), (const bf16*)(F.ws + WS_WGU), NP * 256, NEXP * 512, D};
        MoeGatherOrder S{NP * 2, F.G, (int)blockIdx.x, 1, (const LAS int*)(F.lds + LT_PTAB), (const int*)(F.ws + WS_LIST), (const unsigned*)(F.ctl + CW_CNT), (unsigned)(D * 2)};
        EpiSwiGLU E{(bf16*)(F.ws + WS_HMID), (const int*)(F.ws + WS_LIST), (const unsigned*)(F.ctl + CW_CNT), (const float*)(F.ws + RW_RSTD), (const LAS int*)(F.lds + LT_PTAB)};
        pg8::gemm_phase<EpiSwiGLU, MoeGatherOrder, true, true>(F.lds, g, S, E);
        if (BOTH(8)) GRID_BAR();
    }
    if (IN(9)) { PHASE_BEGIN();
        const int NP = moe_tables(F);
        pg8::Gemm g{(const bf16*)(F.ws + WS_HMID), (const bf16*)(F.ws + WS_WD), NP * 256, NEXP * D, EFF};
        MoeOrder S{NP * 4, F.G, (int)blockIdx.x, 2, (const LAS int*)(F.lds + LT_PTAB), nullptr, nullptr, 0u};
        EpiDown E{(bf16*)(F.ws + WS_Y2), (const int*)(F.ws + WS_LIST), (const unsigned*)(F.ctl + CW_CNT), (const float*)(F.ws + RW_GATE), (const LAS int*)(F.lds + LT_PTAB)};
        pg8::gemm_phase<EpiDown, MoeOrder, true, true>(F.lds, g, S, E);
        if (BOTH(9)) GRID_BAR();
    }
#ifdef PROBE_PHASES
    if (IN(11) || IN(14) || IN(15) || IN(16)) { PHASE_BEGIN(); const int x = blockIdx.x; if (x < 32) p3_scan(F, (x & 7) + 8 * (x >> 4), (x >> 3) & 1, IN(14) ? 1 : IN(15) ? 3 : IN(16) ? 5 : 0); }
#endif
    if (IN(10) || IN(13)) { PHASE_BEGIN(); p10_final(F, args.in[I_LNF], IN(13) ? (float*)(F.ws + WS_PROJ) : F.out); }
#undef IN
#undef BOTH
}

__global__ void k_shim_proj(const bf16* __restrict__ pb, float* __restrict__ pf) {
    const size_t i = (size_t)blockIdx.x * blockDim.x + threadIdx.x; if (i >= (size_t)T * NPROJ) return;
    const int tok = (int)(i / NPROJ), c = (int)(i % NPROJ);
    pf[(size_t)tok * INW + (c < 2048 ? c : c + 16)] = bf2f(pb[i]);
}
}

extern "C" void kernel_launch(void* const* d_in, const int* in_sizes, int n_in, void* d_out, int out_size, void* d_ws, size_t ws_size, hipStream_t stream) {
    using namespace mk;
    static int grid = 0;
    if (grid == 0) {
        if (n_in != 17 || out_size != T * D || ws_size < 511 * MiB) { fprintf(stderr, "kernel_launch: unexpected sizes (n_in %d out %d ws %zu)\n", n_in, out_size, ws_size); grid = -1; return; }
        int dev = 0, cus = 0, per_cu = 0;
        if (hipGetDevice(&dev) != hipSuccess || hipDeviceGetAttribute(&cus, hipDeviceAttributeMultiprocessorCount, dev) != hipSuccess) { grid = -1; return; }
        if (hipFuncSetAttribute((const void*)mk_fwd, hipFuncAttributeMaxDynamicSharedMemorySize, LDS_BYTES) != hipSuccess) { fprintf(stderr, "kernel_launch: hipFuncSetAttribute failed\n"); grid = -1; return; }
        if (hipOccupancyMaxActiveBlocksPerMultiprocessor(&per_cu, (const void*)mk_fwd, NTHR, LDS_BYTES) != hipSuccess || per_cu < 1) { fprintf(stderr, "kernel_launch: occupancy query says %d blocks/CU\n", per_cu); grid = -1; (void)hipGetLastError(); return; }
        grid = cus;
    }
    if (grid < 0) return;
    (void)hipMemsetAsync((char*)d_ws + WS_CTL, 0, CTL_ZERO_BYTES, stream);
    Args a{};
    for (int i = 0; i < 17; ++i) a.in[i] = (const float*)d_in[i];
    a.out = (float*)d_out; a.ws = (unsigned char*)d_ws; a.pad = 0;
#ifndef LAUNCH_PLAN
#define LAUNCH_PLAN {0, 11}
#endif
    const int plan[] = LAUNCH_PLAN; const int nl = (int)(sizeof(plan) / sizeof(int)) / 2;
    for (int li = 0; li < nl; ++li) {
        a.ph_lo = plan[2 * li]; a.ph_hi = plan[2 * li + 1]; a.li = li;
        void* kargs[] = {&a};
        hipError_t e = hipLaunchCooperativeKernel((const void*)mk_fwd, dim3(grid), dim3(NTHR), kargs, LDS_BYTES, stream);
        if (e != hipSuccess) { fprintf(stderr, "cooperative launch failed: %s (grid %d)\n", hipGetErrorString(e), grid); return; }
    }
}
```

```cpp
#include <hip/hip_runtime.h>
#include <cstdint>
#include <cstdio>
namespace pg8 {
#define PG8_LAS __attribute__((address_space(3)))
typedef unsigned short bf16_t;
typedef short bf16x8 __attribute__((ext_vector_type(8)));
typedef float f32x4 __attribute__((ext_vector_type(4)));
typedef unsigned u32x4 __attribute__((ext_vector_type(4)));
constexpr int BM = 256, BK = 64, HALF = 128, HTB = HALF * BK * 2  , STAGE_BYTES = 8 * HTB, NXCD = 8, WGM = 8;

__host__ __device__ __forceinline__ int lds_byte(int r, int c) { const int st = (r >> 4) * 2 + (c >> 5), rr = r & 15, cc = c & 31, ob = rr * 64 + cc * 2; return st * 1024 + (ob ^ (((ob >> 9) & 1) << 5)); }
__host__ __device__ __forceinline__ void stage_rc(int b, int& R, int& C) { const int st = b / 1024, sb = b % 1024, swz = sb ^ (((sb >> 9) & 1) << 5); R = (st >> 1) * 16 + swz / 64; C = (st & 1) * 32 + (swz % 64) / 2; }
__host__ __device__ __forceinline__ int perm32(int rho) { const int n = rho >> 4, i = rho & 15; return 8 * (i >> 2) + 4 * n + (i & 3); }

struct Unit { int pm, pn; };
struct Gemm { const bf16_t* A; const bf16_t* Bt; int M, N, K; };

struct StaticOrder {
    static constexpr bool GATHER = false;
    int nM, nN, nwg, G, c;
    __device__ __forceinline__ unsigned row_off(const Unit&, int) const { return 0u; }
    __host__ __device__ void init(int M, int N, int G_, int c_) { nM = M / BM; nN = N / BM; nwg = nM * nN; G = G_; c = c_; }
    __host__ __device__ bool next(int i, Unit& u) const {
        const long L = (long)i * G + c; if (L >= nwg) return false;
        int wgid = (int)L; { const int q = nwg / NXCD, r = nwg % NXCD, xcd = wgid % NXCD, off = wgid / NXCD; wgid = (xcd < r ? xcd * (q + 1) : r * (q + 1) + (xcd - r) * q) + off; }
        const int nig = WGM * nN, gid = wgid / nig, fm = gid * WGM, gsz = (nM - fm) < WGM ? (nM - fm) : WGM;
        u.pm = fm + ((wgid % nig) % gsz); u.pn = (wgid % nig) / gsz; return true;
    }
    __device__ __forceinline__ void a_ready(const Unit&) const {}
    __device__ __forceinline__ void done(const Unit&) const {}
};

__device__ __forceinline__ unsigned cvt_pk_bf16(float lo, float hi) { unsigned r; asm volatile("v_cvt_pk_bf16_f32 %0, %1, %2" : "=v"(r) : "v"(lo), "v"(hi)); return r; }
typedef float f32x2 __attribute__((ext_vector_type(2)));
__device__ __forceinline__ f32x2 gelu_pk(f32x2 v) {
    const f32x2 av = __builtin_elementwise_abs(v), d = av * 0.2316418882f + 1.0f;
    f32x2 t; t.x = __builtin_amdgcn_rcpf(d.x); t.y = __builtin_amdgcn_rcpf(d.y);
    f32x2 q = t * 0.5307027145f + (-0.7265760135f); q = q * t + 0.7107068705f; q = q * t + (-0.142248368f); q = q * t + 0.127414796f; q = q * t;
    const f32x2 s = (v * v) * (-0.72134752044f);
    f32x2 e; e.x = __builtin_amdgcn_exp2f(s.x); e.y = __builtin_amdgcn_exp2f(s.y);
    const f32x2 m = v * (q * e), r = v - m;
    f32x2 o; o.x = v.x < 0.f ? m.x : r.x; o.y = v.y < 0.f ? m.y : r.y; return o;
}

template <int ACT  > struct EpiBf16 {
    static constexpr bool PERM = true, AFTER_DRAIN = false; static_assert(ACT == 0 || ACT == 1, "EpiBf16: ACT is 0 (none) or 1 (gelu_pk)");
    bf16_t* O; int ldc; const float* bias; int split_cols; size_t split_stride; float scale0;
    __device__ __forceinline__ void operator()(const f32x4 (&acc)[2][2][4][2], const Unit& u, int wr, int wc, int fr, int fq) const {
        const int row0 = u.pm * BM + wr * 64 + fr; int colt = u.pn * BM; bf16_t* base = O;
        float sc = 1.f; if (split_cols) { const int t = colt / split_cols; base += (size_t)t * split_stride; colt -= t * split_cols; if (t == 0) sc = scale0; }
        const int col0 = colt + wc * 32 + 8 * fq, bcol0 = u.pn * BM + wc * 32 + 8 * fq;
        f32x4 bv[2][2];
#pragma unroll
        for (int bj = 0; bj < 2; ++bj)
#pragma unroll
            for (int n = 0; n < 2; ++n) bv[bj][n] = bias ? *(const f32x4*)(bias + bcol0 + bj * HALF + 4 * n) : (f32x4){0.f, 0.f, 0.f, 0.f};
#pragma unroll
        for (int ai = 0; ai < 2; ++ai)
#pragma unroll
            for (int m = 0; m < 4; ++m) { bf16_t* rowp = base + (size_t)(row0 + ai * HALF + m * 16) * ldc + col0;
#pragma unroll
                for (int bj = 0; bj < 2; ++bj) { f32x4 v0 = acc[ai][bj][m][0] + bv[bj][0], v1 = acc[ai][bj][m][1] + bv[bj][1];
                    if (ACT == 1) { f32x2 a = gelu_pk((f32x2){v0[0], v0[1]}), b = gelu_pk((f32x2){v0[2], v0[3]}), c = gelu_pk((f32x2){v1[0], v1[1]}), d = gelu_pk((f32x2){v1[2], v1[3]});
                        v0 = (f32x4){a.x, a.y, b.x, b.y}; v1 = (f32x4){c.x, c.y, d.x, d.y}; }
                    v0 = v0 * sc; v1 = v1 * sc; u32x4 w; w.x = cvt_pk_bf16(v0[0], v0[1]); w.y = cvt_pk_bf16(v0[2], v0[3]); w.z = cvt_pk_bf16(v1[0], v1[1]); w.w = cvt_pk_bf16(v1[2], v1[3]);
                    *(u32x4*)(rowp + bj * HALF) = w; } }
    }
};
template <class Epi, class Sched, bool ALIGN_EPI = false, bool SP2 = false>
__device__ __forceinline__ void gemm_phase(PG8_LAS unsigned char* lds, const Gemm g, const Sched& S, const Epi& E) {
    const int tid = threadIdx.x, wid = __builtin_amdgcn_readfirstlane(tid >> 6), lane = tid & 63, wr = wid >> 2, wc = wid & 3, fr = lane & 15, fq = lane >> 4;
    const int K = g.K, nt = K / BK;
    unsigned voffA[2], voffB[2];
    constexpr bool GATHER = Sched::GATHER;
    unsigned gA[2][2], nGA[2][2]; int rowA[2], colA[2];
#pragma unroll
    for (int i = 0; i < 2; ++i) { int R, C; stage_rc(tid * 16 + i * 8192, R, C); const int Rb = Epi::PERM ? ((R & ~31) + perm32(R & 31)) : R;
        voffA[i] = (unsigned)(R * K + C) * 2u; voffB[i] = (unsigned)(Rb * K + C) * 2u; rowA[i] = R; colA[i] = C; }
    const size_t kstep = (size_t)(BK * 2);
    const size_t hstep = (size_t)HALF * K * 2;
    const size_t tstep = 2 * hstep;
    const size_t hstepA = GATHER ? 0 : hstep, tstepA = GATHER ? 0 : tstep;
    const unsigned ldsw = (unsigned)wid * 1024u;
    const int aoff = lds_byte(wr * 64 + fr, fq * 8), boff = lds_byte(wc * 32 + fr, fq * 8);
#define PG8_SA(b, h) (((b) * 2 + (h)) * HTB)
#define PG8_SB(b, h) ((4 + (b) * 2 + (h)) * HTB)
#define PG8_STAGE(bufoff, gbase, voff) do { _Pragma("unroll") for (int _i = 0; _i < 2; ++_i) \
        __builtin_amdgcn_global_load_lds((const unsigned*)((const char*)(gbase) + (voff)[_i]), (PG8_LAS unsigned*)(lds + (bufoff) + ldsw + _i * 8192), 16, 0, 0); } while (0)
#define PG8_STAGE_A(bufoff, gbase, h, nx) do { if constexpr (GATHER) { if (nx) PG8_STAGE(bufoff, gbase, nGA[h]); else PG8_STAGE(bufoff, gbase, gA[h]); } else PG8_STAGE(bufoff, gbase, voffA); } while (0)
#define PG8_GOFF(dst, unit) do { if constexpr (GATHER) { _Pragma("unroll") for (int h_ = 0; h_ < 2; ++h_) _Pragma("unroll") for (int i_ = 0; i_ < 2; ++i_) dst[h_][i_] = S.row_off(unit, h_ * HALF + rowA[i_]) + (unsigned)colA[i_] * 2u; \
        asm volatile("s_waitcnt vmcnt(0)" : "+v"(dst[0][0]), "+v"(dst[0][1]), "+v"(dst[1][0]), "+v"(dst[1][1]) :: "memory"); } } while (0)
#define PG8_LDA(dst, b, h) do { _Pragma("unroll") for (int m = 0; m < 4; ++m) _Pragma("unroll") for (int k = 0; k < 2; ++k) dst[m][k] = *(const PG8_LAS bf16x8*)(lds + PG8_SA(b, h) + aoff + m * 2048 + k * 1024); } while (0)
#define PG8_LDB(dst, b, h) do { _Pragma("unroll") for (int n = 0; n < 2; ++n) _Pragma("unroll") for (int k = 0; k < 2; ++k) dst[n][k] = *(const PG8_LAS bf16x8*)(lds + PG8_SB(b, h) + boff + n * 2048 + k * 1024); } while (0)
#define PG8_MMA(ai, bj, At, Bt) do { __builtin_amdgcn_s_setprio(1); _Pragma("unroll") for (int m = 0; m < 4; ++m) _Pragma("unroll") for (int n = 0; n < 2; ++n) _Pragma("unroll") for (int k = 0; k < 2; ++k) \
        acc[ai][bj][m][n] = __builtin_amdgcn_mfma_f32_16x16x32_bf16(Bt[n][k], At[m][k], acc[ai][bj][m][n], 0, 0, 0); __builtin_amdgcn_s_setprio(0); } while (0)
#define PG8_WAIT_V(n) asm volatile("s_waitcnt vmcnt(" #n ")" ::: "memory")
#define PG8_WAIT_L(n) asm volatile("s_waitcnt lgkmcnt(" #n ")" ::: "memory")
#define PG8_BAR __builtin_amdgcn_s_barrier()
#define PG8_SCHED __builtin_amdgcn_sched_barrier(0)
    Unit cur, nxt; int ui = 0;
    if (!S.next(0, cur)) return;
    f32x4 acc[2][2][4][2];
#pragma unroll
    for (int a = 0; a < 2; ++a)
#pragma unroll
        for (int b = 0; b < 2; ++b)
#pragma unroll
            for (int m = 0; m < 4; ++m)
#pragma unroll
                for (int n = 0; n < 2; ++n) acc[a][b][m][n] = (f32x4){0.f, 0.f, 0.f, 0.f};
    bf16x8 At[4][2], B0[2][2], B1[2][2];
    const char* cA = (const char*)g.A + (size_t)cur.pm * tstepA; const char* cB = (const char*)g.Bt + (size_t)cur.pn * tstep;
    PG8_GOFF(gA, cur);
    S.a_ready(cur);
    if constexpr (SP2) {
        PG8_STAGE(PG8_SB(0, 0), cB, voffB); PG8_STAGE(PG8_SB(0, 1), cB + hstep, voffB); PG8_STAGE_A(PG8_SA(0, 0), cA, 0, false); PG8_STAGE_A(PG8_SA(0, 1), cA + hstepA, 1, false);
        if (wr == 1) PG8_BAR;
        PG8_WAIT_V(2); PG8_BAR;
        PG8_STAGE(PG8_SB(1, 0), cB + kstep, voffB); PG8_STAGE_A(PG8_SA(1, 0), cA + kstep, 0, false); PG8_STAGE(PG8_SB(1, 1), cB + hstep + kstep, voffB);
        PG8_WAIT_V(6); PG8_BAR;
    } else {
        PG8_STAGE(PG8_SB(0, 0), cB, voffB); PG8_STAGE_A(PG8_SA(0, 0), cA, 0, false); PG8_STAGE(PG8_SB(0, 1), cB + hstep, voffB); PG8_STAGE_A(PG8_SA(0, 1), cA + hstepA, 1, false);
        if (wr == 1) PG8_BAR;
        PG8_WAIT_V(4); PG8_BAR;
        PG8_STAGE(PG8_SB(1, 0), cB + kstep, voffB); PG8_STAGE_A(PG8_SA(1, 0), cA + kstep, 0, false); PG8_STAGE(PG8_SB(1, 1), cB + hstep + kstep, voffB);
        PG8_WAIT_V(6); PG8_BAR;
    }
    for (;;) {
        const bool has_next = S.next(ui + 1, nxt);
        if constexpr (GATHER) { if (has_next) PG8_GOFF(nGA, nxt); else { _Pragma("unroll") for (int h_ = 0; h_ < 2; ++h_) _Pragma("unroll") for (int i_ = 0; i_ < 2; ++i_) nGA[h_][i_] = gA[h_][i_]; } }
        const char* nA = has_next ? (const char*)g.A + (size_t)nxt.pm * tstepA : cA; const char* nB = has_next ? (const char*)g.Bt + (size_t)nxt.pn * tstep : cB;
        for (int t = 0; t < nt; t += 2) {
            const bool last = (t == nt - 2);
            const char* a1 = cA + (size_t)(t + 1) * kstep;
            const char* a2 = last ? nA : cA + (size_t)(t + 2) * kstep; const char* b2 = last ? nB : cB + (size_t)(t + 2) * kstep;
            const char* a3 = a2 + kstep; const char* b3 = b2 + kstep;
            if (last && has_next) S.a_ready(nxt);
            if constexpr (SP2) {
            PG8_LDB(B0, 0, 0); PG8_LDB(B1, 0, 1); PG8_SCHED; PG8_LDA(At, 0, 0); PG8_STAGE_A(PG8_SA(1, 1), a1 + hstepA, 1, false);
            PG8_WAIT_V(8); PG8_WAIT_L(0); PG8_BAR; PG8_MMA(0, 0, At, B0); PG8_MMA(0, 1, At, B1); PG8_BAR; PG8_SCHED;
            PG8_LDA(At, 0, 1); PG8_STAGE(PG8_SB(0, 0), b2, voffB); PG8_STAGE(PG8_SB(0, 1), b2 + hstep, voffB); PG8_STAGE_A(PG8_SA(0, 0), a2, 0, last);
            PG8_WAIT_V(8); PG8_WAIT_L(0); PG8_BAR; PG8_MMA(1, 0, At, B0); PG8_MMA(1, 1, At, B1); PG8_BAR; PG8_SCHED;
            PG8_LDB(B0, 1, 0); PG8_LDB(B1, 1, 1); PG8_SCHED; PG8_LDA(At, 1, 0); PG8_STAGE_A(PG8_SA(0, 1), a2 + hstepA, 1, last);
            PG8_WAIT_V(8); PG8_WAIT_L(0); PG8_BAR; PG8_MMA(0, 0, At, B0); PG8_MMA(0, 1, At, B1); PG8_BAR; PG8_SCHED;
            PG8_LDA(At, 1, 1); PG8_STAGE(PG8_SB(1, 0), b3, voffB); PG8_STAGE(PG8_SB(1, 1), b3 + hstep, voffB); PG8_STAGE_A(PG8_SA(1, 0), a3, 0, last);
            PG8_WAIT_V(8); PG8_WAIT_L(0); PG8_BAR; PG8_MMA(1, 0, At, B0); PG8_MMA(1, 1, At, B1); PG8_BAR; PG8_SCHED;
            } else {
            PG8_LDB(B0, 0, 0); PG8_SCHED; PG8_LDA(At, 0, 0); PG8_STAGE_A(PG8_SA(1, 1), a1 + hstepA, 1, false);
            PG8_WAIT_L(8); PG8_BAR; PG8_WAIT_L(0); PG8_MMA(0, 0, At, B0); PG8_BAR; PG8_SCHED;
            PG8_LDB(B1, 0, 1); PG8_STAGE(PG8_SB(0, 0), b2, voffB);
            PG8_BAR; PG8_WAIT_L(0); PG8_MMA(0, 1, At, B1); PG8_BAR;
            PG8_LDA(At, 0, 1); PG8_STAGE_A(PG8_SA(0, 0), a2, 0, last);
            PG8_BAR; PG8_WAIT_L(0); PG8_MMA(1, 0, At, B0); PG8_BAR; PG8_SCHED;
            PG8_STAGE(PG8_SB(0, 1), b2 + hstep, voffB);
            PG8_WAIT_V(6); PG8_BAR; PG8_MMA(1, 1, At, B1); PG8_BAR;
            PG8_LDB(B0, 1, 0); PG8_SCHED; PG8_LDA(At, 1, 0); PG8_STAGE_A(PG8_SA(0, 1), a2 + hstepA, 1, last);
            PG8_WAIT_L(8); PG8_BAR; PG8_WAIT_L(0); PG8_MMA(0, 0, At, B0); PG8_BAR; PG8_SCHED;
            PG8_LDB(B1, 1, 1); PG8_STAGE(PG8_SB(1, 0), b3, voffB);
            PG8_BAR; PG8_WAIT_L(0); PG8_MMA(0, 1, At, B1); PG8_BAR;
            PG8_LDA(At, 1, 1); PG8_STAGE_A(PG8_SA(1, 0), a3, 0, last);
            PG8_BAR; PG8_WAIT_L(0); PG8_MMA(1, 0, At, B0); PG8_BAR; PG8_SCHED;
            PG8_STAGE(PG8_SB(1, 1), b3 + hstep, voffB);
            PG8_WAIT_V(6); PG8_BAR; PG8_MMA(1, 1, At, B1); PG8_BAR;
            }
        }
        if constexpr (ALIGN_EPI) { if (wr == 0) PG8_BAR; }
        if constexpr (!Epi::AFTER_DRAIN) { E(acc, cur, wr, wc, fr, fq); S.done(cur); }
        if (!has_next) break;
#pragma unroll
        for (int a = 0; a < 2; ++a)
#pragma unroll
            for (int b = 0; b < 2; ++b)
#pragma unroll
                for (int m = 0; m < 4; ++m)
#pragma unroll
                    for (int n = 0; n < 2; ++n) acc[a][b][m][n] = (f32x4){0.f, 0.f, 0.f, 0.f};
        cur = nxt; cA = nA; cB = nB; ++ui;
        if constexpr (GATHER) { _Pragma("unroll") for (int h_ = 0; h_ < 2; ++h_) _Pragma("unroll") for (int i_ = 0; i_ < 2; ++i_) gA[h_][i_] = nGA[h_][i_]; }
        if constexpr (ALIGN_EPI) { if (wr == 1) PG8_BAR; }
    }
    PG8_WAIT_V(0);
    if constexpr (!ALIGN_EPI) { if (wr == 0) PG8_BAR; }
    PG8_BAR;
    if constexpr (Epi::AFTER_DRAIN) { E.fused(acc, cur, wr, wc, fr, fq, lds, wid, lane); S.done(cur); }
#undef PG8_SA
#undef PG8_SB
#undef PG8_STAGE
#undef PG8_STAGE_A
#undef PG8_GOFF
#undef PG8_LDA
#undef PG8_LDB
#undef PG8_MMA
#undef PG8_WAIT_V
#undef PG8_WAIT_L
#undef PG8_BAR
#undef PG8_SCHED
}
}
namespace mk {
constexpr int D = 1024, BATCH = 2, SEQ = 8192, T = BATCH * SEQ;
constexpr int INW = 2832, NPROJ = 2816;
constexpr int PJ_Q = 0, PJ_K = 512, PJ_V = 1024, PJ_Z = 1536, PJ_AQ = 2048, PJ_AK = 2560, PJ_AV = 2688;
constexpr int NEXP = 64, EFF = 256;
constexpr float EPS = 1e-6f;
constexpr int NWAVES = 8, NTHR = 512;
constexpr size_t MiB = 1u << 20;
constexpr size_t WS_CTL = 0, CTL_ZERO_BYTES = 1 * MiB;
constexpr size_t WS_WIN = 1 * MiB, WS_WOUT = 7 * MiB, WS_WGU = 9 * MiB, WS_WD = 73 * MiB;
constexpr size_t WS_HN = 105 * MiB, WS_BG = 137 * MiB, WS_MISC = 138 * MiB, WS_PROJ = 144 * MiB;
constexpr size_t WS_DN = 232 * MiB, WS_MIX = 456 * MiB, WS_END = 488 * MiB;
constexpr int CW_BAR = 4096;
constexpr int LDS_BYTES = 163840, RING_BYTES = 159744, LDSCTL_OFF = RING_BYTES, MISC_OFF = LDSCTL_OFF + 320;

#define GAS __attribute__((address_space(1)))
#define LAS __attribute__((address_space(3)))
typedef unsigned short bf16;
typedef unsigned v4u __attribute__((ext_vector_type(4)));
typedef float f32x4 __attribute__((ext_vector_type(4)));
typedef GAS unsigned gu32;
#define RLX_AGENT __ATOMIC_RELAXED, __HIP_MEMORY_SCOPE_AGENT
#define LDS_WAIT() asm volatile("s_waitcnt lgkmcnt(0)" ::: "memory")
#define VM_WAIT() asm volatile("s_waitcnt vmcnt(0)" ::: "memory")
__device__ __forceinline__ unsigned f2bf(float f) { unsigned u = __builtin_bit_cast(unsigned, f); return (u + 0x7fffu + ((u >> 16) & 1u)) >> 16; }
typedef float f32x2_t __attribute__((ext_vector_type(2))); typedef __bf16 bf16x2_t __attribute__((ext_vector_type(2)));
__device__ __forceinline__ unsigned pk2(float lo, float hi) { f32x2_t v = {lo, hi}; bf16x2_t b = __builtin_convertvector(v, bf16x2_t); return __builtin_bit_cast(unsigned, b); }
__device__ __forceinline__ float bf2f(unsigned short b) { return __builtin_bit_cast(float, (unsigned)b << 16); }
__device__ __forceinline__ float wave_sum(float v) {
#pragma unroll
    for (int o = 1; o < 64; o <<= 1) v += __shfl_xor(v, o);
    return v;
}
__device__ __forceinline__ float reduce16(float (&v)[16], int lane) {
    { const bool h = (lane & 32) != 0;
#pragma unroll
      for (int i = 0; i < 8; ++i) { const float keep = h ? v[i + 8] : v[i], send = h ? v[i] : v[i + 8]; v[i] = keep + __shfl_xor(send, 32); } }
    { const bool h = (lane & 16) != 0;
#pragma unroll
      for (int i = 0; i < 4; ++i) { const float keep = h ? v[i + 4] : v[i], send = h ? v[i] : v[i + 4]; v[i] = keep + __shfl_xor(send, 16); } }
    { const bool h = (lane & 8) != 0;
#pragma unroll
      for (int i = 0; i < 2; ++i) { const float keep = h ? v[i + 2] : v[i], send = h ? v[i] : v[i + 2]; v[i] = keep + __shfl_xor(send, 8); } }
    { const bool h = (lane & 4) != 0; const float keep = h ? v[1] : v[0], send = h ? v[0] : v[1]; v[0] = keep + __shfl_xor(send, 4); }
    v[0] += __shfl_xor(v[0], 2); v[0] += __shfl_xor(v[0], 1);
    return v[0];
}
__device__ __forceinline__ float silu_f(float x) { return x / (1.f + __expf(-x)); }
__device__ __forceinline__ float softplus_f(float x) { return fmaxf(x, 0.f) + log1pf(expf(-fabsf(x))); }

#define XB_TMO      128
#define XB_XCNT(j)  (256  + 64 * (j))
#define XB_XSUB(j)  (1280 + 64 * (j))
#define XB_XGEN(j)  (2304 + 64 * (j))
#define XB_TOP      3328
#define XB_TOPGEN   3392
#define XCD_BAR_WORDS 3456
#define XB_SPIN_CAP (1u << 22)
__device__ __forceinline__ unsigned xb_ld(unsigned* p)              { return __hip_atomic_load(p, __ATOMIC_RELAXED, __HIP_MEMORY_SCOPE_AGENT); }
__device__ __forceinline__ unsigned xb_add(unsigned* p, unsigned v) { return __hip_atomic_fetch_add(p, v, __ATOMIC_RELAXED, __HIP_MEMORY_SCOPE_AGENT); }
__device__ __forceinline__ unsigned xb_xcc_id() { return (unsigned)__builtin_amdgcn_s_getreg((3 << 11) | 20) & 0xFu; }
#define XB_SPIN(cond, bar) do { unsigned _sp = 0; while (cond) { __builtin_amdgcn_s_sleep(1); \
    if ((++_sp & 255u) == 0u) { if (xb_ld(&(bar)[XB_TMO])) break; if (_sp > XB_SPIN_CAP) { atomicAdd(&(bar)[XB_TMO], 1u); break; } } } } while (0)
struct XcdBarrier { unsigned* bar; unsigned x; volatile LAS unsigned* st; };
__device__ __forceinline__ XcdBarrier xcd_barrier_post(unsigned* bar, volatile LAS unsigned* st) {
    XcdBarrier b; b.bar = bar; b.x = xb_xcc_id(); b.st = st;
    if (threadIdx.x == 0) (void)xb_add(&bar[XB_XCNT(b.x)], 1u);
    return b;
}
__device__ __forceinline__ void xcd_barrier_complete(unsigned* bar, unsigned x, unsigned& nloc, unsigned& nx) {
    const unsigned G = gridDim.x * gridDim.y * gridDim.z;
    unsigned sum, cnt, mine, sp = 0u;
    for (;;) {
        sum = 0u; cnt = 0u; mine = 0u;
#pragma unroll
        for (unsigned j = 0; j < 16; ++j) { const unsigned c = xb_ld(&bar[XB_XCNT(j)]); sum += c; cnt += (c > 0u) ? 1u : 0u; mine = (j == x) ? c : mine; }
        if (sum == G) break;
        __builtin_amdgcn_s_sleep(1);
        if ((++sp & 255u) == 0u) { if (xb_ld(&bar[XB_TMO])) break; if (sp > XB_SPIN_CAP) { atomicAdd(&bar[XB_TMO], 1u); break; } }
    }
    nloc = mine > 0u ? mine : 1u; nx = cnt > 0u ? cnt : 1u;
}
__device__ __forceinline__ void xcd_barrier(const XcdBarrier& b) {
    asm volatile("s_waitcnt vmcnt(0)" ::: "memory");
    __syncthreads();
    if (threadIdx.x == 0) {
        unsigned* bar = b.bar;
        __builtin_amdgcn_s_waitcnt(0);
        unsigned nloc = b.st[0], nx = b.st[1];
        if (nloc == 0u) { xcd_barrier_complete(bar, b.x, nloc, nx); b.st[0] = nloc; b.st[1] = nx; }
        const unsigned old = xb_add(&bar[XB_XSUB(b.x)], 1u);
        const unsigned gen = old / nloc;
        if (old + 1u == (gen + 1u) * nloc) {
            __builtin_amdgcn_fence(__ATOMIC_RELEASE, "agent");
            asm volatile("s_waitcnt vmcnt(0)" ::: "memory");
            const unsigned og = xb_add(&bar[XB_TOP], 1u);
            const unsigned tg = og / nx;
            if (og + 1u == (tg + 1u) * nx) xb_add(&bar[XB_TOPGEN], 1u);
            else XB_SPIN(xb_ld(&bar[XB_TOPGEN]) == tg, bar);
            __builtin_amdgcn_fence(__ATOMIC_ACQUIRE, "agent");
            xb_add(&bar[XB_XGEN(b.x)], 1u);
            asm volatile("s_waitcnt vmcnt(0)" ::: "memory");
        } else {
            XB_SPIN(xb_ld(&bar[XB_XGEN(b.x)]) == gen, bar);
            __builtin_amdgcn_fence(__ATOMIC_ACQUIRE, "agent");
            asm volatile("s_waitcnt vmcnt(0)" ::: "memory");
        }
    }
    __syncthreads();
}

struct Frame {
    LAS unsigned char* lds;
    volatile LAS unsigned* MISC;
    gu32* ctl;
    int tid, lane, wave;
    int vcu, G, li;
    float* out; unsigned char* ws;
};
enum { I_X = 0, I_LNMIX, I_WIN, I_CONV, I_ALOG, I_DTB, I_DNNORM, I_SINK, I_WOUT, I_LNFFN, I_WG, I_BG, I_WE, I_BE, I_WGU, I_WD, I_LNF };

__device__ __forceinline__ void transpose_item(const float* W, int ldn, int src_col0, int k0, bf16* WT, int ldk, int dst_row0, LAS float* scr, int lane) {
#pragma unroll 8
    for (int i = 0; i < 32; ++i) { const int kk = 2 * i + (lane >> 5); scr[kk * 33 + (lane & 31)] = __builtin_nontemporal_load(W + (size_t)(k0 + kk) * ldn + src_col0 + (lane & 31)); }
    LDS_WAIT(); asm volatile("" ::: "memory");
    const int c = lane & 7;
#pragma unroll
    for (int j = 0; j < 4; ++j) { const int n = (lane >> 3) + 8 * j; const LAS float* s = scr + (8 * c) * 33 + n;
        v4u o; o.x = pk2(s[0 * 33], s[1 * 33]); o.y = pk2(s[2 * 33], s[3 * 33]); o.z = pk2(s[4 * 33], s[5 * 33]); o.w = pk2(s[6 * 33], s[7 * 33]);
        __builtin_nontemporal_store(o, (v4u*)(WT + (size_t)(dst_row0 + n) * ldk + k0 + 8 * c)); }
    LDS_WAIT(); asm volatile("" ::: "memory");
}
__device__ __forceinline__ void p0_prologue(Frame& F, const float* x_in, const float* lnw, const float* w_in, const float* w_out, const float* a_log, const float* dt_b) {
    LAS float* scr = (LAS float*)(F.lds + F.wave * 16384);
    const int gw = F.vcu * NWAVES + F.wave, NGW = F.G * NWAVES;
    bf16* Win_t = (bf16*)(F.ws + WS_WIN); bf16* Wout_t = (bf16*)(F.ws + WS_WOUT);
    constexpr int I_IN = 16 * 88, I_OUT = 16 * 32, NITEMS = I_IN + I_OUT;
    for (int it = gw; it < NITEMS; it += NGW) {
        int r = it;
        if (r < I_IN) { const int kb = r / 88, nb = r % 88, n0 = 32 * nb; transpose_item(w_in, INW, n0 + (n0 >= 2048 ? 16 : 0), 64 * kb, Win_t, D, n0, scr, F.lane); continue; } r -= I_IN;
        { const int kb = r / 32, nb = r % 32; transpose_item(w_out, D, 32 * nb, 64 * kb, Wout_t, D, 32 * nb, scr, F.lane); }
    }
    __syncthreads();
    LAS float* w16T = (LAS float*)F.lds;
    for (int i = F.tid; i < D * 4; i += NTHR) { const int k = i >> 2, c4 = (i & 3) * 4; const f32x4 w = *(const f32x4*)(w_in + (size_t)k * INW + 2048 + c4);
        w16T[(c4 + 0) * D + k] = w.x; w16T[(c4 + 1) * D + k] = w.y; w16T[(c4 + 2) * D + k] = w.z; w16T[(c4 + 3) * D + k] = w.w; }
    __syncthreads();
    bf16* hn = (bf16*)(F.ws + WS_HN); float* bg = (float*)(F.ws + WS_BG);
    f32x4 lw[4];
#pragma unroll
    for (int j = 0; j < 4; ++j) lw[j] = ((const f32x4*)lnw)[F.lane + 64 * j];
    for (int m = gw; m < T; m += NGW) {
        const GAS f32x4* xr = (const GAS f32x4*)(x_in + (size_t)m * D) + F.lane;
        f32x4 v[4]; float s = 0.f;
#pragma unroll
        for (int j = 0; j < 4; ++j) { v[j] = xr[64 * j]; s += (v[j].x * v[j].x + v[j].y * v[j].y) + (v[j].z * v[j].z + v[j].w * v[j].w); }
        const float rstd = rsqrtf(wave_sum(s) * (1.f / D) + EPS);
#pragma unroll
        for (int j = 0; j < 4; ++j) v[j] = v[j] * rstd * lw[j];
        GAS unsigned long long* o8 = (GAS unsigned long long*)(hn + (size_t)m * D) + F.lane;
#pragma unroll
        for (int j = 0; j < 4; ++j) o8[64 * j] = (unsigned long long)pk2(v[j].x, v[j].y) | ((unsigned long long)pk2(v[j].z, v[j].w) << 32);
        float acc[16];
#pragma unroll
        for (int c = 0; c < 16; ++c) { float a = 0.f;
#pragma unroll
            for (int j = 0; j < 4; ++j) { const f32x4 w = *(const LAS f32x4*)(w16T + c * D + 4 * F.lane + 256 * j); a += (v[j].x * w.x + v[j].y * w.y) + (v[j].z * w.z + v[j].w * w.w); }
            acc[c] = a; if ((c & 3) == 3) asm volatile("" ::: "memory"); }
        const float tot = reduce16(acc, F.lane);
        if ((F.lane & 3) == 0) { const int idx = ((F.lane >> 5) & 1) * 8 + ((F.lane >> 4) & 1) * 4 + ((F.lane >> 3) & 1) * 2 + ((F.lane >> 2) & 1);
            if (idx < 8) bg[(size_t)m * 16 + idx] = 1.f / (1.f + expf(-tot));
            else bg[(size_t)m * 16 + idx] = -expf(a_log[idx - 8]) * softplus_f(tot + dt_b[idx - 8]); }
    }
}

typedef short bf16x8 __attribute__((ext_vector_type(8)));
typedef short bf16x4 __attribute__((ext_vector_type(4)));
typedef unsigned v2u __attribute__((ext_vector_type(2)));
constexpr size_t DN_QS = WS_DN, DN_KT = WS_DN + 32 * MiB, DN_U = WS_DN + 64 * MiB, DN_W = WS_DN + 128 * MiB, DN_AT = WS_DN + 192 * MiB;
constexpr size_t DN_GV = WS_MISC;
constexpr size_t SC_KKQK = WS_WGU, SC_VT = WS_WD;
#define MFMA16(a, b, c) __builtin_amdgcn_mfma_f32_16x16x32_bf16((a), (b), (c), 0, 0, 0)
#define RAW_BAR() do { asm volatile("s_waitcnt lgkmcnt(0)" ::: "memory"); __builtin_amdgcn_s_barrier(); asm volatile("" ::: "memory"); } while (0)

__device__ __forceinline__ void glds16(const void* gsrc, LAS unsigned char* ldst) {
    __builtin_amdgcn_global_load_lds((const unsigned*)gsrc, (LAS unsigned*)ldst, 16, 0, 0);
}
__device__ __forceinline__ void p2_group(Frame& F, int grp, const float* convw, const float* bgp, int stmask = 3) {
    const int tid = F.tid, lane = F.lane, w = F.wave;
    const bf16* proj = (const bf16*)(F.ws + WS_PROJ);
    LAS bf16* QL = (LAS bf16*)(F.lds + 52224);
    LAS bf16* KL = (LAS bf16*)(F.lds + 52224 + 17408);
    LAS float* CWL = (LAS float*)(F.lds + 139264);
    auto xin_issue = [&](int ui, LAS unsigned char* XB) {
        const int un = grp * 4 + ui, n = un & 127, bh = un >> 7, h = bh & 3, b = bh >> 2;
#pragma unroll 1
        for (int k = 0; k < 7; ++k) { const int pc = k * 8 + w;
            if (pc < 51) { const int c = pc * 64 + lane, rr = c / 48, rem = c - rr * 48, p = rem >> 4, c16 = rem & 15, s = 64 * n - 2 + rr;
                if (s >= 0 && s < SEQ) glds16(proj + (size_t)(b * SEQ + s) * NPROJ + p * 512 + h * 128 + c16 * 8, XB + pc * 1024);
                else *(LAS v4u*)(XB + c * 16) = (v4u){0u, 0u, 0u, 0u}; } }
    };
    if (stmask & 1) {
        xin_issue(0, F.lds);
        if (tid < 480) { const int pj = tid >> 5, c4 = tid & 31, p = pj / 5, j = pj - p * 5, h = ((grp * 4) >> 7) & 3;
            *(LAS f32x4*)(CWL + pj * 128 + 4 * c4) = *(const f32x4*)(convw + j * 1536 + p * 512 + h * 128 + 4 * c4); }
    }
#pragma unroll 1
    for (int ui = 0; ui < ((stmask & 1) ? 4 : 0); ++ui) {
        const int un = grp * 4 + ui, n = un & 127, bh = un >> 7, h = bh & 3, b = bh >> 2;
        LAS bf16* XIN = (LAS bf16*)(F.lds + (ui & 1) * 87040);
        asm volatile("s_waitcnt vmcnt(0) lgkmcnt(0)" ::: "memory"); __syncthreads();
        if (ui + 1 < 4) xin_issue(ui + 1, F.lds + ((ui + 1) & 1) * 87040);
        {
            float val[3][8][2];
#pragma unroll
            for (int p = 0; p < 3; ++p) {
                float cw[5][2];
#pragma unroll
                for (int j = 0; j < 5; ++j) { const LAS float* cp = CWL + (p * 5 + j) * 128 + 2 * lane; cw[j][0] = cp[0]; cw[j][1] = cp[1]; }
                float xr[12][2];
#pragma unroll
                for (int r = 0; r < 12; ++r) { const unsigned u2 = *(const LAS unsigned*)(XIN + (8 * w + r) * 384 + p * 128 + 2 * lane); xr[r][0] = bf2f((unsigned short)(u2 & 0xffffu)); xr[r][1] = bf2f((unsigned short)(u2 >> 16)); }
#pragma unroll
                for (int i = 0; i < 8; ++i) { float a0 = 0.f, a1 = 0.f;
#pragma unroll
                    for (int j = 0; j < 5; ++j) { a0 = fmaf(xr[i + j][0], cw[j][0], a0); a1 = fmaf(xr[i + j][1], cw[j][1], a1); }
                    val[p][i][0] = silu_f(a0); val[p][i][1] = silu_f(a1); }
            }
#pragma unroll
            for (int i = 0; i < 8; ++i) {
                const float sq = wave_sum(val[0][i][0] * val[0][i][0] + val[0][i][1] * val[0][i][1]);
                const float sk = wave_sum(val[1][i][0] * val[1][i][0] + val[1][i][1] * val[1][i][1]);
                const float rq = rsqrtf(sq + EPS) * 0.08838834764831845f, rk = rsqrtf(sk + EPS);
                val[0][i][0] *= rq; val[0][i][1] *= rq; val[1][i][0] *= rk; val[1][i][1] *= rk;
                const unsigned qp = pk2(val[0][i][0], val[0][i][1]), kp = pk2(val[1][i][0], val[1][i][1]);
                *(LAS unsigned*)(QL + (8 * w + i) * 136 + 2 * lane) = qp; *(LAS unsigned*)(KL + (8 * w + i) * 136 + 2 * lane) = kp;
                *(GAS unsigned*)((bf16*)(F.ws + DN_QS) + ((size_t)un * 64 + 8 * w + i) * 128 + 2 * lane) = qp;
            }
#pragma unroll
            for (int c = 0; c < 2; ++c) {
                v4u kt, vt;
                kt.x = pk2(val[1][0][c], val[1][1][c]); kt.y = pk2(val[1][2][c], val[1][3][c]); kt.z = pk2(val[1][4][c], val[1][5][c]); kt.w = pk2(val[1][6][c], val[1][7][c]);
                vt.x = pk2(val[2][0][c], val[2][1][c]); vt.y = pk2(val[2][2][c], val[2][3][c]); vt.z = pk2(val[2][4][c], val[2][5][c]); vt.w = pk2(val[2][6][c], val[2][7][c]);
                { bf16* kp = (bf16*)(F.ws + DN_KT) + ((size_t)un * 128 + 2 * lane + c) * 64 + 32 * (w >> 2) + 16 * (w & 1) + 4 * ((w & 3) >> 1);
                  *(GAS v2u*)kp = (v2u){kt.x, kt.y}; *(GAS v2u*)(kp + 8) = (v2u){kt.z, kt.w}; }
                *(GAS v4u*)((bf16*)(F.ws + SC_VT) + ((size_t)un * 128 + 2 * lane + c) * 64 + 8 * w) = vt;
            }
        }
        __syncthreads();
        {
            const int type = w >> 2, tr = w & 3, fr = lane & 15, fq = lane >> 4;
            const LAS bf16* Asrc = type ? QL : KL;
            bf16x8 af[4];
#pragma unroll
            for (int ks = 0; ks < 4; ++ks) af[ks] = *(const LAS bf16x8*)(Asrc + (16 * tr + fr) * 136 + 32 * ks + 8 * fq);
            float* G = (float*)(F.ws + SC_KKQK) + ((size_t)un * 2 + type) * 4096;
#pragma unroll
            for (int tc = 0; tc < 4; ++tc) { f32x4 acc = (f32x4){0.f, 0.f, 0.f, 0.f};
#pragma unroll
                for (int ks = 0; ks < 4; ++ks) { const bf16x8 bfr = *(const LAS bf16x8*)(KL + (16 * tc + fr) * 136 + 32 * ks + 8 * fq); acc = MFMA16(af[ks], bfr, acc); }
#pragma unroll
                for (int r = 0; r < 4; ++r) G[(16 * tr + 4 * fq + r) * 64 + 16 * tc + fr] = acc[r]; }
        }
    }
    VM_WAIT(); __syncthreads();
    if (tid == 0) { __builtin_amdgcn_fence(__ATOMIC_ACQUIRE, "agent"); VM_WAIT(); }
    __syncthreads();
    if (stmask & 2) {
        int lane = F.lane; asm volatile("" : "+v"(lane));
        const int un = grp * 4 + (w >> 1), dir = w & 1, n = un & 127, bh = un >> 7, h = bh & 3, b = bh >> 2, item = un * 2 + dir;
        const int rl = dir ? 63 - lane : lane;
        const size_t tok = (size_t)b * SEQ + 64 * n + rl;
        const float beta = bgp[tok * 16 + dir * 4 + h], g = bgp[tok * 16 + 8 + dir * 4 + h];
        float gc = g;
#pragma unroll
        for (int o = 1; o < 64; o <<= 1) { const float t = __shfl_up(gc, o); if (lane >= o) gc += t; }
        const float gcl = __shfl(gc, 63), egc = __expf(gc), ekd = __expf(gcl - gc);
        float* gv = (float*)(F.ws + DN_GV) + (size_t)item * 128; gv[lane] = egc; gv[64 + lane] = ekd;
        const float* KKp = (const float*)(F.ws + SC_KKQK) + (size_t)un * 8192; const float* QKp = KKp + 4096;
        bf16* ATp = (bf16*)(F.ws + DN_AT) + (size_t)item * 4096;
        float Tr[64];
        float kkc[8], qkc[8];
        const char* KKb = (const char*)KKp; char* ATb = (char*)ATp;
        const int kstep = dir ? -256 : 256;
        const unsigned kk0 = (unsigned)(((dir ? 63 : 0) * 64 + rl) * 4);
        {   unsigned o2 = kk0; asm volatile("" : "+v"(o2));
#pragma unroll
            for (int r = 0; r < 8; ++r) { kkc[r] = *(const float*)(KKb + (o2 + (unsigned)(r * kstep))); qkc[r] = *(const float*)(KKb + (o2 + (unsigned)(r * kstep) + 16384u)); } }
#pragma unroll
        for (int blk = 0; blk < 8; ++blk) {
            float kkn[8], qkn[8];
            {   unsigned o2 = kk0 + (unsigned)((blk < 7 ? 8 * (blk + 1) : 0) * kstep); asm volatile("" : "+v"(o2));
#pragma unroll
                for (int r = 0; r < 8; ++r) { kkn[r] = *(const float*)(KKb + (o2 + (unsigned)(r * kstep))); qkn[r] = *(const float*)(KKb + (o2 + (unsigned)(r * kstep) + 16384u)); } }
            unsigned ao = (unsigned)(lane * 2 + blk * 1024); asm volatile("" : "+v"(ao));
            asm volatile("" ::: "memory");
#pragma unroll
            for (int r = 0; r < 8; ++r) {
                const int i = 8 * blk + r;
                const float kk = kkc[r], qk = qkc[r];
                const float gci = __builtin_bit_cast(float, __builtin_amdgcn_readlane(__builtin_bit_cast(int, gc), i));
                const float bi = __builtin_bit_cast(float, __builtin_amdgcn_readlane(__builtin_bit_cast(int, beta), i));
                const float dec = __expf(fminf(gci - gc, 0.f));
                const float arow = (lane < i) ? bi * kk * dec : 0.f;
                *(bf16*)(ATb + (ao + (unsigned)(r * 128))) = (bf16)f2bf((lane <= i) ? qk * dec : 0.f);
                float t = (lane == i) ? 1.f : 0.f;
#pragma unroll
                for (int j = 0; j < i; ++j) { const float sv = __builtin_bit_cast(float, __builtin_amdgcn_readlane(__builtin_bit_cast(int, arow), j)); t = fmaf(-sv, Tr[j], t); }
                Tr[i] = t;
            }
            asm volatile("" ::: "memory");
#pragma unroll
            for (int r = 0; r < 8; ++r) { kkc[r] = kkn[r]; qkc[r] = qkn[r]; }
        }
        LAS bf16* TB = (LAS bf16*)(F.lds + w * 16384); LAS bf16* TG = TB + 4096;
        const float cb = beta, cg = beta * egc;
        const int rp = (rl & 32) | (((rl >> 2) & 3) << 3) | (((rl >> 4) & 1) << 2) | (rl & 3);
#pragma unroll
        for (int i = 0; i < 64; ++i) { const int off = i * 64 + ((((rl >> 3) ^ (i & 7))) << 3) + (rl & 7), offg = i * 64 + ((((rp >> 3) ^ (i & 7))) << 3) + (rp & 7);
            TB[off] = (bf16)f2bf(Tr[i] * cb); TG[offg] = (bf16)f2bf(Tr[i] * cg); }
        LDS_WAIT(); asm volatile("" ::: "memory");
        const int fr = lane & 15, fq = lane >> 4;
        bf16x8 ab[4][2], ag[4][2];
#pragma unroll
        for (int m = 0; m < 4; ++m)
#pragma unroll
            for (int ks = 0; ks < 2; ++ks) { const int row = 16 * m + fr, off = row * 64 + (((4 * ks + fq) ^ (row & 7)) << 3); ab[m][ks] = *(const LAS bf16x8*)(TB + off); ag[m][ks] = *(const LAS bf16x8*)(TG + off); }
        const bf16* VTp = (const bf16*)(F.ws + SC_VT) + (size_t)un * 8192; const bf16* KTp = (const bf16*)(F.ws + DN_KT) + (size_t)un * 8192;
        bf16* Up = (bf16*)(F.ws + DN_U) + (size_t)item * 8192; bf16* Wp = (bf16*)(F.ws + DN_W) + (size_t)item * 8192;
#pragma unroll 4
        for (int nn = 0; nn < 8; ++nn) {
            bf16x8 bv[2], bk[2];
#pragma unroll
            for (int ks = 0; ks < 2; ++ks) { bv[ks] = *(const GAS bf16x8*)(VTp + (16 * nn + fr) * 64 + 32 * ks + 8 * fq); bk[ks] = *(const GAS bf16x8*)(KTp + (16 * nn + fr) * 64 + 32 * ks + 8 * fq); }
#pragma unroll
            for (int m = 0; m < 4; ++m) {
                f32x4 au = (f32x4){0.f, 0.f, 0.f, 0.f}, aw = (f32x4){0.f, 0.f, 0.f, 0.f};
#pragma unroll
                for (int ks = 0; ks < 2; ++ks) { au = MFMA16(ab[m][ks], bv[ks], au); aw = MFMA16(bk[ks], ag[m][ks], aw); }
                v2u uo; uo.x = pk2(au[0], au[1]); uo.y = pk2(au[2], au[3]);
                *(GAS v2u*)(Up + ((m * 8 + nn) * 64 + lane) * 4) = uo;
                v2u wo; wo.x = pk2(aw[0], aw[1]); wo.y = pk2(aw[2], aw[3]);
                *(GAS v2u*)(Wp + (16 * m + fr) * 128 + 32 * (nn >> 1) + 8 * fq + 4 * (nn & 1)) = wo;
            }
        }
    }
    __syncthreads();
}

constexpr int CW_PROG = 36864;
constexpr int RB_W = 0, RB_KT = 16384, RB_U = 32768, RB_GV = 40960, RB_SIZE = 41984;
static_assert(3 * RB_SIZE <= RING_BYTES, "scan ring");
constexpr size_t DN_SX0 = DN_U + 32 * MiB, DN_SX1 = DN_W + 32 * MiB, DN_VX0 = DN_QS + 16 * MiB, DN_VX1 = DN_KT + 16 * MiB;
__device__ __forceinline__ void glds16_sc1(const void* gsrc, LAS unsigned char* ldst) {
    __builtin_amdgcn_global_load_lds((const unsigned*)gsrc, (LAS unsigned*)ldst, 16, 0, 16);
}
template <int OFF>
__device__ __forceinline__ void store16_sc1(void* gdst, v4u v) {
    asm volatile("global_store_dwordx4 %0, %1, off offset:%2 sc1\n\ts_nop 1" :: "v"(gdst), "v"(v), "n"(OFF) : "memory");
}
__device__ __forceinline__ bf16x8 ld2x8(const LAS unsigned char* p0, const LAS unsigned char* p1) {
    const v2u lo = *(const LAS v2u*)p0, hi = *(const LAS v2u*)p1; v4u v; v.x = lo.x; v.y = lo.y; v.z = hi.x; v.w = hi.y; return __builtin_bit_cast(bf16x8, v);
}
struct ScanOff { unsigned w0[4], k0[2], u, gk; };
template <int DIR, int BUF>
__device__ __forceinline__ void scan_step(LAS unsigned char* L, const ScanOff& O, f32x4 (&S)[8], unsigned char*& sxp, unsigned char*& vxp, bool ex) {
    const LAS unsigned char* B = L + BUF * RB_SIZE;
    v4u sbv[4];
#pragma unroll
    for (int ks = 0; ks < 4; ++ks) { sbv[ks].x = pk2(S[2 * ks][0], S[2 * ks][1]); sbv[ks].y = pk2(S[2 * ks][2], S[2 * ks][3]); sbv[ks].z = pk2(S[2 * ks + 1][0], S[2 * ks + 1][1]); sbv[ks].w = pk2(S[2 * ks + 1][2], S[2 * ks + 1][3]); }
    if (ex) { store16_sc1<0>(sxp, sbv[0]); store16_sc1<1024>(sxp, sbv[1]); store16_sc1<2048>(sxp, sbv[2]); store16_sc1<3072>(sxp, sbv[3]); }
    bf16x8 fw[4][4]; v2u ucv[4]; f32x4 ekv[4];
#pragma unroll
    for (int it = 0; it < 4; ++it) {
#pragma unroll
        for (int ks = 0; ks < 4; ++ks) fw[it][ks] = *(const LAS bf16x8*)(B + RB_W + O.w0[ks] + it * 4096);
        ucv[it] = *(const LAS v2u*)(B + RB_U + O.u + it * 2048); ekv[it] = *(const LAS f32x4*)(B + RB_GV + O.gk + it * 64); }
    const float dch = ((const LAS float*)(B + RB_GV))[63];
    f32x4 aW[4];
#pragma unroll
    for (int it = 0; it < 4; ++it) { aW[it] = (f32x4){0.f, 0.f, 0.f, 0.f};
#pragma unroll
        for (int ks = 0; ks < 4; ++ks) aW[it] = MFMA16(fw[it][ks], __builtin_bit_cast(bf16x8, sbv[ks]), aW[it]); }
    bf16x8 fk[8][2];
#pragma unroll
    for (int dt = 0; dt < 8; ++dt)
#pragma unroll
        for (int k2 = 0; k2 < 2; ++k2) fk[dt][k2] = *(const LAS bf16x8*)(B + RB_KT + O.k0[k2] + dt * 2048);
    f32x4 vs[4]; v2u vnp[4];
#pragma unroll
    for (int it = 0; it < 4; ++it) {
        const v2u uc = ucv[it]; const f32x4 ek = ekv[it];
        f32x4 vn;
        vn[0] = bf2f((unsigned short)(uc.x & 0xffffu)) - aW[it][0]; vn[1] = bf2f((unsigned short)(uc.x >> 16)) - aW[it][1];
        vn[2] = bf2f((unsigned short)(uc.y & 0xffffu)) - aW[it][2]; vn[3] = bf2f((unsigned short)(uc.y >> 16)) - aW[it][3];
        vnp[it] = (v2u){pk2(vn[0], vn[1]), pk2(vn[2], vn[3])};
        vs[it] = vn * ek;
    }
    if (ex) { store16_sc1<0>(vxp, (v4u){vnp[0].x, vnp[0].y, vnp[1].x, vnp[1].y}); store16_sc1<1024>(vxp, (v4u){vnp[2].x, vnp[2].y, vnp[3].x, vnp[3].y}); }
    sxp += DIR ? -32768 : 32768; vxp += DIR ? -16384 : 16384;
    bf16x8 Vsb[2];
#pragma unroll
    for (int k2 = 0; k2 < 2; ++k2) { v4u t;
        if (DIR) { t.x = pk2(vs[2 * k2 + 1][3], vs[2 * k2 + 1][2]); t.y = pk2(vs[2 * k2 + 1][1], vs[2 * k2 + 1][0]); t.z = pk2(vs[2 * k2][3], vs[2 * k2][2]); t.w = pk2(vs[2 * k2][1], vs[2 * k2][0]); }
        else { t.x = pk2(vs[2 * k2][0], vs[2 * k2][1]); t.y = pk2(vs[2 * k2][2], vs[2 * k2][3]); t.z = pk2(vs[2 * k2 + 1][0], vs[2 * k2 + 1][1]); t.w = pk2(vs[2 * k2 + 1][2], vs[2 * k2 + 1][3]); }
        Vsb[k2] = __builtin_bit_cast(bf16x8, t); }
#pragma unroll
    for (int dt = 0; dt < 8; ++dt) { S[dt] = S[dt] * dch;
#pragma unroll
        for (int k2 = 0; k2 < 2; ++k2) S[dt] = MFMA16(fk[dt][k2], Vsb[k2], S[dt]); }
    asm volatile("s_waitcnt vmcnt(12) lgkmcnt(0)" ::: "memory"); __builtin_amdgcn_s_barrier(); asm volatile("" ::: "memory");
}
template <int DIR>
__device__ __forceinline__ void scan_compute(Frame& F, LAS unsigned char* L, int hf, int bh, int mode) {
    const int lane = F.lane, w = F.wave, fr = lane & 15, fq = lane >> 4;
    ScanOff O;
    const int s7 = (fr >> 1) & 7;
#pragma unroll
    for (int ks = 0; ks < 4; ++ks) O.w0[ks] = (unsigned)(fr * 256 + (((4 * ks + fq) ^ fr) << 4));
#pragma unroll
    for (int k2 = 0; k2 < 2; ++k2) {
        const int ck = DIR ? 4 * (1 - k2) + (3 - fq) : 4 * k2 + fq;
        O.k0[k2] = (unsigned)(fr * 128 + ((ck ^ s7) << 4));
    }
    O.u = (unsigned)((w * 64 + lane) * 8); O.gk = (unsigned)((64 + 4 * fq) * 4);
    const int item0 = (bh * 128 + (DIR ? 127 : 0)) * 2 + DIR;
    unsigned char* sxp = F.ws + (hf ? DN_SX1 : DN_SX0) + (size_t)item0 * 16384 + w * 4096 + lane * 16;
    unsigned char* vxp = F.ws + (hf ? DN_VX1 : DN_VX0) + (size_t)item0 * 8192 + w * 2048 + lane * 16;
    const bool ex = !(mode & 1);
    f32x4 S[8];
#pragma unroll
    for (int t = 0; t < 8; ++t) S[t] = (f32x4){0.f, 0.f, 0.f, 0.f};
    __builtin_amdgcn_s_barrier(); asm volatile("" ::: "memory");
#pragma unroll 1
    for (int step = 0; step < 126; step += 3) { scan_step<DIR, 0>(L, O, S, sxp, vxp, ex); scan_step<DIR, 1>(L, O, S, sxp, vxp, ex); scan_step<DIR, 2>(L, O, S, sxp, vxp, ex); }
    scan_step<DIR, 0>(L, O, S, sxp, vxp, ex); scan_step<DIR, 1>(L, O, S, sxp, vxp, ex);
}
__device__ __forceinline__ void scan_loader(Frame& F, LAS unsigned char* L, int c, int hf, int dir, int bh, int mode) {
    const int lane = F.lane, lw = F.wave - 4;
    unsigned goff[11];
#pragma unroll
    for (int k = 0; k < 11; ++k) { const int p = lw + 4 * k, q = (p & 15) * 64 + lane;
        if (p < 16) { const int row = q >> 4, ch = (q & 15) ^ (row & 15); goff[k] = (unsigned)(row * 256 + ch * 16); }
        else if (p < 32) { const int row = q >> 3, ch = (q & 7) ^ ((row >> 1) & 7); goff[k] = (unsigned)(row * 128 + ch * 16); }
        else if (p < 40) { const int pu = p - 32; goff[k] = (unsigned)((((pu >> 1) * 8 + 4 * hf) * 512) + (pu & 1) * 1024 + lane * 16); }
        else goff[k] = (unsigned)(lane * 16); }
    unsigned* prog = (unsigned*)(F.ctl + CW_PROG + 2048 * F.li + 64 * (c * 2 + hf));
    auto issue = [&](int t, LAS unsigned char* B) {
        const int nc = dir ? 127 - t : t, un = bh * 128 + nc, item = un * 2 + dir;
        const unsigned char* gW = F.ws + DN_W + (size_t)item * 16384; const unsigned char* gK = F.ws + DN_KT + (size_t)un * 16384;
        const unsigned char* gU = F.ws + DN_U + (size_t)item * 16384; const unsigned char* gG = F.ws + DN_GV + (size_t)item * 512;
#pragma unroll
        for (int k = 0; k < 11; ++k) { const int p = lw + 4 * k;
            if (k < 4) glds16(gW + goff[k], B + RB_W + p * 1024);
            else if (k < 8) glds16(gK + goff[k], B + RB_KT + (p - 16) * 1024);
            else if (k < 10) glds16(gU + goff[k], B + RB_U + (p - 32) * 1024);
            else if (lw == 0) glds16(gG + goff[k], B + RB_GV); }
    };
    if (!(mode & 2)) issue(0, L);
    int nb = 1;
#pragma unroll 1
    for (int k = 0; k <= 128; ++k) {
        if (k + 1 < 128 && !(mode & 2)) { issue(k + 1, L + nb * RB_SIZE);
            if (lw == 0) asm volatile("s_waitcnt vmcnt(11)" ::: "memory"); else asm volatile("s_waitcnt vmcnt(10)" ::: "memory"); }
        else asm volatile("s_waitcnt vmcnt(0)" ::: "memory");
        if (++nb == 3) nb = 0;
        __builtin_amdgcn_s_barrier(); asm volatile("" ::: "memory");
        if (lw == 0 && lane == 0 && k >= 3 && !(mode & 1)) __hip_atomic_store(prog, (unsigned)(k - 2), RLX_AGENT);
    }
}
__device__ __forceinline__ void p3_scan(Frame& F, int c, int hf, int mode  ) {
    const int b = c >> 3, h = (c >> 1) & 3, dir = c & 1, bh = b * 4 + h;
    LAS unsigned char* L = F.lds;
    if (F.wave >= 4) scan_loader(F, L, c, hf, dir, bh, mode);
    else if (dir) scan_compute<1>(F, L, hf, bh, mode); else scan_compute<0>(F, L, hf, bh, mode);
    asm volatile("s_waitcnt vmcnt(0) lgkmcnt(0)" ::: "memory"); __syncthreads();
    if (F.tid == 256 && !(mode & 1)) __hip_atomic_store((unsigned*)(F.ctl + CW_PROG + 2048 * F.li + 64 * (c * 2 + hf)), 128u, RLX_AGENT);
    __syncthreads();
}

constexpr int OL_Q = 0, OL_AT = 16384, OL_SX = 24576, OL_VX = 40960, OL_GV = 49152, OL_SIZE = 50176;
__device__ __forceinline__ void p3_out_issue(Frame& F, int j, LAS unsigned char* Lb) {
    const int lane = F.lane, w = F.wave;
    const int n = j >> 5, wg = j & 31, c = wg >> 1, hf = wg & 1, b = c >> 3, h = (c >> 1) & 3, dir = c & 1, bh = b * 4 + h;
    const int nc = dir ? 127 - n : n, un = bh * 128 + nc, item = un * 2 + dir;
    const unsigned char* gQ = F.ws + DN_QS + (size_t)un * 16384; const unsigned char* gA = F.ws + DN_AT + (size_t)item * 8192;
    const unsigned char* gS = F.ws + (hf ? DN_SX1 : DN_SX0) + (size_t)item * 16384; const unsigned char* gV = F.ws + (hf ? DN_VX1 : DN_VX0) + (size_t)item * 8192;
#pragma unroll
    for (int k = 0; k < 2; ++k) { const int p = 2 * w + k, q = p * 64 + lane, row = q >> 4, ch = (q & 15) ^ (row & 15);
        glds16(gQ + row * 256 + ch * 16, Lb + OL_Q + p * 1024); glds16_sc1(gS + p * 1024 + lane * 16, Lb + OL_SX + p * 1024); }
    { const int q = w * 64 + lane, row = q >> 3, ch = (q & 7) ^ ((row >> 1) & 7); glds16(gA + row * 128 + ch * 16, Lb + OL_AT + w * 1024); glds16_sc1(gV + w * 1024 + lane * 16, Lb + OL_VX + w * 1024); }
    if (w == 0) glds16(F.ws + DN_GV + (size_t)item * 512 + lane * 16, Lb + OL_GV);
}
__device__ __forceinline__ void p3_out_compute(Frame& F, int j, const LAS unsigned char* Lb, float* odir) {
    const int lane = F.lane, w = F.wave, fr = lane & 15, fq = lane >> 4, mi = w >> 1, eh = w & 1;
    const int n = j >> 5, wg = j & 31, c = wg >> 1, hf = wg & 1, b = c >> 3, h = (c >> 1) & 3, dir = c & 1;
    const int nc = dir ? 127 - n : n;
    const int irow = 16 * mi + fr, qrow = dir ? 63 - irow : irow;
    const int hb = 8 * (fq & 1), fh = fq >> 1;
    f32x4 aQ[2];
#pragma unroll
    for (int t = 0; t < 2; ++t) aQ[t] = (f32x4){0.f, 0.f, 0.f, 0.f};
#pragma unroll
    for (int ks = 0; ks < 4; ++ks) {
        const bf16x8 fqv = ld2x8(Lb + OL_Q + qrow * 256 + (((4 * ks + fh) ^ (qrow & 15)) << 4) + hb, Lb + OL_Q + qrow * 256 + (((4 * ks + 2 + fh) ^ (qrow & 15)) << 4) + hb);
#pragma unroll
        for (int t = 0; t < 2; ++t) { const bf16x8 fs = *(const LAS bf16x8*)(Lb + OL_SX + ((2 * eh + t) * 4 + ks) * 1024 + lane * 16); aQ[t] = MFMA16(fs, fqv, aQ[t]); }
    }
    const float egc_i = ((const LAS float*)(Lb + OL_GV))[irow];
#pragma unroll
    for (int t = 0; t < 2; ++t) aQ[t] = aQ[t] * egc_i;
#pragma unroll
    for (int ks = 0; ks < 2; ++ks) {
        const bf16x8 fa = ld2x8(Lb + OL_AT + irow * 128 + (((4 * ks + fh) ^ ((irow >> 1) & 7)) << 4) + hb, Lb + OL_AT + irow * 128 + (((4 * ks + 2 + fh) ^ ((irow >> 1) & 7)) << 4) + hb);
#pragma unroll
        for (int t = 0; t < 2; ++t) { const bf16x8 fv = *(const LAS bf16x8*)(Lb + OL_VX + ((2 * eh + t) * 2 + ks) * 1024 + lane * 16); aQ[t] = MFMA16(fv, fa, aQ[t]); }
    }
    const size_t tok = (size_t)b * SEQ + 64 * nc + qrow;
    float* op = odir + ((size_t)dir * T + tok) * 512 + h * 128 + 64 * hf + 4 * fq;
#pragma unroll
    for (int t = 0; t < 2; ++t) *(GAS f32x4*)(op + 16 * (2 * eh + t)) = aQ[t];
}
__device__ __forceinline__ void p3_out_batch(Frame& F, int j0, int cnt  , float* odir) {
    const int n = j0 >> 5;
    LAS unsigned char* L = F.lds;
    if (F.tid < 64) { unsigned sp = 0;
        for (;;) { bool ok = true; if (F.tid < cnt) ok = (int)__hip_atomic_load((unsigned*)(F.ctl + CW_PROG + 2048 * F.li + 64 * ((j0 & 31) + F.tid)), RLX_AGENT) > n;
            if (__all(ok) || ++sp > (1u << 22)) break; __builtin_amdgcn_s_sleep(127); __builtin_amdgcn_s_sleep(127); } }
    __syncthreads();
    p3_out_issue(F, j0, L); p3_out_issue(F, j0 + (cnt > 1 ? 1 : 0), L + OL_SIZE);
    int bk = 0;
#pragma unroll 1
    for (int k = 0; k < cnt; ++k) {
        asm volatile("s_waitcnt vmcnt(6) lgkmcnt(0)" ::: "memory"); __builtin_amdgcn_s_barrier(); asm volatile("" ::: "memory");
        { int b2 = bk + 2; if (b2 >= 3) b2 -= 3; const int kn = k + 2 < cnt ? k + 2 : cnt - 1; p3_out_issue(F, j0 + kn, L + b2 * OL_SIZE); }
        p3_out_compute(F, j0 + k, L + bk * OL_SIZE, odir);
        if (++bk == 3) bk = 0;
    }
    asm volatile("s_waitcnt vmcnt(0) lgkmcnt(0)" ::: "memory"); __syncthreads();
}
typedef float f32x16 __attribute__((ext_vector_type(16)));
#define MFMA32(a, b, c) __builtin_amdgcn_mfma_f32_32x32x16_bf16((a), (b), (c), 0, 0, 0)
constexpr size_t WS_ROT = WS_CTL + 256 * 1024;
constexpr int VT_PITCH = 324;
constexpr int CW_WQ = 49152;
constexpr int LT_WQ = LDSCTL_OFF + 512;

__device__ __forceinline__ void p0_rot_table(Frame& F) {
    float* rot = (float*)(F.ws + WS_ROT);
    for (int i = (F.vcu * NTHR + F.tid); i < SEQ * 8; i += F.G * NTHR) { const int s = i >> 3, k = i & 7;
        const float inv = powf(500000.f, -(float)(2 * k) / 16.f); float sn, cs; sincosf((float)s * inv, &sn, &cs); rot[2 * i] = cs; rot[2 * i + 1] = sn; }
}

__device__ __forceinline__ void p3_attn_unit(Frame& F, int unit, const float* sink) {
    const int tid = F.tid, lane = F.lane, w = F.wave, r = lane & 31, hh = lane >> 5;
    const int b = unit >> 8, kvh = (unit >> 7) & 1, qt = unit & 127, k0 = 64 * qt - 128;
    const bf16* proj = (const bf16*)(F.ws + WS_PROJ); const float* rot = (const float*)(F.ws + WS_ROT);
    LAS bf16* KLs = (LAS bf16*)F.lds;
    LAS bf16* VTs = (LAS bf16*)(F.lds + 40960);
#pragma unroll 1
    for (int idx = tid; idx < 320 * 8; idx += NTHR) {
        const int key = idx >> 3, ch = idx & 7, kp = k0 + key;
        v4u kv = (v4u){0u, 0u, 0u, 0u}, vv = (v4u){0u, 0u, 0u, 0u};
        if (kp >= 0 && kp < SEQ) {
            const bf16* rowp = proj + (size_t)(b * SEQ + kp) * NPROJ;
            vv = *(const GAS v4u*)(rowp + PJ_AV + kvh * 64 + ch * 8);
            if (ch >= 2) kv = *(const GAS v4u*)(rowp + PJ_AK + kvh * 64 + ch * 8);
            else {
                const v4u a = *(const GAS v4u*)(rowp + PJ_AK + kvh * 64), c = *(const GAS v4u*)(rowp + PJ_AK + kvh * 64 + 8);
                const float* rp = rot + (size_t)kp * 16; float o[8];
#pragma unroll
                for (int i = 0; i < 8; ++i) { const unsigned ua = a[i >> 1], uc = c[i >> 1];
                    const float x1 = bf2f((unsigned short)((i & 1) ? (ua >> 16) : (ua & 0xffffu))), x2 = bf2f((unsigned short)((i & 1) ? (uc >> 16) : (uc & 0xffffu)));
                    const float cs = rp[2 * i], sn = rp[2 * i + 1]; o[i] = ch == 0 ? x1 * cs - x2 * sn : x2 * cs + x1 * sn; }
                kv.x = pk2(o[0], o[1]); kv.y = pk2(o[2], o[3]); kv.z = pk2(o[4], o[5]); kv.w = pk2(o[6], o[7]);
            }
        }
        *(LAS v4u*)(KLs + key * 64 + ((ch ^ ((key >> 1) & 7)) << 3)) = kv;
#pragma unroll
        for (int i = 0; i < 8; ++i) { const unsigned u = vv[i >> 1]; VTs[(ch * 8 + i) * VT_PITCH + key] = (bf16)((i & 1) ? (u >> 16) : (u & 0xffffu)); }
    }
    const int hq = kvh * 4 + (w >> 1), qp = 64 * qt + 32 * (w & 1) + r;
    const bf16* qrow = proj + (size_t)(b * SEQ + qp) * NPROJ + PJ_AQ + hq * 64;
    bf16x8 qf[4];
    {
        const v4u a = *(const GAS v4u*)(qrow), c = *(const GAS v4u*)(qrow + 8);
        const float* rp = rot + (size_t)qp * 16; float o[8];
#pragma unroll
        for (int i = 0; i < 8; ++i) { const unsigned ua = a[i >> 1], uc = c[i >> 1];
            const float x1 = bf2f((unsigned short)((i & 1) ? (ua >> 16) : (ua & 0xffffu))), x2 = bf2f((unsigned short)((i & 1) ? (uc >> 16) : (uc & 0xffffu)));
            const float cs = rp[2 * i], sn = rp[2 * i + 1]; o[i] = (hh == 0 ? x1 * cs - x2 * sn : x2 * cs + x1 * sn) * 0.125f; }
        v4u q0; q0.x = pk2(o[0], o[1]); q0.y = pk2(o[2], o[3]); q0.z = pk2(o[4], o[5]); q0.w = pk2(o[6], o[7]);
        qf[0] = __builtin_bit_cast(bf16x8, q0);
#pragma unroll
        for (int s = 1; s < 4; ++s) { const v4u q = *(const GAS v4u*)(qrow + 16 * s + 8 * hh); float t[8];
#pragma unroll
            for (int i = 0; i < 8; ++i) { const unsigned u = q[i >> 1]; t[i] = bf2f((unsigned short)((i & 1) ? (u >> 16) : (u & 0xffffu))) * 0.125f; }
            v4u qq; qq.x = pk2(t[0], t[1]); qq.y = pk2(t[2], t[3]); qq.z = pk2(t[4], t[5]); qq.w = pk2(t[6], t[7]); qf[s] = __builtin_bit_cast(bf16x8, qq); }
    }
    __syncthreads();
    float m = sink[hq], l = hh == 0 ? 1.f : 0.f;
    f32x16 O[2];
#pragma unroll
    for (int i = 0; i < 16; ++i) { O[0][i] = 0.f; O[1][i] = 0.f; }
#pragma unroll 1
    for (int kb = (w & 1); kb < (w & 1) + 9; ++kb) {
        f32x16 X;
#pragma unroll
        for (int i = 0; i < 16; ++i) X[i] = 0.f;
        const int krow = 32 * kb + r;
#pragma unroll
        for (int s = 0; s < 4; ++s) { const bf16x8 ka = *(const LAS bf16x8*)(KLs + krow * 64 + (((2 * s + hh) ^ ((krow >> 1) & 7)) << 3)); X = MFMA32(ka, qf[s], X); }
        float bm = -1e30f;
#pragma unroll
        for (int i = 0; i < 16; ++i) { const int kp = k0 + 32 * kb + (i & 3) + 8 * (i >> 2) + 4 * hh, dlt = qp - kp;
            const bool ok = (dlt <= 128) && (dlt >= -128) && (kp >= 0) && (kp < SEQ); X[i] = ok ? X[i] : -1e30f; bm = fmaxf(bm, X[i]); }
        bm = fmaxf(bm, __shfl_xor(bm, 32));
        const float mn = fmaxf(m, bm), alpha = __expf(m - mn); m = mn;
        float ps = 0.f;
#pragma unroll
        for (int i = 0; i < 16; ++i) { X[i] = __expf(X[i] - mn); ps += X[i]; }
        l = l * alpha + ps;
#pragma unroll
        for (int i = 0; i < 16; ++i) { O[0][i] *= alpha; O[1][i] *= alpha; }
        bf16x8 pk[2];
#pragma unroll
        for (int s = 0; s < 2; ++s) { v4u t; t.x = pk2(X[8 * s], X[8 * s + 1]); t.y = pk2(X[8 * s + 2], X[8 * s + 3]); t.z = pk2(X[8 * s + 4], X[8 * s + 5]); t.w = pk2(X[8 * s + 6], X[8 * s + 7]); pk[s] = __builtin_bit_cast(bf16x8, t); }
#pragma unroll
        for (int dt = 0; dt < 2; ++dt)
#pragma unroll
            for (int s = 0; s < 2; ++s) { const LAS bf16* vp = VTs + (32 * dt + r) * VT_PITCH + 32 * kb + 16 * s + 4 * hh;
                const v2u lo = *(const LAS v2u*)vp, hi = *(const LAS v2u*)(vp + 8); v4u va; va.x = lo.x; va.y = lo.y; va.z = hi.x; va.w = hi.y;
                O[dt] = MFMA32(__builtin_bit_cast(bf16x8, va), pk[s], O[dt]); }
    }
    l += __shfl_xor(l, 32);
    const float inv = 1.f / l;
    bf16* orow = (bf16*)(F.ws + WS_MIX) + (size_t)(b * SEQ + qp) * D + 512 + hq * 64;
#pragma unroll
    for (int dt = 0; dt < 2; ++dt)
#pragma unroll
        for (int g = 0; g < 4; ++g) { v2u o; o.x = pk2(O[dt][4 * g] * inv, O[dt][4 * g + 1] * inv); o.y = pk2(O[dt][4 * g + 2] * inv, O[dt][4 * g + 3] * inv);
            *(GAS v2u*)(orow + 32 * dt + 8 * g + 4 * hh) = o; }
    __syncthreads();
}

__device__ __forceinline__ void p3_moe_weight_items(Frame& F, int first_wave, int n_waves, int end_item, const float* w_gu, const float* w_dn) {
    LAS float* scr = (LAS float*)(F.lds + F.wave * 16384);
    bf16* Wgu_t = (bf16*)(F.ws + WS_WGU); bf16* Wd_t = (bf16*)(F.ws + WS_WD);
    constexpr int I_GU = NEXP * 16 * 16, I_DN = NEXP * 4 * 32;
#pragma unroll 1
    for (int it = first_wave; it < end_item; it += n_waves) {
        if (it < I_GU) { const int e = it >> 8, kb = (it >> 4) & 15, nb = it & 15, n0 = 32 * nb, pn = n0 >> 8, bj = (n0 >> 7) & 1, c = n0 & 127;
            transpose_item(w_gu + (size_t)e * D * 512, 512, bj * 256 + pn * 128 + c, 64 * kb, Wgu_t + (size_t)e * 512 * D, D, n0, scr, F.lane); }
        else { const int r2 = it - I_GU, e = r2 >> 7, kb = (r2 >> 5) & 3, nb = r2 & 31; transpose_item(w_dn + (size_t)e * EFF * D, D, 32 * nb, 64 * kb, Wd_t + (size_t)e * D * EFF, EFF, 32 * nb, scr, F.lane); }
    }
}

__device__ __forceinline__ void p4_combine(Frame& F, const float* odir, const float* normw) {
    const int gw = F.vcu * NWAVES + F.wave, NGW = F.G * NWAVES, lane = F.lane;
    const bf16* proj = (const bf16*)(F.ws + WS_PROJ); bf16* mix = (bf16*)(F.ws + WS_MIX);
    const f32x4 nw0 = *(const f32x4*)(normw + 8 * (lane & 15)), nw1 = *(const f32x4*)(normw + 8 * (lane & 15) + 4);
#pragma unroll 1
    for (int tok = gw; tok < T; tok += NGW) {
        const float* of = odir + (size_t)tok * 512 + 8 * lane; const float* ob = of + (size_t)T * 512;
        const f32x4 a0 = *(const GAS f32x4*)of + *(const GAS f32x4*)ob, a1 = *(const GAS f32x4*)(of + 4) + *(const GAS f32x4*)(ob + 4);
        float s = (a0.x * a0.x + a0.y * a0.y) + (a0.z * a0.z + a0.w * a0.w) + (a1.x * a1.x + a1.y * a1.y) + (a1.z * a1.z + a1.w * a1.w);
        s += __shfl_xor(s, 1); s += __shfl_xor(s, 2); s += __shfl_xor(s, 4); s += __shfl_xor(s, 8);
        const float rs = rsqrtf(s * (1.f / 128.f) + EPS);
        const v4u zz = *(const GAS v4u*)(proj + (size_t)tok * NPROJ + PJ_Z + 8 * lane);
        float z[8];
#pragma unroll
        for (int i = 0; i < 8; ++i) { const unsigned u = zz[i >> 1]; z[i] = bf2f((unsigned short)((i & 1) ? (u >> 16) : (u & 0xffffu))); }
        v4u o;
        o.x = pk2(a0.x * rs * nw0.x * silu_f(z[0]), a0.y * rs * nw0.y * silu_f(z[1])); o.y = pk2(a0.z * rs * nw0.z * silu_f(z[2]), a0.w * rs * nw0.w * silu_f(z[3]));
        o.z = pk2(a1.x * rs * nw1.x * silu_f(z[4]), a1.y * rs * nw1.y * silu_f(z[5])); o.w = pk2(a1.z * rs * nw1.z * silu_f(z[6]), a1.w * rs * nw1.w * silu_f(z[7]));
        *(GAS v4u*)(mix + (size_t)tok * D + 8 * lane) = o;
    }
}
constexpr size_t WS_RW = 488 * MiB;
constexpr size_t RW_HI = WS_RW, RW_LO = WS_RW + 256 * 1024, RW_RSTD = WS_RW + 512 * 1024, RW_GATE = WS_RW + 640 * 1024;
constexpr size_t WS_LIST = WS_MISC + 2 * MiB;
constexpr size_t WS_XS = WS_DN, WS_HMID = WS_DN + 96 * MiB, WS_Y2 = WS_DN + 120 * MiB;
constexpr int CW_CNT = 32768;
constexpr int LT_PSTART = LDSCTL_OFF + 1024, LT_PTAB = LDSCTL_OFF + 1536;

__device__ __forceinline__ void p0_router_weights(Frame& F, const float* lnw, const float* wg, const float* we) {
    bf16* hi = (bf16*)(F.ws + RW_HI); bf16* lo = (bf16*)(F.ws + RW_LO);
    for (int i = F.vcu * NTHR + F.tid; i < 80 * D; i += F.G * NTHR) { const int n = i >> 10, k = i & 1023;
        float v = 0.f; if (n < 8) v = wg[k * 8 + n] * lnw[k]; else if (n < 72) v = we[k * 64 + (n - 8)] * lnw[k];
        const unsigned h = f2bf(v); const float r = v - bf2f((unsigned short)h); hi[i] = (bf16)h; lo[i] = (bf16)f2bf(r); }
}
__device__ __forceinline__ void split8(const f32x4 a, const f32x4 b, bf16x8& h, bf16x8& l) {
    const float x[8] = {a.x, a.y, a.z, a.w, b.x, b.y, b.z, b.w}; unsigned hh[8], ll[8];
#pragma unroll
    for (int i = 0; i < 8; ++i) { hh[i] = f2bf(x[i]); ll[i] = f2bf(x[i] - bf2f((unsigned short)hh[i])); }
    v4u vh, vl; vh.x = hh[0] | (hh[1] << 16); vh.y = hh[2] | (hh[3] << 16); vh.z = hh[4] | (hh[5] << 16); vh.w = hh[6] | (hh[7] << 16);
    vl.x = ll[0] | (ll[1] << 16); vl.y = ll[2] | (ll[3] << 16); vl.z = ll[4] | (ll[5] << 16); vl.w = ll[6] | (ll[7] << 16);
    h = __builtin_bit_cast(bf16x8, vh); l = __builtin_bit_cast(bf16x8, vl);
}
__device__ __forceinline__ void p6_route(Frame& F, const float* lnw, const float* bgrp, const float* bexp, int dry) {
    const int lane = F.lane, w = F.wave, fr = lane & 15, fq = lane >> 4;
    const float* x1 = F.out; bf16* h2u = (bf16*)(F.ws + WS_HN);
    const bf16* Wh = (const bf16*)(F.ws + RW_HI); const bf16* Wl = (const bf16*)(F.ws + RW_LO);
    LAS float* PL = (LAS float*)F.lds;
    LAS float* PS = PL + 8 * 32 * 80;
    LAS float* LG = PS + 8 * 32;
    LAS float* RS = LG + 32 * 80;
    LAS int* LC = (LAS int*)(RS + 32);
    LAS int* PK = LC + 64;
    unsigned* cnt = (unsigned*)(F.ctl + CW_CNT + (dry ? 24576 : 0)); int* list = (int*)(F.ws + (dry ? WS_DN + 196 * MiB : WS_LIST)); float* pgate = (float*)(F.ws + RW_GATE); float* rstd_g = (float*)(F.ws + RW_RSTD);
#pragma unroll 1
    for (int grp = blockIdx.x; grp < T / 64; grp += F.G) {
        if (F.tid < 64) LC[F.tid] = 0;
        f32x4 acc[4][5]; float ss[4];
#pragma unroll
        for (int tl = 0; tl < 4; ++tl) { ss[tl] = 0.f;
#pragma unroll
            for (int c = 0; c < 5; ++c) acc[tl][c] = (f32x4){0.f, 0.f, 0.f, 0.f}; }
#pragma unroll 1
        for (int kk = 0; kk < 4; ++kk) {
            const int k0 = 32 * (4 * w + kk) + 8 * fq;
            bf16x8 bh[5], bl[5];
#pragma unroll
            for (int c = 0; c < 5; ++c) { bh[c] = *(const GAS bf16x8*)(Wh + (size_t)(16 * c + fr) * D + k0); bl[c] = *(const GAS bf16x8*)(Wl + (size_t)(16 * c + fr) * D + k0); }
            const f32x4 la = *(const f32x4*)(lnw + k0), lb = *(const f32x4*)(lnw + k0 + 4);
#pragma unroll
            for (int tl = 0; tl < 4; ++tl) {
                const int tok = (grp * 4 + tl) * 16 + fr;
                const f32x4 xa = *(const GAS f32x4*)(x1 + (size_t)tok * D + k0), xb = *(const GAS f32x4*)(x1 + (size_t)tok * D + k0 + 4);
                ss[tl] += (xa.x * xa.x + xa.y * xa.y) + (xa.z * xa.z + xa.w * xa.w) + (xb.x * xb.x + xb.y * xb.y) + (xb.z * xb.z + xb.w * xb.w);
                v4u ho; ho.x = pk2(xa.x * la.x, xa.y * la.y); ho.y = pk2(xa.z * la.z, xa.w * la.w); ho.z = pk2(xb.x * lb.x, xb.y * lb.y); ho.w = pk2(xb.z * lb.z, xb.w * lb.w);
                *(GAS v4u*)(h2u + (size_t)tok * D + k0) = ho;
                bf16x8 ah, al; split8(xa, xb, ah, al);
#pragma unroll
                for (int c = 0; c < 5; ++c) { acc[tl][c] = MFMA16(ah, bh[c], acc[tl][c]); acc[tl][c] = MFMA16(al, bh[c], acc[tl][c]); acc[tl][c] = MFMA16(ah, bl[c], acc[tl][c]); }
            }
        }
#pragma unroll
        for (int tl = 0; tl < 4; ++tl) { ss[tl] += __shfl_xor(ss[tl], 16); ss[tl] += __shfl_xor(ss[tl], 32); }
#pragma unroll
        for (int rd = 0; rd < 2; ++rd) {
#pragma unroll
            for (int t2 = 0; t2 < 2; ++t2) { const int tl = 2 * rd + t2;
#pragma unroll
                for (int c = 0; c < 5; ++c)
#pragma unroll
                    for (int r = 0; r < 4; ++r) PL[(w * 32 + t2 * 16 + 4 * fq + r) * 80 + 16 * c + fr] = acc[tl][c][r];
                if (lane < 16) PS[w * 32 + t2 * 16 + lane] = ss[tl]; }
            __syncthreads();
            for (int i = F.tid; i < 32 * 80; i += NTHR) { float s = 0.f;
#pragma unroll
                for (int ww = 0; ww < 8; ++ww) s += PL[ww * 2560 + i];
                LG[i] = s; }
            if (F.tid < 32) { float s = 0.f;
#pragma unroll
                for (int ww = 0; ww < 8; ++ww) s += PS[ww * 32 + F.tid];
                RS[F.tid] = rsqrtf(s * (1.f / D) + EPS); }
            __syncthreads();
            if (F.tid < 32) {
                const LAS float* lg = LG + F.tid * 80; const float rs = RS[F.tid];
                float gl[8]; int gi = 0; float gm = -1e30f;
#pragma unroll
                for (int g = 0; g < 8; ++g) { gl[g] = lg[g] * rs + bgrp[g]; if (gl[g] > gm) { gm = gl[g]; gi = g; } }
                float gs = 0.f;
#pragma unroll
                for (int g = 0; g < 8; ++g) gs += expf(gl[g] - gm);
                const float pg = 1.f / gs;
                float el[8]; int e1 = 0; float m1 = -1e30f;
#pragma unroll
                for (int e = 0; e < 8; ++e) { el[e] = lg[8 + gi * 8 + e] * rs + bexp[gi * 8 + e]; if (el[e] > m1) { m1 = el[e]; e1 = e; } }
                int e2 = 0; float m2 = -1e30f;
#pragma unroll
                for (int e = 0; e < 8; ++e) if (e != e1 && el[e] > m2) { m2 = el[e]; e2 = e; }
                const float p2 = expf(m2 - m1), inv = 1.f / (1.f + p2);
                const int E1 = gi * 8 + e1, E2 = gi * 8 + e2, lt = 32 * rd + F.tid, tk = grp * 64 + lt;
                const int r1 = __hip_atomic_fetch_add(LC + E1, 1, __ATOMIC_RELAXED, __HIP_MEMORY_SCOPE_WORKGROUP), r2 = __hip_atomic_fetch_add(LC + E2, 1, __ATOMIC_RELAXED, __HIP_MEMORY_SCOPE_WORKGROUP);
                PK[lt * 4] = E1; PK[lt * 4 + 1] = E2; PK[lt * 4 + 2] = r1; PK[lt * 4 + 3] = r2;
                pgate[tk * 2] = pg * inv; pgate[tk * 2 + 1] = pg * p2 * inv; rstd_g[tk] = rs;
            }
            __syncthreads();
        }
        if (F.tid < 64) { const int n = LC[F.tid]; LC[F.tid] = n ? (int)atomicAdd(cnt + 64 * F.tid, (unsigned)n) : 0; }
        __syncthreads();
        if (F.tid < 64) { const int E1 = PK[F.tid * 4], E2 = PK[F.tid * 4 + 1], tk = grp * 64 + F.tid;
            list[E1 * 16384 + LC[E1] + PK[F.tid * 4 + 2]] = tk * 2; list[E2 * 16384 + LC[E2] + PK[F.tid * 4 + 3]] = tk * 2 + 1; }
        __syncthreads();
    }
}
__device__ __forceinline__ int moe_tables(Frame& F) {
    LAS int* pstart = (LAS int*)(F.lds + LT_PSTART); LAS int* ptab = (LAS int*)(F.lds + LT_PTAB);
    if (F.tid < 64) { const int c = (int)__hip_atomic_load((unsigned*)(F.ctl + CW_CNT) + 64 * F.tid, RLX_AGENT); const int np = (c + 255) >> 8; int ps = np;
#pragma unroll
        for (int o = 1; o < 64; o <<= 1) { const int t = __shfl_up(ps, o); if (F.lane >= o) ps += t; }
        const int st = ps - np; pstart[F.tid] = st; if (F.tid == 63) pstart[64] = ps;
        for (int j = 0; j < np; ++j) ptab[st + j] = F.tid | (j << 8); }
    __syncthreads();
    return pstart[64];
}
__device__ __forceinline__ void p7_gather(Frame& F, int NP) {
    const LAS int* ptab = (const LAS int*)(F.lds + LT_PTAB);
    const int gw = F.vcu * NWAVES + F.wave, NGW = F.G * NWAVES, lane = F.lane;
    const bf16* h2u = (const bf16*)(F.ws + WS_HN); bf16* xs = (bf16*)(F.ws + WS_XS); const int* list = (const int*)(F.ws + WS_LIST);
    const unsigned* cnt = (const unsigned*)(F.ctl + CW_CNT);
#pragma unroll 1
    for (int rid = gw; rid < NP * 256; rid += NGW) { const int pt = ptab[rid >> 8], e = pt & 255, local = (pt >> 8) * 256 + (rid & 255);
        if (local < (int)cnt[64 * e]) { const int tok = list[e * 16384 + local] >> 1;
            const GAS v4u* src = (const GAS v4u*)(h2u + (size_t)tok * D); GAS v4u* dst = (GAS v4u*)(xs + (size_t)rid * D);
            const v4u a = src[lane], b = src[lane + 64]; dst[lane] = a; dst[lane + 64] = b; } }
}
template <bool GATHER_>
struct MoeOrderT {
    static constexpr bool GATHER = GATHER_;
    int nunits, G, c, SH; const LAS int* ptab; const int* list; const unsigned* cnt; unsigned rowbytes;
    __device__ __forceinline__ unsigned row_off(const pg8::Unit& u, int r) const {
        const int pt = ptab[u.pm], e = pt & 255, local = (pt >> 8) * 256 + r;
        return local < (int)cnt[64 * e] ? (unsigned)(list[e * 16384 + local] >> 1) * rowbytes : 0u; }
    __device__ __forceinline__ bool next(int i, pg8::Unit& u) const { const int L = i * G + c; if (L >= nunits) return false; const int p = L >> SH; u.pm = p; u.pn = ((ptab[p] & 255) << SH) + (L & ((1 << SH) - 1)); return true; }
    __device__ __forceinline__ void a_ready(const pg8::Unit&) const {}
    __device__ __forceinline__ void done(const pg8::Unit&) const {}
};
typedef MoeOrderT<false> MoeOrder; typedef MoeOrderT<true> MoeGatherOrder;
struct EpiSwiGLU {
    static constexpr bool PERM = true, AFTER_DRAIN = false;
    bf16* hmid; const int* list; const unsigned* cnt; const float* rstd; const LAS int* ptab;
    __device__ __forceinline__ void operator()(const pg8::f32x4 (&acc)[2][2][4][2], const pg8::Unit& u, int wr, int wc, int fr, int fq) const {
        const int pt = ptab[u.pm], e = pt & 255, lbase = (pt >> 8) * 256, n_e = (int)cnt[64 * e], pnl = u.pn & 1;
#pragma unroll
        for (int ai = 0; ai < 2; ++ai)
#pragma unroll
            for (int m = 0; m < 4; ++m) { const int rl = ai * 128 + wr * 64 + m * 16 + fr;
                if (lbase + rl < n_e) { const float rs = rstd[list[e * 16384 + lbase + rl] >> 1];
                    float h[8];
#pragma unroll
                    for (int n = 0; n < 2; ++n)
#pragma unroll
                        for (int k = 0; k < 4; ++k) h[4 * n + k] = silu_f(acc[ai][0][m][n][k] * rs) * (acc[ai][1][m][n][k] * rs);
                    v4u o; o.x = pk2(h[0], h[1]); o.y = pk2(h[2], h[3]); o.z = pk2(h[4], h[5]); o.w = pk2(h[6], h[7]);
                    *(GAS v4u*)(hmid + (size_t)(u.pm * 256 + rl) * EFF + pnl * 128 + wc * 32 + 8 * fq) = o; } }
    }
};
struct EpiDown {
    static constexpr bool PERM = true, AFTER_DRAIN = false;
    bf16* y2; const int* list; const unsigned* cnt; const float* gate; const LAS int* ptab;
    __device__ __forceinline__ void operator()(const pg8::f32x4 (&acc)[2][2][4][2], const pg8::Unit& u, int wr, int wc, int fr, int fq) const {
        const int pt = ptab[u.pm], e = pt & 255, lbase = (pt >> 8) * 256, n_e = (int)cnt[64 * e], pnl = u.pn & 3;
#pragma unroll
        for (int ai = 0; ai < 2; ++ai)
#pragma unroll
            for (int m = 0; m < 4; ++m) { const int rl = ai * 128 + wr * 64 + m * 16 + fr;
                if (lbase + rl < n_e) { const int pair = list[e * 16384 + lbase + rl]; const float g = gate[pair];
#pragma unroll
                    for (int bj = 0; bj < 2; ++bj) { const pg8::f32x4 v0 = acc[ai][bj][m][0] * g, v1 = acc[ai][bj][m][1] * g;
                        v4u o; o.x = pk2(v0[0], v0[1]); o.y = pk2(v0[2], v0[3]); o.z = pk2(v1[0], v1[1]); o.w = pk2(v1[2], v1[3]);
                        *(GAS v4u*)(y2 + (size_t)pair * D + pnl * 256 + bj * 128 + wc * 32 + 8 * fq) = o; } } }
    }
};
__device__ __forceinline__ void p10_final(Frame& F, const float* lnw, float* dst) {
    const int gw = F.vcu * NWAVES + F.wave, NGW = F.G * NWAVES, lane = F.lane;
    const bf16* y2 = (const bf16*)(F.ws + WS_Y2);
    f32x4 lw[4];
#pragma unroll
    for (int j = 0; j < 4; ++j) lw[j] = ((const f32x4*)lnw)[lane + 64 * j];
#pragma unroll 1
    for (int tok = gw; tok < T; tok += NGW) {
        GAS f32x4* xr = (GAS f32x4*)(F.out + (size_t)tok * D) + lane;
        const GAS v2u* ya = (const GAS v2u*)(y2 + (size_t)(2 * tok) * D) + lane; const GAS v2u* yb = (const GAS v2u*)(y2 + (size_t)(2 * tok + 1) * D) + lane;
        f32x4 v[4]; float s = 0.f;
#pragma unroll
        for (int j = 0; j < 4; ++j) { const f32x4 x = xr[64 * j]; const v2u a = ya[64 * j], b = yb[64 * j];
            v[j].x = x.x + (bf2f((unsigned short)(a.x & 0xffffu)) + bf2f((unsigned short)(b.x & 0xffffu))); v[j].y = x.y + (bf2f((unsigned short)(a.x >> 16)) + bf2f((unsigned short)(b.x >> 16)));
            v[j].z = x.z + (bf2f((unsigned short)(a.y & 0xffffu)) + bf2f((unsigned short)(b.y & 0xffffu))); v[j].w = x.w + (bf2f((unsigned short)(a.y >> 16)) + bf2f((unsigned short)(b.y >> 16)));
            s += (v[j].x * v[j].x + v[j].y * v[j].y) + (v[j].z * v[j].z + v[j].w * v[j].w); }
        const float r = rsqrtf(wave_sum(s) * (1.f / D) + EPS);
        GAS f32x4* xo = (GAS f32x4*)(dst + (size_t)tok * D) + lane;
#pragma unroll
        for (int j = 0; j < 4; ++j) xo[64 * j] = v[j] * r * lw[j];
    }
}
struct EpiResF32 {
    static constexpr bool PERM = false, AFTER_DRAIN = false;
    const float* base; float* out; int ldc;
    __device__ __forceinline__ void operator()(const pg8::f32x4 (&acc)[2][2][4][2], const pg8::Unit& u, int wr, int wc, int fr, int fq) const {
        const int col0 = u.pn * 256 + wc * 32 + 4 * fq;
#pragma unroll
        for (int ai = 0; ai < 2; ++ai)
#pragma unroll
            for (int m = 0; m < 4; ++m) { const size_t off = (size_t)(u.pm * 256 + ai * 128 + wr * 64 + m * 16 + fr) * ldc + col0;
#pragma unroll
                for (int bj = 0; bj < 2; ++bj)
#pragma unroll
                    for (int n = 0; n < 2; ++n) { const pg8::f32x4 bs = *(const pg8::f32x4*)(base + off + bj * 128 + n * 16); *(pg8::f32x4*)(out + off + bj * 128 + n * 16) = bs + acc[ai][bj][m][n]; }
                if (m & 1) asm volatile("" ::: "memory"); }
    }
};
struct Args { const float* in[17]; float* out; unsigned char* ws; int ph_lo, ph_hi, li, pad; };
__global__ void __launch_bounds__(NTHR, 2) mk_fwd(Args args) {
    extern __shared__ __attribute__((aligned(16))) unsigned char lds[];
    Frame F;
    F.lds = (LAS unsigned char*)lds;
    F.MISC = (volatile LAS unsigned*)(F.lds + MISC_OFF);
    F.tid = threadIdx.x; F.lane = F.tid & 63; F.wave = __builtin_amdgcn_readfirstlane(F.tid >> 6);
    F.G = gridDim.x; { const int bx = blockIdx.x; F.vcu = (F.G % 8 == 0) ? (bx % 8) * (F.G / 8) + bx / 8 : bx; }
    F.ws = args.ws; F.out = args.out; F.li = args.li; F.ctl = (gu32*)(args.ws + WS_CTL);
    for (int u = F.tid; u < (LDS_BYTES - LDSCTL_OFF) / 4; u += NTHR) ((LAS unsigned*)(F.lds + LDSCTL_OFF))[u] = 0u;
    __syncthreads();
    XcdBarrier bar = xcd_barrier_post((unsigned*)(F.ctl + CW_BAR) + args.li * XCD_BAR_WORDS, F.MISC + 8);
    const int lo = args.ph_lo, hi = args.ph_hi;
#define IN(k) (lo <= (k) && (k) < hi)
#define BOTH(k) (IN(k) && IN((k) + 1))
#define GRID_BAR() xcd_barrier(bar)
#define PHASE_BEGIN() do { int t_ = threadIdx.x; asm volatile("" : "+v"(t_)); F.tid = t_; F.lane = t_ & 63; } while (0)
    if (IN(0)) { PHASE_BEGIN(); p0_prologue(F, args.in[I_X], args.in[I_LNMIX], args.in[I_WIN], args.in[I_WOUT], args.in[I_ALOG], args.in[I_DTB]); p0_rot_table(F); p0_router_weights(F, args.in[I_LNFFN], args.in[I_WG], args.in[I_WE]); if (BOTH(0)) GRID_BAR(); }
    if (IN(1)) { PHASE_BEGIN();
        pg8::Gemm g{(const bf16*)(F.ws + WS_HN), (const bf16*)(F.ws + WS_WIN), T, NPROJ, D}; pg8::StaticOrder S; S.init(T, NPROJ, F.G, (int)blockIdx.x);
        pg8::EpiBf16<0> E{(bf16*)(F.ws + WS_PROJ), NPROJ, nullptr, 0, 0, 1.f};
        pg8::gemm_phase<pg8::EpiBf16<0>, pg8::StaticOrder, true, true>(F.lds, g, S, E);
        if (BOTH(1)) GRID_BAR();
    }
    if (IN(2)) { PHASE_BEGIN();
#pragma unroll 1
        for (int grp = blockIdx.x; grp < 256; grp += F.G) p2_group(F, grp, args.in[I_CONV], (const float*)(F.ws + WS_BG));
        if (BOTH(2)) GRID_BAR();
    }
    if (IN(3) || IN(17) || IN(18)) { PHASE_BEGIN(); const int skipq = IN(17) ? 1 : IN(18) ? 3 : 0;
        const int x = blockIdx.x;
        if (x < 32) p3_scan(F, (x & 7) + 8 * (x >> 4), (x >> 3) & 1, 0);
        {
            LAS int* wq = (LAS int*)(F.lds + LT_WQ);
#pragma unroll 1
            for (;;) {
                if (F.tid == 0) *wq = (int)atomicAdd((unsigned*)(F.ctl + CW_WQ + 64 * F.li), 1u);
                __syncthreads();
                const int it = *wq;
                __syncthreads();
                if (it >= 512 + 384 + 480 + 256) break;
                if (it < 384) { if (!(skipq & 1)) p3_moe_weight_items(F, it * 64 + F.wave, NWAVES, it * 64 + 64, args.in[I_WGU], args.in[I_WD]); }
                else if (it < 384 + 512) { if (!(skipq & 2)) p3_attn_unit(F, it - 384, args.in[I_SINK]); }
                else { const int ob = it - (512 + 384); if (ob < 480) p3_out_batch(F, ob * 8, 8, F.out); else p3_out_batch(F, 3840 + (ob - 480), 1, F.out); }
            }
        }
        if (BOTH(3)) GRID_BAR();
    }
    if (IN(4)) { PHASE_BEGIN(); p4_combine(F, F.out, args.in[I_DNNORM]); if (BOTH(4)) GRID_BAR(); }
    if (IN(5)) { PHASE_BEGIN();
        pg8::Gemm g{(const bf16*)(F.ws + WS_MIX), (const bf16*)(F.ws + WS_WOUT), T, D, D}; pg8::StaticOrder S; S.init(T, D, F.G, (int)blockIdx.x);
        EpiResF32 E{args.in[I_X], F.out, D};
        pg8::gemm_phase<EpiResF32, pg8::StaticOrder, true, true>(F.lds, g, S, E);
        if (BOTH(5)) GRID_BAR();
    }
    if (IN(6) || IN(12)) { PHASE_BEGIN(); p6_route(F, args.in[I_LNFFN], args.in[I_BG], args.in[I_BE], IN(12) ? 1 : 0); if (BOTH(6)) GRID_BAR(); }
    if (IN(8)) { PHASE_BEGIN();
        const int NP = moe_tables(F);
        pg8::Gemm g{(const bf16*)(F.ws + WS_HN), (const bf16*)(F.ws + WS_WGU), NP * 256, NEXP * 512, D};
        MoeGatherOrder S{NP * 2, F.G, (int)blockIdx.x, 1, (const LAS int*)(F.lds + LT_PTAB), (const int*)(F.ws + WS_LIST), (const unsigned*)(F.ctl + CW_CNT), (unsigned)(D * 2)};
        EpiSwiGLU E{(bf16*)(F.ws + WS_HMID), (const int*)(F.ws + WS_LIST), (const unsigned*)(F.ctl + CW_CNT), (const float*)(F.ws + RW_RSTD), (const LAS int*)(F.lds + LT_PTAB)};
        pg8::gemm_phase<EpiSwiGLU, MoeGatherOrder, true, true>(F.lds, g, S, E);
        if (BOTH(8)) GRID_BAR();
    }
    if (IN(9)) { PHASE_BEGIN();
        const int NP = moe_tables(F);
        pg8::Gemm g{(const bf16*)(F.ws + WS_HMID), (const bf16*)(F.ws + WS_WD), NP * 256, NEXP * D, EFF};
        MoeOrder S{NP * 4, F.G, (int)blockIdx.x, 2, (const LAS int*)(F.lds + LT_PTAB), nullptr, nullptr, 0u};
        EpiDown E{(bf16*)(F.ws + WS_Y2), (const int*)(F.ws + WS_LIST), (const unsigned*)(F.ctl + CW_CNT), (const float*)(F.ws + RW_GATE), (const LAS int*)(F.lds + LT_PTAB)};
        pg8::gemm_phase<EpiDown, MoeOrder, true, true>(F.lds, g, S, E);
        if (BOTH(9)) GRID_BAR();
    }
#ifdef PROBE_PHASES
    if (IN(11) || IN(14) || IN(15) || IN(16)) { PHASE_BEGIN(); const int x = blockIdx.x; if (x < 32) p3_scan(F, (x & 7) + 8 * (x >> 4), (x >> 3) & 1, IN(14) ? 1 : IN(15) ? 3 : IN(16) ? 5 : 0); }
#endif
    if (IN(10) || IN(13)) { PHASE_BEGIN(); p10_final(F, args.in[I_LNF], IN(13) ? (float*)(F.ws + WS_PROJ) : F.out); }
#undef IN
#undef BOTH
}

__global__ void k_shim_proj(const bf16* __restrict__ pb, float* __restrict__ pf) {
    const size_t i = (size_t)blockIdx.x * blockDim.x + threadIdx.x; if (i >= (size_t)T * NPROJ) return;
    const int tok = (int)(i / NPROJ), c = (int)(i % NPROJ);
    pf[(size_t)tok * INW + (c < 2048 ? c : c + 16)] = bf2f(pb[i]);
}
}

extern "C" void kernel_launch(void* const* d_in, const int* in_sizes, int n_in, void* d_out, int out_size, void* d_ws, size_t ws_size, hipStream_t stream) {
    using namespace mk;
    static int grid = 0;
    if (grid == 0) {
        if (n_in != 17 || out_size != T * D || ws_size < 511 * MiB) { fprintf(stderr, "kernel_launch: unexpected sizes (n_in %d out %d ws %zu)\n", n_in, out_size, ws_size); grid = -1; return; }
        int dev = 0, cus = 0, per_cu = 0;
        if (hipGetDevice(&dev) != hipSuccess || hipDeviceGetAttribute(&cus, hipDeviceAttributeMultiprocessorCount, dev) != hipSuccess) { grid = -1; return; }
        if (hipFuncSetAttribute((const void*)mk_fwd, hipFuncAttributeMaxDynamicSharedMemorySize, LDS_BYTES) != hipSuccess) { fprintf(stderr, "kernel_launch: hipFuncSetAttribute failed\n"); grid = -1; return; }
        if (hipOccupancyMaxActiveBlocksPerMultiprocessor(&per_cu, (const void*)mk_fwd, NTHR, LDS_BYTES) != hipSuccess || per_cu < 1) { fprintf(stderr, "kernel_launch: occupancy query says %d blocks/CU\n", per_cu); grid = -1; (void)hipGetLastError(); return; }
        grid = cus;
    }
    if (grid < 0) return;
    (void)hipMemsetAsync((char*)d_ws + WS_CTL, 0, CTL_ZERO_BYTES, stream);
    Args a{};
    for (int i = 0; i < 17; ++i) a.in[i] = (const float*)d_in[i];
    a.out = (float*)d_out; a.ws = (unsigned char*)d_ws; a.pad = 0;
#ifndef LAUNCH_PLAN
#define LAUNCH_PLAN {0, 11}
#endif
    const int plan[] = LAUNCH_PLAN; const int nl = (int)(sizeof(plan) / sizeof(int)) / 2;
    for (int li = 0; li < nl; ++li) {
        a.ph_lo = plan[2 * li]; a.ph_hi = plan[2 * li + 1]; a.li = li;
        void* kargs[] = {&a};
        hipError_t e = hipLaunchCooperativeKernel((const void*)mk_fwd, dim3(grid), dim3(NTHR), kargs, LDS_BYTES, stream);
        if (e != hipSuccess) { fprintf(stderr, "cooperative launch failed: %s (grid %d)\n", hipGetErrorString(e), grid); return; }
    }
}
```

```cpp
#include <hip/hip_runtime.h>
#include <cstdint>
#include <cstdio>
namespace pg8 {
#define PG8_LAS __attribute__((address_space(3)))
typedef unsigned short bf16_t;
typedef short bf16x8 __attribute__((ext_vector_type(8)));
typedef float f32x4 __attribute__((ext_vector_type(4)));
typedef unsigned u32x4 __attribute__((ext_vector_type(4)));
constexpr int BM = 256, BK = 64, HALF = 128, HTB = HALF * BK * 2  , STAGE_BYTES = 8 * HTB, NXCD = 8, WGM = 8;

__host__ __device__ __forceinline__ int lds_byte(int r, int c) { const int st = (r >> 4) * 2 + (c >> 5), rr = r & 15, cc = c & 31, ob = rr * 64 + cc * 2; return st * 1024 + (ob ^ (((ob >> 9) & 1) << 5)); }
__host__ __device__ __forceinline__ void stage_rc(int b, int& R, int& C) { const int st = b / 1024, sb = b % 1024, swz = sb ^ (((sb >> 9) & 1) << 5); R = (st >> 1) * 16 + swz / 64; C = (st & 1) * 32 + (swz % 64) / 2; }
__host__ __device__ __forceinline__ int perm32(int rho) { const int n = rho >> 4, i = rho & 15; return 8 * (i >> 2) + 4 * n + (i & 3); }

struct Unit { int pm, pn; };
struct Gemm { const bf16_t* A; const bf16_t* Bt; int M, N, K; };

struct StaticOrder {
    static constexpr bool GATHER = false;
    int nM, nN, nwg, G, c;
    __device__ __forceinline__ unsigned row_off(const Unit&, int) const { return 0u; }
    __host__ __device__ void init(int M, int N, int G_, int c_) { nM = M / BM; nN = N / BM; nwg = nM * nN; G = G_; c = c_; }
    __host__ __device__ bool next(int i, Unit& u) const {
        const long L = (long)i * G + c; if (L >= nwg) return false;
        int wgid = (int)L; { const int q = nwg / NXCD, r = nwg % NXCD, xcd = wgid % NXCD, off = wgid / NXCD; wgid = (xcd < r ? xcd * (q + 1) : r * (q + 1) + (xcd - r) * q) + off; }
        const int nig = WGM * nN, gid = wgid / nig, fm = gid * WGM, gsz = (nM - fm) < WGM ? (nM - fm) : WGM;
        u.pm = fm + ((wgid % nig) % gsz); u.pn = (wgid % nig) / gsz; return true;
    }
    __device__ __forceinline__ void a_ready(const Unit&) const {}
    __device__ __forceinline__ void done(const Unit&) const {}
};

__device__ __forceinline__ unsigned cvt_pk_bf16(float lo, float hi) { unsigned r; asm volatile("v_cvt_pk_bf16_f32 %0, %1, %2" : "=v"(r) : "v"(lo), "v"(hi)); return r; }
typedef float f32x2 __attribute__((ext_vector_type(2)));
__device__ __forceinline__ f32x2 gelu_pk(f32x2 v) {
    const f32x2 av = __builtin_elementwise_abs(v), d = av * 0.2316418882f + 1.0f;
    f32x2 t; t.x = __builtin_amdgcn_rcpf(d.x); t.y = __builtin_amdgcn_rcpf(d.y);
    f32x2 q = t * 0.5307027145f + (-0.7265760135f); q = q * t + 0.7107068705f; q = q * t + (-0.142248368f); q = q * t + 0.127414796f; q = q * t;
    const f32x2 s = (v * v) * (-0.72134752044f);
    f32x2 e; e.x = __builtin_amdgcn_exp2f(s.x); e.y = __builtin_amdgcn_exp2f(s.y);
    const f32x2 m = v * (q * e), r = v - m;
    f32x2 o; o.x = v.x < 0.f ? m.x : r.x; o.y = v.y < 0.f ? m.y : r.y; return o;
}

template <int ACT  > struct EpiBf16 {
    static constexpr bool PERM = true, AFTER_DRAIN = false; static_assert(ACT == 0 || ACT == 1, "EpiBf16: ACT is 0 (none) or 1 (gelu_pk)");
    bf16_t* O; int ldc; const float* bias; int split_cols; size_t split_stride; float scale0;
    __device__ __forceinline__ void operator()(const f32x4 (&acc)[2][2][4][2], const Unit& u, int wr, int wc, int fr, int fq) const {
        const int row0 = u.pm * BM + wr * 64 + fr; int colt = u.pn * BM; bf16_t* base = O;
        float sc = 1.f; if (split_cols) { const int t = colt / split_cols; base += (size_t)t * split_stride; colt -= t * split_cols; if (t == 0) sc = scale0; }
        const int col0 = colt + wc * 32 + 8 * fq, bcol0 = u.pn * BM + wc * 32 + 8 * fq;
        f32x4 bv[2][2];
#pragma unroll
        for (int bj = 0; bj < 2; ++bj)
#pragma unroll
            for (int n = 0; n < 2; ++n) bv[bj][n] = bias ? *(const f32x4*)(bias + bcol0 + bj * HALF + 4 * n) : (f32x4){0.f, 0.f, 0.f, 0.f};
#pragma unroll
        for (int ai = 0; ai < 2; ++ai)
#pragma unroll
            for (int m = 0; m < 4; ++m) { bf16_t* rowp = base + (size_t)(row0 + ai * HALF + m * 16) * ldc + col0;
#pragma unroll
                for (int bj = 0; bj < 2; ++bj) { f32x4 v0 = acc[ai][bj][m][0] + bv[bj][0], v1 = acc[ai][bj][m][1] + bv[bj][1];
                    if (ACT == 1) { f32x2 a = gelu_pk((f32x2){v0[0], v0[1]}), b = gelu_pk((f32x2){v0[2], v0[3]}), c = gelu_pk((f32x2){v1[0], v1[1]}), d = gelu_pk((f32x2){v1[2], v1[3]});
                        v0 = (f32x4){a.x, a.y, b.x, b.y}; v1 = (f32x4){c.x, c.y, d.x, d.y}; }
                    v0 = v0 * sc; v1 = v1 * sc; u32x4 w; w.x = cvt_pk_bf16(v0[0], v0[1]); w.y = cvt_pk_bf16(v0[2], v0[3]); w.z = cvt_pk_bf16(v1[0], v1[1]); w.w = cvt_pk_bf16(v1[2], v1[3]);
                    *(u32x4*)(rowp + bj * HALF) = w; } }
    }
};
template <class Epi, class Sched, bool ALIGN_EPI = false, bool SP2 = false>
__device__ __forceinline__ void gemm_phase(PG8_LAS unsigned char* lds, const Gemm g, const Sched& S, const Epi& E) {
    const int tid = threadIdx.x, wid = __builtin_amdgcn_readfirstlane(tid >> 6), lane = tid & 63, wr = wid >> 2, wc = wid & 3, fr = lane & 15, fq = lane >> 4;
    const int K = g.K, nt = K / BK;
    unsigned voffA[2], voffB[2];
    constexpr bool GATHER = Sched::GATHER;
    unsigned gA[2][2], nGA[2][2]; int rowA[2], colA[2];
#pragma unroll
    for (int i = 0; i < 2; ++i) { int R, C; stage_rc(tid * 16 + i * 8192, R, C); const int Rb = Epi::PERM ? ((R & ~31) + perm32(R & 31)) : R;
        voffA[i] = (unsigned)(R * K + C) * 2u; voffB[i] = (unsigned)(Rb * K + C) * 2u; rowA[i] = R; colA[i] = C; }
    const size_t kstep = (size_t)(BK * 2);
    const size_t hstep = (size_t)HALF * K * 2;
    const size_t tstep = 2 * hstep;
    const size_t hstepA = GATHER ? 0 : hstep, tstepA = GATHER ? 0 : tstep;
    const unsigned ldsw = (unsigned)wid * 1024u;
    const int aoff = lds_byte(wr * 64 + fr, fq * 8), boff = lds_byte(wc * 32 + fr, fq * 8);
#define PG8_SA(b, h) (((b) * 2 + (h)) * HTB)
#define PG8_SB(b, h) ((4 + (b) * 2 + (h)) * HTB)
#define PG8_STAGE(bufoff, gbase, voff) do { _Pragma("unroll") for (int _i = 0; _i < 2; ++_i) \
        __builtin_amdgcn_global_load_lds((const unsigned*)((const char*)(gbase) + (voff)[_i]), (PG8_LAS unsigned*)(lds + (bufoff) + ldsw + _i * 8192), 16, 0, 0); } while (0)
#define PG8_STAGE_A(bufoff, gbase, h, nx) do { if constexpr (GATHER) { if (nx) PG8_STAGE(bufoff, gbase, nGA[h]); else PG8_STAGE(bufoff, gbase, gA[h]); } else PG8_STAGE(bufoff, gbase, voffA); } while (0)
#define PG8_GOFF(dst, unit) do { if constexpr (GATHER) { _Pragma("unroll") for (int h_ = 0; h_ < 2; ++h_) _Pragma("unroll") for (int i_ = 0; i_ < 2; ++i_) dst[h_][i_] = S.row_off(unit, h_ * HALF + rowA[i_]) + (unsigned)colA[i_] * 2u; \
        asm volatile("s_waitcnt vmcnt(0)" : "+v"(dst[0][0]), "+v"(dst[0][1]), "+v"(dst[1][0]), "+v"(dst[1][1]) :: "memory"); } } while (0)
#define PG8_LDA(dst, b, h) do { _Pragma("unroll") for (int m = 0; m < 4; ++m) _Pragma("unroll") for (int k = 0; k < 2; ++k) dst[m][k] = *(const PG8_LAS bf16x8*)(lds + PG8_SA(b, h) + aoff + m * 2048 + k * 1024); } while (0)
#define PG8_LDB(dst, b, h) do { _Pragma("unroll") for (int n = 0; n < 2; ++n) _Pragma("unroll") for (int k = 0; k < 2; ++k) dst[n][k] = *(const PG8_LAS bf16x8*)(lds + PG8_SB(b, h) + boff + n * 2048 + k * 1024); } while (0)
#define PG8_MMA(ai, bj, At, Bt) do { __builtin_amdgcn_s_setprio(1); _Pragma("unroll") for (int m = 0; m < 4; ++m) _Pragma("unroll") for (int n = 0; n < 2; ++n) _Pragma("unroll") for (int k = 0; k < 2; ++k) \
        acc[ai][bj][m][n] = __builtin_amdgcn_mfma_f32_16x16x32_bf16(Bt[n][k], At[m][k], acc[ai][bj][m][n], 0, 0, 0); __builtin_amdgcn_s_setprio(0); } while (0)
#define PG8_WAIT_V(n) asm volatile("s_waitcnt vmcnt(" #n ")" ::: "memory")
#define PG8_WAIT_L(n) asm volatile("s_waitcnt lgkmcnt(" #n ")" ::: "memory")
#define PG8_BAR __builtin_amdgcn_s_barrier()
#define PG8_SCHED __builtin_amdgcn_sched_barrier(0)
    Unit cur, nxt; int ui = 0;
    if (!S.next(0, cur)) return;
    f32x4 acc[2][2][4][2];
#pragma unroll
    for (int a = 0; a < 2; ++a)
#pragma unroll
        for (int b = 0; b < 2; ++b)
#pragma unroll
            for (int m = 0; m < 4; ++m)
#pragma unroll
                for (int n = 0; n < 2; ++n) acc[a][b][m][n] = (f32x4){0.f, 0.f, 0.f, 0.f};
    bf16x8 At[4][2], B0[2][2], B1[2][2];
    const char* cA = (const char*)g.A + (size_t)cur.pm * tstepA; const char* cB = (const char*)g.Bt + (size_t)cur.pn * tstep;
    PG8_GOFF(gA, cur);
    S.a_ready(cur);
    if constexpr (SP2) {
        PG8_STAGE(PG8_SB(0, 0), cB, voffB); PG8_STAGE(PG8_SB(0, 1), cB + hstep, voffB); PG8_STAGE_A(PG8_SA(0, 0), cA, 0, false); PG8_STAGE_A(PG8_SA(0, 1), cA + hstepA, 1, false);
        if (wr == 1) PG8_BAR;
        PG8_WAIT_V(2); PG8_BAR;
        PG8_STAGE(PG8_SB(1, 0), cB + kstep, voffB); PG8_STAGE_A(PG8_SA(1, 0), cA + kstep, 0, false); PG8_STAGE(PG8_SB(1, 1), cB + hstep + kstep, voffB);
        PG8_WAIT_V(6); PG8_BAR;
    } else {
        PG8_STAGE(PG8_SB(0, 0), cB, voffB); PG8_STAGE_A(PG8_SA(0, 0), cA, 0, false); PG8_STAGE(PG8_SB(0, 1), cB + hstep, voffB); PG8_STAGE_A(PG8_SA(0, 1), cA + hstepA, 1, false);
        if (wr == 1) PG8_BAR;
        PG8_WAIT_V(4); PG8_BAR;
        PG8_STAGE(PG8_SB(1, 0), cB + kstep, voffB); PG8_STAGE_A(PG8_SA(1, 0), cA + kstep, 0, false); PG8_STAGE(PG8_SB(1, 1), cB + hstep + kstep, voffB);
        PG8_WAIT_V(6); PG8_BAR;
    }
    for (;;) {
        const bool has_next = S.next(ui + 1, nxt);
        if constexpr (GATHER) { if (has_next) PG8_GOFF(nGA, nxt); else { _Pragma("unroll") for (int h_ = 0; h_ < 2; ++h_) _Pragma("unroll") for (int i_ = 0; i_ < 2; ++i_) nGA[h_][i_] = gA[h_][i_]; } }
        const char* nA = has_next ? (const char*)g.A + (size_t)nxt.pm * tstepA : cA; const char* nB = has_next ? (const char*)g.Bt + (size_t)nxt.pn * tstep : cB;
        for (int t = 0; t < nt; t += 2) {
            const bool last = (t == nt - 2);
            const char* a1 = cA + (size_t)(t + 1) * kstep;
            const char* a2 = last ? nA : cA + (size_t)(t + 2) * kstep; const char* b2 = last ? nB : cB + (size_t)(t + 2) * kstep;
            const char* a3 = a2 + kstep; const char* b3 = b2 + kstep;
            if (last && has_next) S.a_ready(nxt);
            if constexpr (SP2) {
            PG8_LDB(B0, 0, 0); PG8_LDB(B1, 0, 1); PG8_SCHED; PG8_LDA(At, 0, 0); PG8_STAGE_A(PG8_SA(1, 1), a1 + hstepA, 1, false);
            PG8_WAIT_V(8); PG8_WAIT_L(0); PG8_BAR; PG8_MMA(0, 0, At, B0); PG8_MMA(0, 1, At, B1); PG8_BAR; PG8_SCHED;
            PG8_LDA(At, 0, 1); PG8_STAGE(PG8_SB(0, 0), b2, voffB); PG8_STAGE(PG8_SB(0, 1), b2 + hstep, voffB); PG8_STAGE_A(PG8_SA(0, 0), a2, 0, last);
            PG8_WAIT_V(8); PG8_WAIT_L(0); PG8_BAR; PG8_MMA(1, 0, At, B0); PG8_MMA(1, 1, At, B1); PG8_BAR; PG8_SCHED;
            PG8_LDB(B0, 1, 0); PG8_LDB(B1, 1, 1); PG8_SCHED; PG8_LDA(At, 1, 0); PG8_STAGE_A(PG8_SA(0, 1), a2 + hstepA, 1, last);
            PG8_WAIT_V(8); PG8_WAIT_L(0); PG8_BAR; PG8_MMA(0, 0, At, B0); PG8_MMA(0, 1, At, B1); PG8_BAR; PG8_SCHED;
            PG8_LDA(At, 1, 1); PG8_STAGE(PG8_SB(1, 0), b3, voffB); PG8_STAGE(PG8_SB(1, 1), b3 + hstep, voffB); PG8_STAGE_A(PG8_SA(1, 0), a3, 0, last);
            PG8_WAIT_V(8); PG8_WAIT_L(0); PG8_BAR; PG8_MMA(1, 0, At, B0); PG8_MMA(1, 1, At, B1); PG8_BAR; PG8_SCHED;
            } else {
            PG8_LDB(B0, 0, 0); PG8_SCHED; PG8_LDA(At, 0, 0); PG8_STAGE_A(PG8_SA(1, 1), a1 + hstepA, 1, false);
            PG8_WAIT_L(8); PG8_BAR; PG8_WAIT_L(0); PG8_MMA(0, 0, At, B0); PG8_BAR; PG8_SCHED;
            PG8_LDB(B1, 0, 1); PG8_STAGE(PG8_SB(0, 0), b2, voffB);
            PG8_BAR; PG8_WAIT_L(0); PG8_MMA(0, 1, At, B1); PG8_BAR;
            PG8_LDA(At, 0, 1); PG8_STAGE_A(PG8_SA(0, 0), a2, 0, last);
            PG8_BAR; PG8_WAIT_L(0); PG8_MMA(1, 0, At, B0); PG8_BAR; PG8_SCHED;
            PG8_STAGE(PG8_SB(0, 1), b2 + hstep, voffB);
            PG8_WAIT_V(6); PG8_BAR; PG8_MMA(1, 1, At, B1); PG8_BAR;
            PG8_LDB(B0, 1, 0); PG8_SCHED; PG8_LDA(At, 1, 0); PG8_STAGE_A(PG8_SA(0, 1), a2 + hstepA, 1, last);
            PG8_WAIT_L(8); PG8_BAR; PG8_WAIT_L(0); PG8_MMA(0, 0, At, B0); PG8_BAR; PG8_SCHED;
            PG8_LDB(B1, 1, 1); PG8_STAGE(PG8_SB(1, 0), b3, voffB);
            PG8_BAR; PG8_WAIT_L(0); PG8_MMA(0, 1, At, B1); PG8_BAR;
            PG8_LDA(At, 1, 1); PG8_STAGE_A(PG8_SA(1, 0), a3, 0, last);
            PG8_BAR; PG8_WAIT_L(0); PG8_MMA(1, 0, At, B0); PG8_BAR; PG8_SCHED;
            PG8_STAGE(PG8_SB(1, 1), b3 + hstep, voffB);
            PG8_WAIT_V(6); PG8_BAR; PG8_MMA(1, 1, At, B1); PG8_BAR;
            }
        }
        if constexpr (ALIGN_EPI) { if (wr == 0) PG8_BAR; }
        if constexpr (!Epi::AFTER_DRAIN) { E(acc, cur, wr, wc, fr, fq); S.done(cur); }
        if (!has_next) break;
#pragma unroll
        for (int a = 0; a < 2; ++a)
#pragma unroll
            for (int b = 0; b < 2; ++b)
#pragma unroll
                for (int m = 0; m < 4; ++m)
#pragma unroll
                    for (int n = 0; n < 2; ++n) acc[a][b][m][n] = (f32x4){0.f, 0.f, 0.f, 0.f};
        cur = nxt; cA = nA; cB = nB; ++ui;
        if constexpr (GATHER) { _Pragma("unroll") for (int h_ = 0; h_ < 2; ++h_) _Pragma("unroll") for (int i_ = 0; i_ < 2; ++i_) gA[h_][i_] = nGA[h_][i_]; }
        if constexpr (ALIGN_EPI) { if (wr == 1) PG8_BAR; }
    }
    PG8_WAIT_V(0);
    if constexpr (!ALIGN_EPI) { if (wr == 0) PG8_BAR; }
    PG8_BAR;
    if constexpr (Epi::AFTER_DRAIN) { E.fused(acc, cur, wr, wc, fr, fq, lds, wid, lane); S.done(cur); }
#undef PG8_SA
#undef PG8_SB
#undef PG8_STAGE
#undef PG8_STAGE_A
#undef PG8_GOFF
#undef PG8_LDA
#undef PG8_LDB
#undef PG8_MMA
#undef PG8_WAIT_V
#undef PG8_WAIT_L
#undef PG8_BAR
#undef PG8_SCHED
}
}
namespace mk {
constexpr int D = 1024, BATCH = 2, SEQ = 8192, T = BATCH * SEQ;
constexpr int INW = 2832, NPROJ = 2816;
constexpr int PJ_Q = 0, PJ_K = 512, PJ_V = 1024, PJ_Z = 1536, PJ_AQ = 2048, PJ_AK = 2560, PJ_AV = 2688;
constexpr int NEXP = 64, EFF = 256;
constexpr float EPS = 1e-6f;
constexpr int NWAVES = 8, NTHR = 512;
constexpr size_t MiB = 1u << 20;
constexpr size_t WS_CTL = 0, CTL_ZERO_BYTES = 1 * MiB;
constexpr size_t WS_WIN = 1 * MiB, WS_WOUT = 7 * MiB, WS_WGU = 9 * MiB, WS_WD = 73 * MiB;
constexpr size_t WS_HN = 105 * MiB, WS_BG = 137 * MiB, WS_MISC = 138 * MiB, WS_PROJ = 144 * MiB;
constexpr size_t WS_DN = 232 * MiB, WS_MIX = 456 * MiB, WS_END = 488 * MiB;
constexpr int CW_BAR = 4096;
constexpr int LDS_BYTES = 163840, RING_BYTES = 159744, LDSCTL_OFF = RING_BYTES, MISC_OFF = LDSCTL_OFF + 320;

#define GAS __attribute__((address_space(1)))
#define LAS __attribute__((address_space(3)))
typedef unsigned short bf16;
typedef unsigned v4u __attribute__((ext_vector_type(4)));
typedef float f32x4 __attribute__((ext_vector_type(4)));
typedef GAS unsigned gu32;
#define RLX_AGENT __ATOMIC_RELAXED, __HIP_MEMORY_SCOPE_AGENT
#define LDS_WAIT() asm volatile("s_waitcnt lgkmcnt(0)" ::: "memory")
#define VM_WAIT() asm volatile("s_waitcnt vmcnt(0)" ::: "memory")
__device__ __forceinline__ unsigned f2bf(float f) { unsigned u = __builtin_bit_cast(unsigned, f); return (u + 0x7fffu + ((u >> 16) & 1u)) >> 16; }
typedef float f32x2_t __attribute__((ext_vector_type(2))); typedef __bf16 bf16x2_t __attribute__((ext_vector_type(2)));
__device__ __forceinline__ unsigned pk2(float lo, float hi) { f32x2_t v = {lo, hi}; bf16x2_t b = __builtin_convertvector(v, bf16x2_t); return __builtin_bit_cast(unsigned, b); }
__device__ __forceinline__ float bf2f(unsigned short b) { return __builtin_bit_cast(float, (unsigned)b << 16); }
__device__ __forceinline__ float wave_sum(float v) {
#pragma unroll
    for (int o = 1; o < 64; o <<= 1) v += __shfl_xor(v, o);
    return v;
}
__device__ __forceinline__ float reduce16(float (&v)[16], int lane) {
    { const bool h = (lane & 32) != 0;
#pragma unroll
      for (int i = 0; i < 8; ++i) { const float keep = h ? v[i + 8] : v[i], send = h ? v[i] : v[i + 8]; v[i] = keep + __shfl_xor(send, 32); } }
    { const bool h = (lane & 16) != 0;
#pragma unroll
      for (int i = 0; i < 4; ++i) { const float keep = h ? v[i + 4] : v[i], send = h ? v[i] : v[i + 4]; v[i] = keep + __shfl_xor(send, 16); } }
    { const bool h = (lane & 8) != 0;
#pragma unroll
      for (int i = 0; i < 2; ++i) { const float keep = h ? v[i + 2] : v[i], send = h ? v[i] : v[i + 2]; v[i] = keep + __shfl_xor(send, 8); } }
    { const bool h = (lane & 4) != 0; const float keep = h ? v[1] : v[0], send = h ? v[0] : v[1]; v[0] = keep + __shfl_xor(send, 4); }
    v[0] += __shfl_xor(v[0], 2); v[0] += __shfl_xor(v[0], 1);
    return v[0];
}
__device__ __forceinline__ float silu_f(float x) { return x / (1.f + __expf(-x)); }
__device__ __forceinline__ float softplus_f(float x) { return fmaxf(x, 0.f) + log1pf(expf(-fabsf(x))); }

#define XB_TMO      128
#define XB_XCNT(j)  (256  + 64 * (j))
#define XB_XSUB(j)  (1280 + 64 * (j))
#define XB_XGEN(j)  (2304 + 64 * (j))
#define XB_TOP      3328
#define XB_TOPGEN   3392
#define XCD_BAR_WORDS 3456
#define XB_SPIN_CAP (1u << 22)
__device__ __forceinline__ unsigned xb_ld(unsigned* p)              { return __hip_atomic_load(p, __ATOMIC_RELAXED, __HIP_MEMORY_SCOPE_AGENT); }
__device__ __forceinline__ unsigned xb_add(unsigned* p, unsigned v) { return __hip_atomic_fetch_add(p, v, __ATOMIC_RELAXED, __HIP_MEMORY_SCOPE_AGENT); }
__device__ __forceinline__ unsigned xb_xcc_id() { return (unsigned)__builtin_amdgcn_s_getreg((3 << 11) | 20) & 0xFu; }
#define XB_SPIN(cond, bar) do { unsigned _sp = 0; while (cond) { __builtin_amdgcn_s_sleep(1); \
    if ((++_sp & 255u) == 0u) { if (xb_ld(&(bar)[XB_TMO])) break; if (_sp > XB_SPIN_CAP) { atomicAdd(&(bar)[XB_TMO], 1u); break; } } } } while (0)
struct XcdBarrier { unsigned* bar; unsigned x; volatile LAS unsigned* st; };
__device__ __forceinline__ XcdBarrier xcd_barrier_post(unsigned* bar, volatile LAS unsigned* st) {
    XcdBarrier b; b.bar = bar; b.x = xb_xcc_id(); b.st = st;
    if (threadIdx.x == 0) (void)xb_add(&bar[XB_XCNT(b.x)], 1u);
    return b;
}
__device__ __forceinline__ void xcd_barrier_complete(unsigned* bar, unsigned x, unsigned& nloc, unsigned& nx) {
    const unsigned G = gridDim.x * gridDim.y * gridDim.z;
    unsigned sum, cnt, mine, sp = 0u;
    for (;;) {
        sum = 0u; cnt = 0u; mine = 0u;
#pragma unroll
        for (unsigned j = 0; j < 16; ++j) { const unsigned c = xb_ld(&bar[XB_XCNT(j)]); sum += c; cnt += (c > 0u) ? 1u : 0u; mine = (j == x) ? c : mine; }
        if (sum == G) break;
        __builtin_amdgcn_s_sleep(1);
        if ((++sp & 255u) == 0u) { if (xb_ld(&bar[XB_TMO])) break; if (sp > XB_SPIN_CAP) { atomicAdd(&bar[XB_TMO], 1u); break; } }
    }
    nloc = mine > 0u ? mine : 1u; nx = cnt > 0u ? cnt : 1u;
}
__device__ __forceinline__ void xcd_barrier(const XcdBarrier& b) {
    asm volatile("s_waitcnt vmcnt(0)" ::: "memory");
    __syncthreads();
    if (threadIdx.x == 0) {
        unsigned* bar = b.bar;
        __builtin_amdgcn_s_waitcnt(0);
        unsigned nloc = b.st[0], nx = b.st[1];
        if (nloc == 0u) { xcd_barrier_complete(bar, b.x, nloc, nx); b.st[0] = nloc; b.st[1] = nx; }
        const unsigned old = xb_add(&bar[XB_XSUB(b.x)], 1u);
        const unsigned gen = old / nloc;
        if (old + 1u == (gen + 1u) * nloc) {
            __builtin_amdgcn_fence(__ATOMIC_RELEASE, "agent");
            asm volatile("s_waitcnt vmcnt(0)" ::: "memory");
            const unsigned og = xb_add(&bar[XB_TOP], 1u);
            const unsigned tg = og / nx;
            if (og + 1u == (tg + 1u) * nx) xb_add(&bar[XB_TOPGEN], 1u);
            else XB_SPIN(xb_ld(&bar[XB_TOPGEN]) == tg, bar);
            __builtin_amdgcn_fence(__ATOMIC_ACQUIRE, "agent");
            xb_add(&bar[XB_XGEN(b.x)], 1u);
            asm volatile("s_waitcnt vmcnt(0)" ::: "memory");
        } else {
            XB_SPIN(xb_ld(&bar[XB_XGEN(b.x)]) == gen, bar);
            __builtin_amdgcn_fence(__ATOMIC_ACQUIRE, "agent");
            asm volatile("s_waitcnt vmcnt(0)" ::: "memory");
        }
    }
    __syncthreads();
}

struct Frame {
    LAS unsigned char* lds;
    volatile LAS unsigned* MISC;
    gu32* ctl;
    int tid, lane, wave;
    int vcu, G, li;
    float* out; unsigned char* ws;
};
enum { I_X = 0, I_LNMIX, I_WIN, I_CONV, I_ALOG, I_DTB, I_DNNORM, I_SINK, I_WOUT, I_LNFFN, I_WG, I_BG, I_WE, I_BE, I_WGU, I_WD, I_LNF };

__device__ __forceinline__ void transpose_item(const float* W, int ldn, int src_col0, int k0, bf16* WT, int ldk, int dst_row0, LAS float* scr, int lane) {
#pragma unroll 8
    for (int i = 0; i < 32; ++i) { const int kk = 2 * i + (lane >> 5); scr[kk * 33 + (lane & 31)] = __builtin_nontemporal_load(W + (size_t)(k0 + kk) * ldn + src_col0 + (lane & 31)); }
    LDS_WAIT(); asm volatile("" ::: "memory");
    const int c = lane & 7;
#pragma unroll
    for (int j = 0; j < 4; ++j) { const int n = (lane >> 3) + 8 * j; const LAS float* s = scr + (8 * c) * 33 + n;
        v4u o; o.x = pk2(s[0 * 33], s[1 * 33]); o.y = pk2(s[2 * 33], s[3 * 33]); o.z = pk2(s[4 * 33], s[5 * 33]); o.w = pk2(s[6 * 33], s[7 * 33]);
        __builtin_nontemporal_store(o, (v4u*)(WT + (size_t)(dst_row0 + n) * ldk + k0 + 8 * c)); }
    LDS_WAIT(); asm volatile("" ::: "memory");
}
__device__ __forceinline__ void p0_prologue(Frame& F, const float* x_in, const float* lnw, const float* w_in, const float* w_out, const float* a_log, const float* dt_b) {
    LAS float* scr = (LAS float*)(F.lds + F.wave * 16384);
    const int gw = F.vcu * NWAVES + F.wave, NGW = F.G * NWAVES;
    bf16* Win_t = (bf16*)(F.ws + WS_WIN); bf16* Wout_t = (bf16*)(F.ws + WS_WOUT);
    constexpr int I_IN = 16 * 88, I_OUT = 16 * 32, NITEMS = I_IN + I_OUT;
    for (int it = gw; it < NITEMS; it += NGW) {
        int r = it;
        if (r < I_IN) { const int kb = r / 88, nb = r % 88, n0 = 32 * nb; transpose_item(w_in, INW, n0 + (n0 >= 2048 ? 16 : 0), 64 * kb, Win_t, D, n0, scr, F.lane); continue; } r -= I_IN;
        { const int kb = r / 32, nb = r % 32; transpose_item(w_out, D, 32 * nb, 64 * kb, Wout_t, D, 32 * nb, scr, F.lane); }
    }
    __syncthreads();
    LAS float* w16T = (LAS float*)F.lds;
    for (int i = F.tid; i < D * 4; i += NTHR) { const int k = i >> 2, c4 = (i & 3) * 4; const f32x4 w = *(const f32x4*)(w_in + (size_t)k * INW + 2048 + c4);
        w16T[(c4 + 0) * D + k] = w.x; w16T[(c4 + 1) * D + k] = w.y; w16T[(c4 + 2) * D + k] = w.z; w16T[(c4 + 3) * D + k] = w.w; }
    __syncthreads();
    bf16* hn = (bf16*)(F.ws + WS_HN); float* bg = (float*)(F.ws + WS_BG);
    f32x4 lw[4];
#pragma unroll
    for (int j = 0; j < 4; ++j) lw[j] = ((const f32x4*)lnw)[F.lane + 64 * j];
    for (int m = gw; m < T; m += NGW) {
        const GAS f32x4* xr = (const GAS f32x4*)(x_in + (size_t)m * D) + F.lane;
        f32x4 v[4]; float s = 0.f;
#pragma unroll
        for (int j = 0; j < 4; ++j) { v[j] = xr[64 * j]; s += (v[j].x * v[j].x + v[j].y * v[j].y) + (v[j].z * v[j].z + v[j].w * v[j].w); }
        const float rstd = rsqrtf(wave_sum(s) * (1.f / D) + EPS);
#pragma unroll
        for (int j = 0; j < 4; ++j) v[j] = v[j] * rstd * lw[j];
        GAS unsigned long long* o8 = (GAS unsigned long long*)(hn + (size_t)m * D) + F.lane;
#pragma unroll
        for (int j = 0; j < 4; ++j) o8[64 * j] = (unsigned long long)pk2(v[j].x, v[j].y) | ((unsigned long long)pk2(v[j].z, v[j].w) << 32);
        float acc[16];
#pragma unroll
        for (int c = 0; c < 16; ++c) { float a = 0.f;
#pragma unroll
            for (int j = 0; j < 4; ++j) { const f32x4 w = *(const LAS f32x4*)(w16T + c * D + 4 * F.lane + 256 * j); a += (v[j].x * w.x + v[j].y * w.y) + (v[j].z * w.z + v[j].w * w.w); }
            acc[c] = a; if ((c & 3) == 3) asm volatile("" ::: "memory"); }
        const float tot = reduce16(acc, F.lane);
        if ((F.lane & 3) == 0) { const int idx = ((F.lane >> 5) & 1) * 8 + ((F.lane >> 4) & 1) * 4 + ((F.lane >> 3) & 1) * 2 + ((F.lane >> 2) & 1);
            if (idx < 8) bg[(size_t)m * 16 + idx] = 1.f / (1.f + expf(-tot));
            else bg[(size_t)m * 16 + idx] = -expf(a_log[idx - 8]) * softplus_f(tot + dt_b[idx - 8]); }
    }
}

typedef short bf16x8 __attribute__((ext_vector_type(8)));
typedef short bf16x4 __attribute__((ext_vector_type(4)));
typedef unsigned v2u __attribute__((ext_vector_type(2)));
constexpr size_t DN_QS = WS_DN, DN_KT = WS_DN + 32 * MiB, DN_U = WS_DN + 64 * MiB, DN_W = WS_DN + 128 * MiB, DN_AT = WS_DN + 192 * MiB;
constexpr size_t DN_GV = WS_MISC;
constexpr size_t SC_KKQK = WS_WGU, SC_VT = WS_WD;
#define MFMA16(a, b, c) __builtin_amdgcn_mfma_f32_16x16x32_bf16((a), (b), (c), 0, 0, 0)
#define RAW_BAR() do { asm volatile("s_waitcnt lgkmcnt(0)" ::: "memory"); __builtin_amdgcn_s_barrier(); asm volatile("" ::: "memory"); } while (0)

__device__ __forceinline__ void glds16(const void* gsrc, LAS unsigned char* ldst) {
    __builtin_amdgcn_global_load_lds((const unsigned*)gsrc, (LAS unsigned*)ldst, 16, 0, 0);
}
__device__ __forceinline__ void p2_group(Frame& F, int grp, const float* convw, const float* bgp, int stmask = 3) {
    const int tid = F.tid, lane = F.lane, w = F.wave;
    const bf16* proj = (const bf16*)(F.ws + WS_PROJ);
    LAS bf16* QL = (LAS bf16*)(F.lds + 52224);
    LAS bf16* KL = (LAS bf16*)(F.lds + 52224 + 17408);
    LAS float* CWL = (LAS float*)(F.lds + 139264);
    auto xin_issue = [&](int ui, LAS unsigned char* XB) {
        const int un = grp * 4 + ui, n = un & 127, bh = un >> 7, h = bh & 3, b = bh >> 2;
#pragma unroll 1
        for (int k = 0; k < 7; ++k) { const int pc = k * 8 + w;
            if (pc < 51) { const int c = pc * 64 + lane, rr = c / 48, rem = c - rr * 48, p = rem >> 4, c16 = rem & 15, s = 64 * n - 2 + rr;
                if (s >= 0 && s < SEQ) glds16(proj + (size_t)(b * SEQ + s) * NPROJ + p * 512 + h * 128 + c16 * 8, XB + pc * 1024);
                else *(LAS v4u*)(XB + c * 16) = (v4u){0u, 0u, 0u, 0u}; } }
    };
    if (stmask & 1) {
        xin_issue(0, F.lds);
        if (tid < 480) { const int pj = tid >> 5, c4 = tid & 31, p = pj / 5, j = pj - p * 5, h = ((grp * 4) >> 7) & 3;
            *(LAS f32x4*)(CWL + pj * 128 + 4 * c4) = *(const f32x4*)(convw + j * 1536 + p * 512 + h * 128 + 4 * c4); }
    }
#pragma unroll 1
    for (int ui = 0; ui < ((stmask & 1) ? 4 : 0); ++ui) {
        const int un = grp * 4 + ui, n = un & 127, bh = un >> 7, h = bh & 3, b = bh >> 2;
        LAS bf16* XIN = (LAS bf16*)(F.lds + (ui & 1) * 87040);
        asm volatile("s_waitcnt vmcnt(0) lgkmcnt(0)" ::: "memory"); __syncthreads();
        if (ui + 1 < 4) xin_issue(ui + 1, F.lds + ((ui + 1) & 1) * 87040);
        {
            float val[3][8][2];
#pragma unroll
            for (int p = 0; p < 3; ++p) {
                float cw[5][2];
#pragma unroll
                for (int j = 0; j < 5; ++j) { const LAS float* cp = CWL + (p * 5 + j) * 128 + 2 * lane; cw[j][0] = cp[0]; cw[j][1] = cp[1]; }
                float xr[12][2];
#pragma unroll
                for (int r = 0; r < 12; ++r) { const unsigned u2 = *(const LAS unsigned*)(XIN + (8 * w + r) * 384 + p * 128 + 2 * lane); xr[r][0] = bf2f((unsigned short)(u2 & 0xffffu)); xr[r][1] = bf2f((unsigned short)(u2 >> 16)); }
#pragma unroll
                for (int i = 0; i < 8; ++i) { float a0 = 0.f, a1 = 0.f;
#pragma unroll
                    for (int j = 0; j < 5; ++j) { a0 = fmaf(xr[i + j][0], cw[j][0], a0); a1 = fmaf(xr[i + j][1], cw[j][1], a1); }
                    val[p][i][0] = silu_f(a0); val[p][i][1] = silu_f(a1); }
            }
#pragma unroll
            for (int i = 0; i < 8; ++i) {
                const float sq = wave_sum(val[0][i][0] * val[0][i][0] + val[0][i][1] * val[0][i][1]);
                const float sk = wave_sum(val[1][i][0] * val[1][i][0] + val[1][i][1] * val[1][i][1]);
                const float rq = rsqrtf(sq + EPS) * 0.08838834764831845f, rk = rsqrtf(sk + EPS);
                val[0][i][0] *= rq; val[0][i][1] *= rq; val[1][i][0] *= rk; val[1][i][1] *= rk;
                const unsigned qp = pk2(val[0][i][0], val[0][i][1]), kp = pk2(val[1][i][0], val[1][i][1]);
                *(LAS unsigned*)(QL + (8 * w + i) * 136 + 2 * lane) = qp; *(LAS unsigned*)(KL + (8 * w + i) * 136 + 2 * lane) = kp;
                *(GAS unsigned*)((bf16*)(F.ws + DN_QS) + ((size_t)un * 64 + 8 * w + i) * 128 + 2 * lane) = qp;
            }
#pragma unroll
            for (int c = 0; c < 2; ++c) {
                v4u kt, vt;
                kt.x = pk2(val[1][0][c], val[1][1][c]); kt.y = pk2(val[1][2][c], val[1][3][c]); kt.z = pk2(val[1][4][c], val[1][5][c]); kt.w = pk2(val[1][6][c], val[1][7][c]);
                vt.x = pk2(val[2][0][c], val[2][1][c]); vt.y = pk2(val[2][2][c], val[2][3][c]); vt.z = pk2(val[2][4][c], val[2][5][c]); vt.w = pk2(val[2][6][c], val[2][7][c]);
                { bf16* kp = (bf16*)(F.ws + DN_KT) + ((size_t)un * 128 + 2 * lane + c) * 64 + 32 * (w >> 2) + 16 * (w & 1) + 4 * ((w & 3) >> 1);
                  *(GAS v2u*)kp = (v2u){kt.x, kt.y}; *(GAS v2u*)(kp + 8) = (v2u){kt.z, kt.w}; }
                *(GAS v4u*)((bf16*)(F.ws + SC_VT) + ((size_t)un * 128 + 2 * lane + c) * 64 + 8 * w) = vt;
            }
        }
        __syncthreads();
        {
            const int type = w >> 2, tr = w & 3, fr = lane & 15, fq = lane >> 4;
            const LAS bf16* Asrc = type ? QL : KL;
            bf16x8 af[4];
#pragma unroll
            for (int ks = 0; ks < 4; ++ks) af[ks] = *(const LAS bf16x8*)(Asrc + (16 * tr + fr) * 136 + 32 * ks + 8 * fq);
            float* G = (float*)(F.ws + SC_KKQK) + ((size_t)un * 2 + type) * 4096;
#pragma unroll
            for (int tc = 0; tc < 4; ++tc) { f32x4 acc = (f32x4){0.f, 0.f, 0.f, 0.f};
#pragma unroll
                for (int ks = 0; ks < 4; ++ks) { const bf16x8 bfr = *(const LAS bf16x8*)(KL + (16 * tc + fr) * 136 + 32 * ks + 8 * fq); acc = MFMA16(af[ks], bfr, acc); }
#pragma unroll
                for (int r = 0; r < 4; ++r) G[(16 * tr + 4 * fq + r) * 64 + 16 * tc + fr] = acc[r]; }
        }
    }
    VM_WAIT(); __syncthreads();
    if (tid == 0) { __builtin_amdgcn_fence(__ATOMIC_ACQUIRE, "agent"); VM_WAIT(); }
    __syncthreads();
    if (stmask & 2) {
        int lane = F.lane; asm volatile("" : "+v"(lane));
        const int un = grp * 4 + (w >> 1), dir = w & 1, n = un & 127, bh = un >> 7, h = bh & 3, b = bh >> 2, item = un * 2 + dir;
        const int rl = dir ? 63 - lane : lane;
        const size_t tok = (size_t)b * SEQ + 64 * n + rl;
        const float beta = bgp[tok * 16 + dir * 4 + h], g = bgp[tok * 16 + 8 + dir * 4 + h];
        float gc = g;
#pragma unroll
        for (int o = 1; o < 64; o <<= 1) { const float t = __shfl_up(gc, o); if (lane >= o) gc += t; }
        const float gcl = __shfl(gc, 63), egc = __expf(gc), ekd = __expf(gcl - gc);
        float* gv = (float*)(F.ws + DN_GV) + (size_t)item * 128; gv[lane] = egc; gv[64 + lane] = ekd;
        const float* KKp = (const float*)(F.ws + SC_KKQK) + (size_t)un * 8192; const float* QKp = KKp + 4096;
        bf16* ATp = (bf16*)(F.ws + DN_AT) + (size_t)item * 4096;
        float Tr[64];
        float kkc[8], qkc[8];
        const char* KKb = (const char*)KKp; char* ATb = (char*)ATp;
        const int kstep = dir ? -256 : 256;
        const unsigned kk0 = (unsigned)(((dir ? 63 : 0) * 64 + rl) * 4);
        {   unsigned o2 = kk0; asm volatile("" : "+v"(o2));
#pragma unroll
            for (int r = 0; r < 8; ++r) { kkc[r] = *(const float*)(KKb + (o2 + (unsigned)(r * kstep))); qkc[r] = *(const float*)(KKb + (o2 + (unsigned)(r * kstep) + 16384u)); } }
#pragma unroll
        for (int blk = 0; blk < 8; ++blk) {
            float kkn[8], qkn[8];
            {   unsigned o2 = kk0 + (unsigned)((blk < 7 ? 8 * (blk + 1) : 0) * kstep); asm volatile("" : "+v"(o2));
#pragma unroll
                for (int r = 0; r < 8; ++r) { kkn[r] = *(const float*)(KKb + (o2 + (unsigned)(r * kstep))); qkn[r] = *(const float*)(KKb + (o2 + (unsigned)(r * kstep) + 16384u)); } }
            unsigned ao = (unsigned)(lane * 2 + blk * 1024); asm volatile("" : "+v"(ao));
            asm volatile("" ::: "memory");
#pragma unroll
            for (int r = 0; r < 8; ++r) {
                const int i = 8 * blk + r;
                const float kk = kkc[r], qk = qkc[r];
                const float gci = __builtin_bit_cast(float, __builtin_amdgcn_readlane(__builtin_bit_cast(int, gc), i));
                const float bi = __builtin_bit_cast(float, __builtin_amdgcn_readlane(__builtin_bit_cast(int, beta), i));
                const float dec = __expf(fminf(gci - gc, 0.f));
                const float arow = (lane < i) ? bi * kk * dec : 0.f;
                *(bf16*)(ATb + (ao + (unsigned)(r * 128))) = (bf16)f2bf((lane <= i) ? qk * dec : 0.f);
                float t = (lane == i) ? 1.f : 0.f;
#pragma unroll
                for (int j = 0; j < i; ++j) { const float sv = __builtin_bit_cast(float, __builtin_amdgcn_readlane(__builtin_bit_cast(int, arow), j)); t = fmaf(-sv, Tr[j], t); }
                Tr[i] = t;
            }
            asm volatile("" ::: "memory");
#pragma unroll
            for (int r = 0; r < 8; ++r) { kkc[r] = kkn[r]; qkc[r] = qkn[r]; }
        }
        LAS bf16* TB = (LAS bf16*)(F.lds + w * 16384); LAS bf16* TG = TB + 4096;
        const float cb = beta, cg = beta * egc;
        const int rp = (rl & 32) | (((rl >> 2) & 3) << 3) | (((rl >> 4) & 1) << 2) | (rl & 3);
#pragma unroll
        for (int i = 0; i < 64; ++i) { const int off = i * 64 + ((((rl >> 3) ^ (i & 7))) << 3) + (rl & 7), offg = i * 64 + ((((rp >> 3) ^ (i & 7))) << 3) + (rp & 7);
            TB[off] = (bf16)f2bf(Tr[i] * cb); TG[offg] = (bf16)f2bf(Tr[i] * cg); }
        LDS_WAIT(); asm volatile("" ::: "memory");
        const int fr = lane & 15, fq = lane >> 4;
        bf16x8 ab[4][2], ag[4][2];
#pragma unroll
        for (int m = 0; m < 4; ++m)
#pragma unroll
            for (int ks = 0; ks < 2; ++ks) { const int row = 16 * m + fr, off = row * 64 + (((4 * ks + fq) ^ (row & 7)) << 3); ab[m][ks] = *(const LAS bf16x8*)(TB + off); ag[m][ks] = *(const LAS bf16x8*)(TG + off); }
        const bf16* VTp = (const bf16*)(F.ws + SC_VT) + (size_t)un * 8192; const bf16* KTp = (const bf16*)(F.ws + DN_KT) + (size_t)un * 8192;
        bf16* Up = (bf16*)(F.ws + DN_U) + (size_t)item * 8192; bf16* Wp = (bf16*)(F.ws + DN_W) + (size_t)item * 8192;
#pragma unroll 4
        for (int nn = 0; nn < 8; ++nn) {
            bf16x8 bv[2], bk[2];
#pragma unroll
            for (int ks = 0; ks < 2; ++ks) { bv[ks] = *(const GAS bf16x8*)(VTp + (16 * nn + fr) * 64 + 32 * ks + 8 * fq); bk[ks] = *(const GAS bf16x8*)(KTp + (16 * nn + fr) * 64 + 32 * ks + 8 * fq); }
#pragma unroll
            for (int m = 0; m < 4; ++m) {
                f32x4 au = (f32x4){0.f, 0.f, 0.f, 0.f}, aw = (f32x4){0.f, 0.f, 0.f, 0.f};
#pragma unroll
                for (int ks = 0; ks < 2; ++ks) { au = MFMA16(ab[m][ks], bv[ks], au); aw = MFMA16(bk[ks], ag[m][ks], aw); }
                v2u uo; uo.x = pk2(au[0], au[1]); uo.y = pk2(au[2], au[3]);
                *(GAS v2u*)(Up + ((m * 8 + nn) * 64 + lane) * 4) = uo;
                v2u wo; wo.x = pk2(aw[0], aw[1]); wo.y = pk2(aw[2], aw[3]);
                *(GAS v2u*)(Wp + (16 * m + fr) * 128 + 32 * (nn >> 1) + 8 * fq + 4 * (nn & 1)) = wo;
            }
        }
    }
    __syncthreads();
}

constexpr int CW_PROG = 36864;
constexpr int RB_W = 0, RB_KT = 16384, RB_U = 32768, RB_GV = 40960, RB_SIZE = 41984;
static_assert(3 * RB_SIZE <= RING_BYTES, "scan ring");
constexpr size_t DN_SX0 = DN_U + 32 * MiB, DN_SX1 = DN_W + 32 * MiB, DN_VX0 = DN_QS + 16 * MiB, DN_VX1 = DN_KT + 16 * MiB;
__device__ __forceinline__ void glds16_sc1(const void* gsrc, LAS unsigned char* ldst) {
    __builtin_amdgcn_global_load_lds((const unsigned*)gsrc, (LAS unsigned*)ldst, 16, 0, 16);
}
template <int OFF>
__device__ __forceinline__ void store16_sc1(void* gdst, v4u v) {
    asm volatile("global_store_dwordx4 %0, %1, off offset:%2 sc1\n\ts_nop 1" :: "v"(gdst), "v"(v), "n"(OFF) : "memory");
}
__device__ __forceinline__ bf16x8 ld2x8(const LAS unsigned char* p0, const LAS unsigned char* p1) {
    const v2u lo = *(const LAS v2u*)p0, hi = *(const LAS v2u*)p1; v4u v; v.x = lo.x; v.y = lo.y; v.z = hi.x; v.w = hi.y; return __builtin_bit_cast(bf16x8, v);
}
struct ScanOff { unsigned w0[4], k0[2], u, gk; };
template <int DIR, int BUF>
__device__ __forceinline__ void scan_step(LAS unsigned char* L, const ScanOff& O, f32x4 (&S)[8], unsigned char*& sxp, unsigned char*& vxp, bool ex) {
    const LAS unsigned char* B = L + BUF * RB_SIZE;
    v4u sbv[4];
#pragma unroll
    for (int ks = 0; ks < 4; ++ks) { sbv[ks].x = pk2(S[2 * ks][0], S[2 * ks][1]); sbv[ks].y = pk2(S[2 * ks][2], S[2 * ks][3]); sbv[ks].z = pk2(S[2 * ks + 1][0], S[2 * ks + 1][1]); sbv[ks].w = pk2(S[2 * ks + 1][2], S[2 * ks + 1][3]); }
    if (ex) { store16_sc1<0>(sxp, sbv[0]); store16_sc1<1024>(sxp, sbv[1]); store16_sc1<2048>(sxp, sbv[2]); store16_sc1<3072>(sxp, sbv[3]); }
    bf16x8 fw[4][4]; v2u ucv[4]; f32x4 ekv[4];
#pragma unroll
    for (int it = 0; it < 4; ++it) {
#pragma unroll
        for (int ks = 0; ks < 4; ++ks) fw[it][ks] = *(const LAS bf16x8*)(B + RB_W + O.w0[ks] + it * 4096);
        ucv[it] = *(const LAS v2u*)(B + RB_U + O.u + it * 2048); ekv[it] = *(const LAS f32x4*)(B + RB_GV + O.gk + it * 64); }
    const float dch = ((const LAS float*)(B + RB_GV))[63];
    f32x4 aW[4];
#pragma unroll
    for (int it = 0; it < 4; ++it) { aW[it] = (f32x4){0.f, 0.f, 0.f, 0.f};
#pragma unroll
        for (int ks = 0; ks < 4; ++ks) aW[it] = MFMA16(fw[it][ks], __builtin_bit_cast(bf16x8, sbv[ks]), aW[it]); }
    bf16x8 fk[8][2];
#pragma unroll
    for (int dt = 0; dt < 8; ++dt)
#pragma unroll
        for (int k2 = 0; k2 < 2; ++k2) fk[dt][k2] = *(const LAS bf16x8*)(B + RB_KT + O.k0[k2] + dt * 2048);
    f32x4 vs[4]; v2u vnp[4];
#pragma unroll
    for (int it = 0; it < 4; ++it) {
        const v2u uc = ucv[it]; const f32x4 ek = ekv[it];
        f32x4 vn;
        vn[0] = bf2f((unsigned short)(uc.x & 0xffffu)) - aW[it][0]; vn[1] = bf2f((unsigned short)(uc.x >> 16)) - aW[it][1];
        vn[2] = bf2f((unsigned short)(uc.y & 0xffffu)) - aW[it][2]; vn[3] = bf2f((unsigned short)(uc.y >> 16)) - aW[it][3];
        vnp[it] = (v2u){pk2(vn[0], vn[1]), pk2(vn[2], vn[3])};
        vs[it] = vn * ek;
    }
    if (ex) { store16_sc1<0>(vxp, (v4u){vnp[0].x, vnp[0].y, vnp[1].x, vnp[1].y}); store16_sc1<1024>(vxp, (v4u){vnp[2].x, vnp[2].y, vnp[3].x, vnp[3].y}); }
    sxp += DIR ? -32768 : 32768; vxp += DIR ? -16384 : 16384;
    bf16x8 Vsb[2];
#pragma unroll
    for (int k2 = 0; k2 < 2; ++k2) { v4u t;
        if (DIR) { t.x = pk2(vs[2 * k2 + 1][3], vs[2 * k2 + 1][2]); t.y = pk2(vs[2 * k2 + 1][1], vs[2 * k2 + 1][0]); t.z = pk2(vs[2 * k2][3], vs[2 * k2][2]); t.w = pk2(vs[2 * k2][1], vs[2 * k2][0]); }
        else { t.x = pk2(vs[2 * k2][0], vs[2 * k2][1]); t.y = pk2(vs[2 * k2][2], vs[2 * k2][3]); t.z = pk2(vs[2 * k2 + 1][0], vs[2 * k2 + 1][1]); t.w = pk2(vs[2 * k2 + 1][2], vs[2 * k2 + 1][3]); }
        Vsb[k2] = __builtin_bit_cast(bf16x8, t); }
#pragma unroll
    for (int dt = 0; dt < 8; ++dt) { S[dt] = S[dt] * dch;
#pragma unroll
        for (int k2 = 0; k2 < 2; ++k2) S[dt] = MFMA16(fk[dt][k2], Vsb[k2], S[dt]); }
    asm volatile("s_waitcnt vmcnt(12) lgkmcnt(0)" ::: "memory"); __builtin_amdgcn_s_barrier(); asm volatile("" ::: "memory");
}
template <int DIR>
__device__ __forceinline__ void scan_compute(Frame& F, LAS unsigned char* L, int hf, int bh, int mode) {
    const int lane = F.lane, w = F.wave, fr = lane & 15, fq = lane >> 4;
    ScanOff O;
    const int s7 = (fr >> 1) & 7;
#pragma unroll
    for (int ks = 0; ks < 4; ++ks) O.w0[ks] = (unsigned)(fr * 256 + (((4 * ks + fq) ^ fr) << 4));
#pragma unroll
    for (int k2 = 0; k2 < 2; ++k2) {
        const int ck = DIR ? 4 * (1 - k2) + (3 - fq) : 4 * k2 + fq;
        O.k0[k2] = (unsigned)(fr * 128 + ((ck ^ s7) << 4));
    }
    O.u = (unsigned)((w * 64 + lane) * 8); O.gk = (unsigned)((64 + 4 * fq) * 4);
    const int item0 = (bh * 128 + (DIR ? 127 : 0)) * 2 + DIR;
    unsigned char* sxp = F.ws + (hf ? DN_SX1 : DN_SX0) + (size_t)item0 * 16384 + w * 4096 + lane * 16;
    unsigned char* vxp = F.ws + (hf ? DN_VX1 : DN_VX0) + (size_t)item0 * 8192 + w * 2048 + lane * 16;
    const bool ex = !(mode & 1);
    f32x4 S[8];
#pragma unroll
    for (int t = 0; t < 8; ++t) S[t] = (f32x4){0.f, 0.f, 0.f, 0.f};
    __builtin_amdgcn_s_barrier(); asm volatile("" ::: "memory");
#pragma unroll 1
    for (int step = 0; step < 126; step += 3) { scan_step<DIR, 0>(L, O, S, sxp, vxp, ex); scan_step<DIR, 1>(L, O, S, sxp, vxp, ex); scan_step<DIR, 2>(L, O, S, sxp, vxp, ex); }
    scan_step<DIR, 0>(L, O, S, sxp, vxp, ex); scan_step<DIR, 1>(L, O, S, sxp, vxp, ex);
}
__device__ __forceinline__ void scan_loader(Frame& F, LAS unsigned char* L, int c, int hf, int dir, int bh, int mode) {
    const int lane = F.lane, lw = F.wave - 4;
    unsigned goff[11];
#pragma unroll
    for (int k = 0; k < 11; ++k) { const int p = lw + 4 * k, q = (p & 15) * 64 + lane;
        if (p < 16) { const int row = q >> 4, ch = (q & 15) ^ (row & 15); goff[k] = (unsigned)(row * 256 + ch * 16); }
        else if (p < 32) { const int row = q >> 3, ch = (q & 7) ^ ((row >> 1) & 7); goff[k] = (unsigned)(row * 128 + ch * 16); }
        else if (p < 40) { const int pu = p - 32; goff[k] = (unsigned)((((pu >> 1) * 8 + 4 * hf) * 512) + (pu & 1) * 1024 + lane * 16); }
        else goff[k] = (unsigned)(lane * 16); }
    unsigned* prog = (unsigned*)(F.ctl + CW_PROG + 2048 * F.li + 64 * (c * 2 + hf));
    auto issue = [&](int t, LAS unsigned char* B) {
        const int nc = dir ? 127 - t : t, un = bh * 128 + nc, item = un * 2 + dir;
        const unsigned char* gW = F.ws + DN_W + (size_t)item * 16384; const unsigned char* gK = F.ws + DN_KT + (size_t)un * 16384;
        const unsigned char* gU = F.ws + DN_U + (size_t)item * 16384; const unsigned char* gG = F.ws + DN_GV + (size_t)item * 512;
#pragma unroll
        for (int k = 0; k < 11; ++k) { const int p = lw + 4 * k;
            if (k < 4) glds16(gW + goff[k], B + RB_W + p * 1024);
            else if (k < 8) glds16(gK + goff[k], B + RB_KT + (p - 16) * 1024);
            else if (k < 10) glds16(gU + goff[k], B + RB_U + (p - 32) * 1024);
            else if (lw == 0) glds16(gG + goff[k], B + RB_GV); }
    };
    if (!(mode & 2)) issue(0, L);
    int nb = 1;
#pragma unroll 1
    for (int k = 0; k <= 128; ++k) {
        if (k + 1 < 128 && !(mode & 2)) { issue(k + 1, L + nb * RB_SIZE);
            if (lw == 0) asm volatile("s_waitcnt vmcnt(11)" ::: "memory"); else asm volatile("s_waitcnt vmcnt(10)" ::: "memory"); }
        else asm volatile("s_waitcnt vmcnt(0)" ::: "memory");
        if (++nb == 3) nb = 0;
        __builtin_amdgcn_s_barrier(); asm volatile("" ::: "memory");
        if (lw == 0 && lane == 0 && k >= 3 && !(mode & 1)) __hip_atomic_store(prog, (unsigned)(k - 2), RLX_AGENT);
    }
}
__device__ __forceinline__ void p3_scan(Frame& F, int c, int hf, int mode  ) {
    const int b = c >> 3, h = (c >> 1) & 3, dir = c & 1, bh = b * 4 + h;
    LAS unsigned char* L = F.lds;
    if (F.wave >= 4) scan_loader(F, L, c, hf, dir, bh, mode);
    else if (dir) scan_compute<1>(F, L, hf, bh, mode); else scan_compute<0>(F, L, hf, bh, mode);
    asm volatile("s_waitcnt vmcnt(0) lgkmcnt(0)" ::: "memory"); __syncthreads();
    if (F.tid == 256 && !(mode & 1)) __hip_atomic_store((unsigned*)(F.ctl + CW_PROG + 2048 * F.li + 64 * (c * 2 + hf)), 128u, RLX_AGENT);
    __syncthreads();
}

constexpr int OL_Q = 0, OL_AT = 16384, OL_SX = 24576, OL_VX = 40960, OL_GV = 49152, OL_SIZE = 50176;
__device__ __forceinline__ void p3_out_issue(Frame& F, int j, LAS unsigned char* Lb) {
    const int lane = F.lane, w = F.wave;
    const int n = j >> 5, wg = j & 31, c = wg >> 1, hf = wg & 1, b = c >> 3, h = (c >> 1) & 3, dir = c & 1, bh = b * 4 + h;
    const int nc = dir ? 127 - n : n, un = bh * 128 + nc, item = un * 2 + dir;
    const unsigned char* gQ = F.ws + DN_QS + (size_t)un * 16384; const unsigned char* gA = F.ws + DN_AT + (size_t)item * 8192;
    const unsigned char* gS = F.ws + (hf ? DN_SX1 : DN_SX0) + (size_t)item * 16384; const unsigned char* gV = F.ws + (hf ? DN_VX1 : DN_VX0) + (size_t)item * 8192;
#pragma unroll
    for (int k = 0; k < 2; ++k) { const int p = 2 * w + k, q = p * 64 + lane, row = q >> 4, ch = (q & 15) ^ (row & 15);
        glds16(gQ + row * 256 + ch * 16, Lb + OL_Q + p * 1024); glds16_sc1(gS + p * 1024 + lane * 16, Lb + OL_SX + p * 1024); }
    { const int q = w * 64 + lane, row = q >> 3, ch = (q & 7) ^ ((row >> 1) & 7); glds16(gA + row * 128 + ch * 16, Lb + OL_AT + w * 1024); glds16_sc1(gV + w * 1024 + lane * 16, Lb + OL_VX + w * 1024); }
    if (w == 0) glds16(F.ws + DN_GV + (size_t)item * 512 + lane * 16, Lb + OL_GV);
}
__device__ __forceinline__ void p3_out_compute(Frame& F, int j, const LAS unsigned char* Lb, float* odir) {
    const int lane = F.lane, w = F.wave, fr = lane & 15, fq = lane >> 4, mi = w >> 1, eh = w & 1;
    const int n = j >> 5, wg = j & 31, c = wg >> 1, hf = wg & 1, b = c >> 3, h = (c >> 1) & 3, dir = c & 1;
    const int nc = dir ? 127 - n : n;
    const int irow = 16 * mi + fr, qrow = dir ? 63 - irow : irow;
    const int hb = 8 * (fq & 1), fh = fq >> 1;
    f32x4 aQ[2];
#pragma unroll
    for (int t = 0; t < 2; ++t) aQ[t] = (f32x4){0.f, 0.f, 0.f, 0.f};
#pragma unroll
    for (int ks = 0; ks < 4; ++ks) {
        const bf16x8 fqv = ld2x8(Lb + OL_Q + qrow * 256 + (((4 * ks + fh) ^ (qrow & 15)) << 4) + hb, Lb + OL_Q + qrow * 256 + (((4 * ks + 2 + fh) ^ (qrow & 15)) << 4) + hb);
#pragma unroll
        for (int t = 0; t < 2; ++t) { const bf16x8 fs = *(const LAS bf16x8*)(Lb + OL_SX + ((2 * eh + t) * 4 + ks) * 1024 + lane * 16); aQ[t] = MFMA16(fs, fqv, aQ[t]); }
    }
    const float egc_i = ((const LAS float*)(Lb + OL_GV))[irow];
#pragma unroll
    for (int t = 0; t < 2; ++t) aQ[t] = aQ[t] * egc_i;
#pragma unroll
    for (int ks = 0; ks < 2; ++ks) {
        const bf16x8 fa = ld2x8(Lb + OL_AT + irow * 128 + (((4 * ks + fh) ^ ((irow >> 1) & 7)) << 4) + hb, Lb + OL_AT + irow * 128 + (((4 * ks + 2 + fh) ^ ((irow >> 1) & 7)) << 4) + hb);
#pragma unroll
        for (int t = 0; t < 2; ++t) { const bf16x8 fv = *(const LAS bf16x8*)(Lb + OL_VX + ((2 * eh + t) * 2 + ks) * 1024 + lane * 16); aQ[t] = MFMA16(fv, fa, aQ[t]); }
    }
    const size_t tok = (size_t)b * SEQ + 64 * nc + qrow;
    float* op = odir + ((size_t)dir * T + tok) * 512 + h * 128 + 64 * hf + 4 * fq;
#pragma unroll
    for (int t = 0; t < 2; ++t) *(GAS f32x4*)(op + 16 * (2 * eh + t)) = aQ[t];
}
__device__ __forceinline__ void p3_out_batch(Frame& F, int j0, int cnt  , float* odir) {
    const int n = j0 >> 5;
    LAS unsigned char* L = F.lds;
    if (F.tid < 64) { unsigned sp = 0;
        for (;;) { bool ok = true; if (F.tid < cnt) ok = (int)__hip_atomic_load((unsigned*)(F.ctl + CW_PROG + 2048 * F.li + 64 * ((j0 & 31) + F.tid)), RLX_AGENT) > n;
            if (__all(ok) || ++sp > (1u << 22)) break; __builtin_amdgcn_s_sleep(127); __builtin_amdgcn_s_sleep(127); } }
    __syncthreads();
    p3_out_issue(F, j0, L); p3_out_issue(F, j0 + (cnt > 1 ? 1 : 0), L + OL_SIZE);
    int bk = 0;
#pragma unroll 1
    for (int k = 0; k < cnt; ++k) {
        asm volatile("s_waitcnt vmcnt(6) lgkmcnt(0)" ::: "memory"); __builtin_amdgcn_s_barrier(); asm volatile("" ::: "memory");
        { int b2 = bk + 2; if (b2 >= 3) b2 -= 3; const int kn = k + 2 < cnt ? k + 2 : cnt - 1; p3_out_issue(F, j0 + kn, L + b2 * OL_SIZE); }
        p3_out_compute(F, j0 + k, L + bk * OL_SIZE, odir);
        if (++bk == 3) bk = 0;
    }
    asm volatile("s_waitcnt vmcnt(0) lgkmcnt(0)" ::: "memory"); __syncthreads();
}
typedef float f32x16 __attribute__((ext_vector_type(16)));
#define MFMA32(a, b, c) __builtin_amdgcn_mfma_f32_32x32x16_bf16((a), (b), (c), 0, 0, 0)
constexpr size_t WS_ROT = WS_CTL + 256 * 1024;
constexpr int VT_PITCH = 324;
constexpr int CW_WQ = 49152;
constexpr int LT_WQ = LDSCTL_OFF + 512;

__device__ __forceinline__ void p0_rot_table(Frame& F) {
    float* rot = (float*)(F.ws + WS_ROT);
    for (int i = (F.vcu * NTHR + F.tid); i < SEQ * 8; i += F.G * NTHR) { const int s = i >> 3, k = i & 7;
        const float inv = powf(500000.f, -(float)(2 * k) / 16.f); float sn, cs; sincosf((float)s * inv, &sn, &cs); rot[2 * i] = cs; rot[2 * i + 1] = sn; }
}

__device__ __forceinline__ void p3_attn_unit(Frame& F, int unit, const float* sink) {
    const int tid = F.tid, lane = F.lane, w = F.wave, r = lane & 31, hh = lane >> 5;
    const int b = unit >> 8, kvh = (unit >> 7) & 1, qt = unit & 127, k0 = 64 * qt - 128;
    const bf16* proj = (const bf16*)(F.ws + WS_PROJ); const float* rot = (const float*)(F.ws + WS_ROT);
    LAS bf16* KLs = (LAS bf16*)F.lds;
    LAS bf16* VTs = (LAS bf16*)(F.lds + 40960);
#pragma unroll 1
    for (int idx = tid; idx < 320 * 8; idx += NTHR) {
        const int key = idx >> 3, ch = idx & 7, kp = k0 + key;
        v4u kv = (v4u){0u, 0u, 0u, 0u}, vv = (v4u){0u, 0u, 0u, 0u};
        if (kp >= 0 && kp < SEQ) {
            const bf16* rowp = proj + (size_t)(b * SEQ + kp) * NPROJ;
            vv = *(const GAS v4u*)(rowp + PJ_AV + kvh * 64 + ch * 8);
            if (ch >= 2) kv = *(const GAS v4u*)(rowp + PJ_AK + kvh * 64 + ch * 8);
            else {
                const v4u a = *(const GAS v4u*)(rowp + PJ_AK + kvh * 64), c = *(const GAS v4u*)(rowp + PJ_AK + kvh * 64 + 8);
                const float* rp = rot + (size_t)kp * 16; float o[8];
#pragma unroll
                for (int i = 0; i < 8; ++i) { const unsigned ua = a[i >> 1], uc = c[i >> 1];
                    const float x1 = bf2f((unsigned short)((i & 1) ? (ua >> 16) : (ua & 0xffffu))), x2 = bf2f((unsigned short)((i & 1) ? (uc >> 16) : (uc & 0xffffu)));
                    const float cs = rp[2 * i], sn = rp[2 * i + 1]; o[i] = ch == 0 ? x1 * cs - x2 * sn : x2 * cs + x1 * sn; }
                kv.x = pk2(o[0], o[1]); kv.y = pk2(o[2], o[3]); kv.z = pk2(o[4], o[5]); kv.w = pk2(o[6], o[7]);
            }
        }
        *(LAS v4u*)(KLs + key * 64 + ((ch ^ ((key >> 1) & 7)) << 3)) = kv;
#pragma unroll
        for (int i = 0; i < 8; ++i) { const unsigned u = vv[i >> 1]; VTs[(ch * 8 + i) * VT_PITCH + key] = (bf16)((i & 1) ? (u >> 16) : (u & 0xffffu)); }
    }
    const int hq = kvh * 4 + (w >> 1), qp = 64 * qt + 32 * (w & 1) + r;
    const bf16* qrow = proj + (size_t)(b * SEQ + qp) * NPROJ + PJ_AQ + hq * 64;
    bf16x8 qf[4];
    {
        const v4u a = *(const GAS v4u*)(qrow), c = *(const GAS v4u*)(qrow + 8);
        const float* rp = rot + (size_t)qp * 16; float o[8];
#pragma unroll
        for (int i = 0; i < 8; ++i) { const unsigned ua = a[i >> 1], uc = c[i >> 1];
            const float x1 = bf2f((unsigned short)((i & 1) ? (ua >> 16) : (ua & 0xffffu))), x2 = bf2f((unsigned short)((i & 1) ? (uc >> 16) : (uc & 0xffffu)));
            const float cs = rp[2 * i], sn = rp[2 * i + 1]; o[i] = (hh == 0 ? x1 * cs - x2 * sn : x2 * cs + x1 * sn) * 0.125f; }
        v4u q0; q0.x = pk2(o[0], o[1]); q0.y = pk2(o[2], o[3]); q0.z = pk2(o[4], o[5]); q0.w = pk2(o[6], o[7]);
        qf[0] = __builtin_bit_cast(bf16x8, q0);
#pragma unroll
        for (int s = 1; s < 4; ++s) { const v4u q = *(const GAS v4u*)(qrow + 16 * s + 8 * hh); float t[8];
#pragma unroll
            for (int i = 0; i < 8; ++i) { const unsigned u = q[i >> 1]; t[i] = bf2f((unsigned short)((i & 1) ? (u >> 16) : (u & 0xffffu))) * 0.125f; }
            v4u qq; qq.x = pk2(t[0], t[1]); qq.y = pk2(t[2], t[3]); qq.z = pk2(t[4], t[5]); qq.w = pk2(t[6], t[7]); qf[s] = __builtin_bit_cast(bf16x8, qq); }
    }
    __syncthreads();
    float m = sink[hq], l = hh == 0 ? 1.f : 0.f;
    f32x16 O[2];
#pragma unroll
    for (int i = 0; i < 16; ++i) { O[0][i] = 0.f; O[1][i] = 0.f; }
#pragma unroll 1
    for (int kb = (w & 1); kb < (w & 1) + 9; ++kb) {
        f32x16 X;
#pragma unroll
        for (int i = 0; i < 16; ++i) X[i] = 0.f;
        const int krow = 32 * kb + r;
#pragma unroll
        for (int s = 0; s < 4; ++s) { const bf16x8 ka = *(const LAS bf16x8*)(KLs + krow * 64 + (((2 * s + hh) ^ ((krow >> 1) & 7)) << 3)); X = MFMA32(ka, qf[s], X); }
        float bm = -1e30f;
#pragma unroll
        for (int i = 0; i < 16; ++i) { const int kp = k0 + 32 * kb + (i & 3) + 8 * (i >> 2) + 4 * hh, dlt = qp - kp;
            const bool ok = (dlt <= 128) && (dlt >= -128) && (kp >= 0) && (kp < SEQ); X[i] = ok ? X[i] : -1e30f; bm = fmaxf(bm, X[i]); }
        bm = fmaxf(bm, __shfl_xor(bm, 32));
        const float mn = fmaxf(m, bm), alpha = __expf(m - mn); m = mn;
        float ps = 0.f;
#pragma unroll
        for (int i = 0; i < 16; ++i) { X[i] = __expf(X[i] - mn); ps += X[i]; }
        l = l * alpha + ps;
#pragma unroll
        for (int i = 0; i < 16; ++i) { O[0][i] *= alpha; O[1][i] *= alpha; }
        bf16x8 pk[2];
#pragma unroll
        for (int s = 0; s < 2; ++s) { v4u t; t.x = pk2(X[8 * s], X[8 * s + 1]); t.y = pk2(X[8 * s + 2], X[8 * s + 3]); t.z = pk2(X[8 * s + 4], X[8 * s + 5]); t.w = pk2(X[8 * s + 6], X[8 * s + 7]); pk[s] = __builtin_bit_cast(bf16x8, t); }
#pragma unroll
        for (int dt = 0; dt < 2; ++dt)
#pragma unroll
            for (int s = 0; s < 2; ++s) { const LAS bf16* vp = VTs + (32 * dt + r) * VT_PITCH + 32 * kb + 16 * s + 4 * hh;
                const v2u lo = *(const LAS v2u*)vp, hi = *(const LAS v2u*)(vp + 8); v4u va; va.x = lo.x; va.y = lo.y; va.z = hi.x; va.w = hi.y;
                O[dt] = MFMA32(__builtin_bit_cast(bf16x8, va), pk[s], O[dt]); }
    }
    l += __shfl_xor(l, 32);
    const float inv = 1.f / l;
    bf16* orow = (bf16*)(F.ws + WS_MIX) + (size_t)(b * SEQ + qp) * D + 512 + hq * 64;
#pragma unroll
    for (int dt = 0; dt < 2; ++dt)
#pragma unroll
        for (int g = 0; g < 4; ++g) { v2u o; o.x = pk2(O[dt][4 * g] * inv, O[dt][4 * g + 1] * inv); o.y = pk2(O[dt][4 * g + 2] * inv, O[dt][4 * g + 3] * inv);
            *(GAS v2u*)(orow + 32 * dt + 8 * g + 4 * hh) = o; }
    __syncthreads();
}

__device__ __forceinline__ void p3_moe_weight_items(Frame& F, int first_wave, int n_waves, int end_item, const float* w_gu, const float* w_dn) {
    LAS float* scr = (LAS float*)(F.lds + F.wave * 16384);
    bf16* Wgu_t = (bf16*)(F.ws + WS_WGU); bf16* Wd_t = (bf16*)(F.ws + WS_WD);
    constexpr int I_GU = NEXP * 16 * 16, I_DN = NEXP * 4 * 32;
#pragma unroll 1
    for (int it = first_wave; it < end_item; it += n_waves) {
        if (it < I_GU) { const int e = it >> 8, kb = (it >> 4) & 15, nb = it & 15, n0 = 32 * nb, pn = n0 >> 8, bj = (n0 >> 7) & 1, c = n0 & 127;
            transpose_item(w_gu + (size_t)e * D * 512, 512, bj * 256 + pn * 128 + c, 64 * kb, Wgu_t + (size_t)e * 512 * D, D, n0, scr, F.lane); }
        else { const int r2 = it - I_GU, e = r2 >> 7, kb = (r2 >> 5) & 3, nb = r2 & 31; transpose_item(w_dn + (size_t)e * EFF * D, D, 32 * nb, 64 * kb, Wd_t + (size_t)e * D * EFF, EFF, 32 * nb, scr, F.lane); }
    }
}

__device__ __forceinline__ void p4_combine(Frame& F, const float* odir, const float* normw) {
    const int gw = F.vcu * NWAVES + F.wave, NGW = F.G * NWAVES, lane = F.lane;
    const bf16* proj = (const bf16*)(F.ws + WS_PROJ); bf16* mix = (bf16*)(F.ws + WS_MIX);
    const f32x4 nw0 = *(const f32x4*)(normw + 8 * (lane & 15)), nw1 = *(const f32x4*)(normw + 8 * (lane & 15) + 4);
#pragma unroll 1
    for (int tok = gw; tok < T; tok += NGW) {
        const float* of = odir + (size_t)tok * 512 + 8 * lane; const float* ob = of + (size_t)T * 512;
        const f32x4 a0 = *(const GAS f32x4*)of + *(const GAS f32x4*)ob, a1 = *(const GAS f32x4*)(of + 4) + *(const GAS f32x4*)(ob + 4);
        float s = (a0.x * a0.x + a0.y * a0.y) + (a0.z * a0.z + a0.w * a0.w) + (a1.x * a1.x + a1.y * a1.y) + (a1.z * a1.z + a1.w * a1.w);
        s += __shfl_xor(s, 1); s += __shfl_xor(s, 2); s += __shfl_xor(s, 4); s += __shfl_xor(s, 8);
        const float rs = rsqrtf(s * (1.f / 128.f) + EPS);
        const v4u zz = *(const GAS v4u*)(proj + (size_t)tok * NPROJ + PJ_Z + 8 * lane);
        float z[8];
#pragma unroll
        for (int i = 0; i < 8; ++i) { const unsigned u = zz[i >> 1]; z[i] = bf2f((unsigned short)((i & 1) ? (u >> 16) : (u & 0xffffu))); }
        v4u o;
        o.x = pk2(a0.x * rs * nw0.x * silu_f(z[0]), a0.y * rs * nw0.y * silu_f(z[1])); o.y = pk2(a0.z * rs * nw0.z * silu_f(z[2]), a0.w * rs * nw0.w * silu_f(z[3]));
        o.z = pk2(a1.x * rs * nw1.x * silu_f(z[4]), a1.y * rs * nw1.y * silu_f(z[5])); o.w = pk2(a1.z * rs * nw1.z * silu_f(z[6]), a1.w * rs * nw1.w * silu_f(z[7]));
        *(GAS v4u*)(mix + (size_t)tok * D + 8 * lane) = o;
    }
}
constexpr size_t WS_RW = 488 * MiB;
constexpr size_t RW_HI = WS_RW, RW_LO = WS_RW + 256 * 1024, RW_RSTD = WS_RW + 512 * 1024, RW_GATE = WS_RW + 640 * 1024;
constexpr size_t WS_LIST = WS_MISC + 2 * MiB;
constexpr size_t WS_XS = WS_DN, WS_HMID = WS_DN + 96 * MiB, WS_Y2 = WS_DN + 120 * MiB;
constexpr int CW_CNT = 32768;
constexpr int LT_PSTART = LDSCTL_OFF + 1024, LT_PTAB = LDSCTL_OFF + 1536;

__device__ __forceinline__ void p0_router_weights(Frame& F, const float* lnw, const float* wg, const float* we) {
    bf16* hi = (bf16*)(F.ws + RW_HI); bf16* lo = (bf16*)(F.ws + RW_LO);
    for (int i = F.vcu * NTHR + F.tid; i < 80 * D; i += F.G * NTHR) { const int n = i >> 10, k = i & 1023;
        float v = 0.f; if (n < 8) v = wg[k * 8 + n] * lnw[k]; else if (n < 72) v = we[k * 64 + (n - 8)] * lnw[k];
        const unsigned h = f2bf(v); const float r = v - bf2f((unsigned short)h); hi[i] = (bf16)h; lo[i] = (bf16)f2bf(r); }
}
__device__ __forceinline__ void split8(const f32x4 a, const f32x4 b, bf16x8& h, bf16x8& l) {
    const float x[8] = {a.x, a.y, a.z, a.w, b.x, b.y, b.z, b.w}; unsigned hh[8], ll[8];
#pragma unroll
    for (int i = 0; i < 8; ++i) { hh[i] = f2bf(x[i]); ll[i] = f2bf(x[i] - bf2f((unsigned short)hh[i])); }
    v4u vh, vl; vh.x = hh[0] | (hh[1] << 16); vh.y = hh[2] | (hh[3] << 16); vh.z = hh[4] | (hh[5] << 16); vh.w = hh[6] | (hh[7] << 16);
    vl.x = ll[0] | (ll[1] << 16); vl.y = ll[2] | (ll[3] << 16); vl.z = ll[4] | (ll[5] << 16); vl.w = ll[6] | (ll[7] << 16);
    h = __builtin_bit_cast(bf16x8, vh); l = __builtin_bit_cast(bf16x8, vl);
}
__device__ __forceinline__ void p6_route(Frame& F, const float* lnw, const float* bgrp, const float* bexp, int dry) {
    const int lane = F.lane, w = F.wave, fr = lane & 15, fq = lane >> 4;
    const float* x1 = F.out; bf16* h2u = (bf16*)(F.ws + WS_HN);
    const bf16* Wh = (const bf16*)(F.ws + RW_HI); const bf16* Wl = (const bf16*)(F.ws + RW_LO);
    LAS float* PL = (LAS float*)F.lds;
    LAS float* PS = PL + 8 * 32 * 80;
    LAS float* LG = PS + 8 * 32;
    LAS float* RS = LG + 32 * 80;
    LAS int* LC = (LAS int*)(RS + 32);
    LAS int* PK = LC + 64;
    unsigned* cnt = (unsigned*)(F.ctl + CW_CNT + (dry ? 24576 : 0)); int* list = (int*)(F.ws + (dry ? WS_DN + 196 * MiB : WS_LIST)); float* pgate = (float*)(F.ws + RW_GATE); float* rstd_g = (float*)(F.ws + RW_RSTD);
#pragma unroll 1
    for (int grp = blockIdx.x; grp < T / 64; grp += F.G) {
        if (F.tid < 64) LC[F.tid] = 0;
        f32x4 acc[4][5]; float ss[4];
#pragma unroll
        for (int tl = 0; tl < 4; ++tl) { ss[tl] = 0.f;
#pragma unroll
            for (int c = 0; c < 5; ++c) acc[tl][c] = (f32x4){0.f, 0.f, 0.f, 0.f}; }
#pragma unroll 1
        for (int kk = 0; kk < 4; ++kk) {
            const int k0 = 32 * (4 * w + kk) + 8 * fq;
            bf16x8 bh[5], bl[5];
#pragma unroll
            for (int c = 0; c < 5; ++c) { bh[c] = *(const GAS bf16x8*)(Wh + (size_t)(16 * c + fr) * D + k0); bl[c] = *(const GAS bf16x8*)(Wl + (size_t)(16 * c + fr) * D + k0); }
            const f32x4 la = *(const f32x4*)(lnw + k0), lb = *(const f32x4*)(lnw + k0 + 4);
#pragma unroll
            for (int tl = 0; tl < 4; ++tl) {
                const int tok = (grp * 4 + tl) * 16 + fr;
                const f32x4 xa = *(const GAS f32x4*)(x1 + (size_t)tok * D + k0), xb = *(const GAS f32x4*)(x1 + (size_t)tok * D + k0 + 4);
                ss[tl] += (xa.x * xa.x + xa.y * xa.y) + (xa.z * xa.z + xa.w * xa.w) + (xb.x * xb.x + xb.y * xb.y) + (xb.z * xb.z + xb.w * xb.w);
                v4u ho; ho.x = pk2(xa.x * la.x, xa.y * la.y); ho.y = pk2(xa.z * la.z, xa.w * la.w); ho.z = pk2(xb.x * lb.x, xb.y * lb.y); ho.w = pk2(xb.z * lb.z, xb.w * lb.w);
                *(GAS v4u*)(h2u + (size_t)tok * D + k0) = ho;
                bf16x8 ah, al; split8(xa, xb, ah, al);
#pragma unroll
                for (int c = 0; c < 5; ++c) { acc[tl][c] = MFMA16(ah, bh[c], acc[tl][c]); acc[tl][c] = MFMA16(al, bh[c], acc[tl][c]); acc[tl][c] = MFMA16(ah, bl[c], acc[tl][c]); }
            }
        }
#pragma unroll
        for (int tl = 0; tl < 4; ++tl) { ss[tl] += __shfl_xor(ss[tl], 16); ss[tl] += __shfl_xor(ss[tl], 32); }
#pragma unroll
        for (int rd = 0; rd < 2; ++rd) {
#pragma unroll
            for (int t2 = 0; t2 < 2; ++t2) { const int tl = 2 * rd + t2;
#pragma unroll
                for (int c = 0; c < 5; ++c)
#pragma unroll
                    for (int r = 0; r < 4; ++r) PL[(w * 32 + t2 * 16 + 4 * fq + r) * 80 + 16 * c + fr] = acc[tl][c][r];
                if (lane < 16) PS[w * 32 + t2 * 16 + lane] = ss[tl]; }
            __syncthreads();
            for (int i = F.tid; i < 32 * 80; i += NTHR) { float s = 0.f;
#pragma unroll
                for (int ww = 0; ww < 8; ++ww) s += PL[ww * 2560 + i];
                LG[i] = s; }
            if (F.tid < 32) { float s = 0.f;
#pragma unroll
                for (int ww = 0; ww < 8; ++ww) s += PS[ww * 32 + F.tid];
                RS[F.tid] = rsqrtf(s * (1.f / D) + EPS); }
            __syncthreads();
            if (F.tid < 32) {
                const LAS float* lg = LG + F.tid * 80; const float rs = RS[F.tid];
                float gl[8]; int gi = 0; float gm = -1e30f;
#pragma unroll
                for (int g = 0; g < 8; ++g) { gl[g] = lg[g] * rs + bgrp[g]; if (gl[g] > gm) { gm = gl[g]; gi = g; } }
                float gs = 0.f;
#pragma unroll
                for (int g = 0; g < 8; ++g) gs += expf(gl[g] - gm);
                const float pg = 1.f / gs;
                float el[8]; int e1 = 0; float m1 = -1e30f;
#pragma unroll
                for (int e = 0; e < 8; ++e) { el[e] = lg[8 + gi * 8 + e] * rs + bexp[gi * 8 + e]; if (el[e] > m1) { m1 = el[e]; e1 = e; } }
                int e2 = 0; float m2 = -1e30f;
#pragma unroll
                for (int e = 0; e < 8; ++e) if (e != e1 && el[e] > m2) { m2 = el[e]; e2 = e; }
                const float p2 = expf(m2 - m1), inv = 1.f / (1.f + p2);
                const int E1 = gi * 8 + e1, E2 = gi * 8 + e2, lt = 32 * rd + F.tid, tk = grp * 64 + lt;
                const int r1 = __hip_atomic_fetch_add(LC + E1, 1, __ATOMIC_RELAXED, __HIP_MEMORY_SCOPE_WORKGROUP), r2 = __hip_atomic_fetch_add(LC + E2, 1, __ATOMIC_RELAXED, __HIP_MEMORY_SCOPE_WORKGROUP);
                PK[lt * 4] = E1; PK[lt * 4 + 1] = E2; PK[lt * 4 + 2] = r1; PK[lt * 4 + 3] = r2;
                pgate[tk * 2] = pg * inv; pgate[tk * 2 + 1] = pg * p2 * inv; rstd_g[tk] = rs;
            }
            __syncthreads();
        }
        if (F.tid < 64) { const int n = LC[F.tid]; LC[F.tid] = n ? (int)atomicAdd(cnt + 64 * F.tid, (unsigned)n) : 0; }
        __syncthreads();
        if (F.tid < 64) { const int E1 = PK[F.tid * 4], E2 = PK[F.tid * 4 + 1], tk = grp * 64 + F.tid;
            list[E1 * 16384 + LC[E1] + PK[F.tid * 4 + 2]] = tk * 2; list[E2 * 16384 + LC[E2] + PK[F.tid * 4 + 3]] = tk * 2 + 1; }
        __syncthreads();
    }
}
__device__ __forceinline__ int moe_tables(Frame& F) {
    LAS int* pstart = (LAS int*)(F.lds + LT_PSTART); LAS int* ptab = (LAS int*)(F.lds + LT_PTAB);
    if (F.tid < 64) { const int c = (int)__hip_atomic_load((unsigned*)(F.ctl + CW_CNT) + 64 * F.tid, RLX_AGENT); const int np = (c + 255) >> 8; int ps = np;
#pragma unroll
        for (int o = 1; o < 64; o <<= 1) { const int t = __shfl_up(ps, o); if (F.lane >= o) ps += t; }
        const int st = ps - np; pstart[F.tid] = st; if (F.tid == 63) pstart[64] = ps;
        for (int j = 0; j < np; ++j) ptab[st + j] = F.tid | (j << 8); }
    __syncthreads();
    return pstart[64];
}
__device__ __forceinline__ void p7_gather(Frame& F, int NP) {
    const LAS int* ptab = (const LAS int*)(F.lds + LT_PTAB);
    const int gw = F.vcu * NWAVES + F.wave, NGW = F.G * NWAVES, lane = F.lane;
    const bf16* h2u = (const bf16*)(F.ws + WS_HN); bf16* xs = (bf16*)(F.ws + WS_XS); const int* list = (const int*)(F.ws + WS_LIST);
    const unsigned* cnt = (const unsigned*)(F.ctl + CW_CNT);
#pragma unroll 1
    for (int rid = gw; rid < NP * 256; rid += NGW) { const int pt = ptab[rid >> 8], e = pt & 255, local = (pt >> 8) * 256 + (rid & 255);
        if (local < (int)cnt[64 * e]) { const int tok = list[e * 16384 + local] >> 1;
            const GAS v4u* src = (const GAS v4u*)(h2u + (size_t)tok * D); GAS v4u* dst = (GAS v4u*)(xs + (size_t)rid * D);
            const v4u a = src[lane], b = src[lane + 64]; dst[lane] = a; dst[lane + 64] = b; } }
}
constexpr int CW_PAN = 196608, PAN_NEED = 16;
template <bool GATHER_>
struct MoeOrderT {
    static constexpr bool GATHER = GATHER_;
    int nunits, G, c, SH; const LAS int* ptab; const int* list; const unsigned* cnt; unsigned rowbytes;
    unsigned* pan; int pmode;
    __device__ __forceinline__ unsigned row_off(const pg8::Unit& u, int r) const {
        const int pt = ptab[u.pm], e = pt & 255, local = (pt >> 8) * 256 + r;
        return local < (int)cnt[64 * e] ? (unsigned)(list[e * 16384 + local] >> 1) * rowbytes : 0u; }
    __device__ __forceinline__ bool next(int i, pg8::Unit& u) const { const int L = i * G + c; if (L >= nunits) return false; const int p = L >> SH; u.pm = p; u.pn = ((ptab[p] & 255) << SH) + (L & ((1 << SH) - 1)); return true; }
    __device__ __forceinline__ void a_ready(const pg8::Unit&) const {}
    __device__ __forceinline__ void wait_panels() const {
        if (threadIdx.x == 0) {
#pragma unroll 1
            for (int L = c; L < nunits; L += G) { unsigned sp = 0;
                while (__hip_atomic_load(pan + 64 * (L >> SH), RLX_AGENT) < (unsigned)PAN_NEED && ++sp < (1u << 22)) __builtin_amdgcn_s_sleep(16); } }
        __syncthreads();
        __builtin_amdgcn_fence(__ATOMIC_ACQUIRE, "agent");
    }
    __device__ __forceinline__ void done(const pg8::Unit& u) const {
        if (pmode == 1) { asm volatile("s_waitcnt vmcnt(0)" ::: "memory");
            if ((threadIdx.x & 63) == 0) __hip_atomic_fetch_add(pan + 64 * u.pm, 1u, __ATOMIC_RELAXED, __HIP_MEMORY_SCOPE_AGENT); } }
};
typedef MoeOrderT<false> MoeOrder; typedef MoeOrderT<true> MoeGatherOrder;
struct EpiSwiGLU {
    static constexpr bool PERM = true, AFTER_DRAIN = false;
    bf16* hmid; const int* list; const unsigned* cnt; const float* rstd; const LAS int* ptab;
    __device__ __forceinline__ void operator()(const pg8::f32x4 (&acc)[2][2][4][2], const pg8::Unit& u, int wr, int wc, int fr, int fq) const {
        const int pt = ptab[u.pm], e = pt & 255, lbase = (pt >> 8) * 256, n_e = (int)cnt[64 * e], pnl = u.pn & 1;
#pragma unroll
        for (int ai = 0; ai < 2; ++ai)
#pragma unroll
            for (int m = 0; m < 4; ++m) { const int rl = ai * 128 + wr * 64 + m * 16 + fr;
                if (lbase + rl < n_e) { const float rs = rstd[list[e * 16384 + lbase + rl] >> 1];
                    float h[8];
#pragma unroll
                    for (int n = 0; n < 2; ++n)
#pragma unroll
                        for (int k = 0; k < 4; ++k) h[4 * n + k] = silu_f(acc[ai][0][m][n][k] * rs) * (acc[ai][1][m][n][k] * rs);
                    v4u o; o.x = pk2(h[0], h[1]); o.y = pk2(h[2], h[3]); o.z = pk2(h[4], h[5]); o.w = pk2(h[6], h[7]);
                    store16_sc1<0>(hmid + (size_t)(u.pm * 256 + rl) * EFF + pnl * 128 + wc * 32 + 8 * fq, o); } }
    }
};
struct EpiDown {
    static constexpr bool PERM = true, AFTER_DRAIN = false;
    bf16* y2; const int* list; const unsigned* cnt; const float* gate; const LAS int* ptab;
    __device__ __forceinline__ void operator()(const pg8::f32x4 (&acc)[2][2][4][2], const pg8::Unit& u, int wr, int wc, int fr, int fq) const {
        const int pt = ptab[u.pm], e = pt & 255, lbase = (pt >> 8) * 256, n_e = (int)cnt[64 * e], pnl = u.pn & 3;
#pragma unroll
        for (int ai = 0; ai < 2; ++ai)
#pragma unroll
            for (int m = 0; m < 4; ++m) { const int rl = ai * 128 + wr * 64 + m * 16 + fr;
                if (lbase + rl < n_e) { const int pair = list[e * 16384 + lbase + rl]; const float g = gate[pair];
#pragma unroll
                    for (int bj = 0; bj < 2; ++bj) { const pg8::f32x4 v0 = acc[ai][bj][m][0] * g, v1 = acc[ai][bj][m][1] * g;
                        v4u o; o.x = pk2(v0[0], v0[1]); o.y = pk2(v0[2], v0[3]); o.z = pk2(v1[0], v1[1]); o.w = pk2(v1[2], v1[3]);
                        *(GAS v4u*)(y2 + (size_t)pair * D + pnl * 256 + bj * 128 + wc * 32 + 8 * fq) = o; } } }
    }
};
__device__ __forceinline__ void p10_final(Frame& F, const float* lnw, float* dst) {
    const int gw = F.vcu * NWAVES + F.wave, NGW = F.G * NWAVES, lane = F.lane;
    const bf16* y2 = (const bf16*)(F.ws + WS_Y2);
    f32x4 lw[4];
#pragma unroll
    for (int j = 0; j < 4; ++j) lw[j] = ((const f32x4*)lnw)[lane + 64 * j];
#pragma unroll 1
    for (int tok = gw; tok < T; tok += NGW) {
        GAS f32x4* xr = (GAS f32x4*)(F.out + (size_t)tok * D) + lane;
        const GAS v2u* ya = (const GAS v2u*)(y2 + (size_t)(2 * tok) * D) + lane; const GAS v2u* yb = (const GAS v2u*)(y2 + (size_t)(2 * tok + 1) * D) + lane;
        f32x4 v[4]; float s = 0.f;
#pragma unroll
        for (int j = 0; j < 4; ++j) { const f32x4 x = xr[64 * j]; const v2u a = ya[64 * j], b = yb[64 * j];
            v[j].x = x.x + (bf2f((unsigned short)(a.x & 0xffffu)) + bf2f((unsigned short)(b.x & 0xffffu))); v[j].y = x.y + (bf2f((unsigned short)(a.x >> 16)) + bf2f((unsigned short)(b.x >> 16)));
            v[j].z = x.z + (bf2f((unsigned short)(a.y & 0xffffu)) + bf2f((unsigned short)(b.y & 0xffffu))); v[j].w = x.w + (bf2f((unsigned short)(a.y >> 16)) + bf2f((unsigned short)(b.y >> 16)));
            s += (v[j].x * v[j].x + v[j].y * v[j].y) + (v[j].z * v[j].z + v[j].w * v[j].w); }
        const float r = rsqrtf(wave_sum(s) * (1.f / D) + EPS);
        GAS f32x4* xo = (GAS f32x4*)(dst + (size_t)tok * D) + lane;
#pragma unroll
        for (int j = 0; j < 4; ++j) xo[64 * j] = v[j] * r * lw[j];
    }
}
struct EpiResF32 {
    static constexpr bool PERM = false, AFTER_DRAIN = false;
    const float* base; float* out; int ldc;
    __device__ __forceinline__ void operator()(const pg8::f32x4 (&acc)[2][2][4][2], const pg8::Unit& u, int wr, int wc, int fr, int fq) const {
        const int col0 = u.pn * 256 + wc * 32 + 4 * fq;
#pragma unroll
        for (int ai = 0; ai < 2; ++ai)
#pragma unroll
            for (int m = 0; m < 4; ++m) { const size_t off = (size_t)(u.pm * 256 + ai * 128 + wr * 64 + m * 16 + fr) * ldc + col0;
#pragma unroll
                for (int bj = 0; bj < 2; ++bj)
#pragma unroll
                    for (int n = 0; n < 2; ++n) { const pg8::f32x4 bs = *(const pg8::f32x4*)(base + off + bj * 128 + n * 16); *(pg8::f32x4*)(out + off + bj * 128 + n * 16) = bs + acc[ai][bj][m][n]; }
                if (m & 1) asm volatile("" ::: "memory"); }
    }
};
struct Args { const float* in[17]; float* out; unsigned char* ws; int ph_lo, ph_hi, li, pad; };
__global__ void __launch_bounds__(NTHR, 2) mk_fwd(Args args) {
    extern __shared__ __attribute__((aligned(16))) unsigned char lds[];
    Frame F;
    F.lds = (LAS unsigned char*)lds;
    F.MISC = (volatile LAS unsigned*)(F.lds + MISC_OFF);
    F.tid = threadIdx.x; F.lane = F.tid & 63; F.wave = __builtin_amdgcn_readfirstlane(F.tid >> 6);
    F.G = gridDim.x; { const int bx = blockIdx.x; F.vcu = (F.G % 8 == 0) ? (bx % 8) * (F.G / 8) + bx / 8 : bx; }
    F.ws = args.ws; F.out = args.out; F.li = args.li; F.ctl = (gu32*)(args.ws + WS_CTL);
    for (int u = F.tid; u < (LDS_BYTES - LDSCTL_OFF) / 4; u += NTHR) ((LAS unsigned*)(F.lds + LDSCTL_OFF))[u] = 0u;
    __syncthreads();
    XcdBarrier bar = xcd_barrier_post((unsigned*)(F.ctl + CW_BAR) + args.li * XCD_BAR_WORDS, F.MISC + 8);
    const int lo = args.ph_lo, hi = args.ph_hi;
#define IN(k) (lo <= (k) && (k) < hi)
#define BOTH(k) (IN(k) && IN((k) + 1))
#define GRID_BAR() xcd_barrier(bar)
#define PHASE_BEGIN() do { int t_ = threadIdx.x; asm volatile("" : "+v"(t_)); F.tid = t_; F.lane = t_ & 63; } while (0)
    if (IN(0)) { PHASE_BEGIN(); p0_prologue(F, args.in[I_X], args.in[I_LNMIX], args.in[I_WIN], args.in[I_WOUT], args.in[I_ALOG], args.in[I_DTB]); p0_rot_table(F); p0_router_weights(F, args.in[I_LNFFN], args.in[I_WG], args.in[I_WE]); if (BOTH(0)) GRID_BAR(); }
    if (IN(1)) { PHASE_BEGIN();
        pg8::Gemm g{(const bf16*)(F.ws + WS_HN), (const bf16*)(F.ws + WS_WIN), T, NPROJ, D}; pg8::StaticOrder S; S.init(T, NPROJ, F.G, (int)blockIdx.x);
        pg8::EpiBf16<0> E{(bf16*)(F.ws + WS_PROJ), NPROJ, nullptr, 0, 0, 1.f};
        pg8::gemm_phase<pg8::EpiBf16<0>, pg8::StaticOrder, true, true>(F.lds, g, S, E);
        if (BOTH(1)) GRID_BAR();
    }
    if (IN(2)) { PHASE_BEGIN();
#pragma unroll 1
        for (int grp = blockIdx.x; grp < 256; grp += F.G) p2_group(F, grp, args.in[I_CONV], (const float*)(F.ws + WS_BG));
        if (BOTH(2)) GRID_BAR();
    }
    if (IN(3) || IN(17) || IN(18)) { PHASE_BEGIN(); const int skipq = IN(17) ? 1 : IN(18) ? 3 : 0;
        const int x = blockIdx.x;
        if (x < 32) p3_scan(F, (x & 7) + 8 * (x >> 4), (x >> 3) & 1, 0);
        {
            LAS int* wq = (LAS int*)(F.lds + LT_WQ);
#pragma unroll 1
            for (;;) {
                if (F.tid == 0) *wq = (int)atomicAdd((unsigned*)(F.ctl + CW_WQ + 64 * F.li), 1u);
                __syncthreads();
                const int it = *wq;
                __syncthreads();
                if (it >= 512 + 384 + 480 + 256) break;
                if (it < 384) { if (!(skipq & 1)) p3_moe_weight_items(F, it * 64 + F.wave, NWAVES, it * 64 + 64, args.in[I_WGU], args.in[I_WD]); }
                else if (it < 384 + 512) { if (!(skipq & 2)) p3_attn_unit(F, it - 384, args.in[I_SINK]); }
                else { const int ob = it - (512 + 384); if (ob < 480) p3_out_batch(F, ob * 8, 8, F.out); else p3_out_batch(F, 3840 + (ob - 480), 1, F.out); }
            }
        }
        if (BOTH(3)) GRID_BAR();
    }
    if (IN(4)) { PHASE_BEGIN(); p4_combine(F, F.out, args.in[I_DNNORM]); if (BOTH(4)) GRID_BAR(); }
    if (IN(5)) { PHASE_BEGIN();
        pg8::Gemm g{(const bf16*)(F.ws + WS_MIX), (const bf16*)(F.ws + WS_WOUT), T, D, D}; pg8::StaticOrder S; S.init(T, D, F.G, (int)blockIdx.x);
        EpiResF32 E{args.in[I_X], F.out, D};
        pg8::gemm_phase<EpiResF32, pg8::StaticOrder, true, true>(F.lds, g, S, E);
        if (BOTH(5)) GRID_BAR();
    }
    if (IN(6) || IN(12)) { PHASE_BEGIN(); p6_route(F, args.in[I_LNFFN], args.in[I_BG], args.in[I_BE], IN(12) ? 1 : 0); if (BOTH(6)) GRID_BAR(); }
    if (IN(8)) { PHASE_BEGIN();
        const int NP = moe_tables(F);
        pg8::Gemm g{(const bf16*)(F.ws + WS_HN), (const bf16*)(F.ws + WS_WGU), NP * 256, NEXP * 512, D};
        MoeGatherOrder S{NP * 2, F.G, (int)blockIdx.x, 1, (const LAS int*)(F.lds + LT_PTAB), (const int*)(F.ws + WS_LIST), (const unsigned*)(F.ctl + CW_CNT), (unsigned)(D * 2), (unsigned*)(F.ctl + CW_PAN), 1};
        EpiSwiGLU E{(bf16*)(F.ws + WS_HMID), (const int*)(F.ws + WS_LIST), (const unsigned*)(F.ctl + CW_CNT), (const float*)(F.ws + RW_RSTD), (const LAS int*)(F.lds + LT_PTAB)};
        pg8::gemm_phase<EpiSwiGLU, MoeGatherOrder, true, true>(F.lds, g, S, E);
    }
    if (IN(9)) { PHASE_BEGIN();
        const int NP = moe_tables(F);
        pg8::Gemm g{(const bf16*)(F.ws + WS_HMID), (const bf16*)(F.ws + WS_WD), NP * 256, NEXP * D, EFF};
        int r8 = NP * 2 - F.G; r8 = r8 < 0 ? 0 : r8; const int pe4 = (NP < F.G / 2 ? NP : F.G / 2) * 4, bx = (int)blockIdx.x;
        const bool late = r8 > 0 && bx < r8 && r8 < F.G;
        MoeOrder S{late ? NP * 4 : (r8 > 0 && r8 < F.G ? pe4 : NP * 4), late ? r8 : (r8 > 0 && r8 < F.G ? F.G - r8 : F.G), late ? pe4 + bx : (r8 > 0 && r8 < F.G ? bx - r8 : bx), 2,
                   (const LAS int*)(F.lds + LT_PTAB), nullptr, nullptr, 0u, (unsigned*)(F.ctl + CW_PAN), 0};
        S.wait_panels();
        EpiDown E{(bf16*)(F.ws + WS_Y2), (const int*)(F.ws + WS_LIST), (const unsigned*)(F.ctl + CW_CNT), (const float*)(F.ws + RW_GATE), (const LAS int*)(F.lds + LT_PTAB)};
        pg8::gemm_phase<EpiDown, MoeOrder, true, true>(F.lds, g, S, E);
        if (BOTH(9)) GRID_BAR();
    }
#ifdef PROBE_PHASES
    if (IN(11) || IN(14) || IN(15) || IN(16)) { PHASE_BEGIN(); const int x = blockIdx.x; if (x < 32) p3_scan(F, (x & 7) + 8 * (x >> 4), (x >> 3) & 1, IN(14) ? 1 : IN(15) ? 3 : IN(16) ? 5 : 0); }
#endif
    if (IN(10) || IN(13)) { PHASE_BEGIN(); p10_final(F, args.in[I_LNF], IN(13) ? (float*)(F.ws + WS_PROJ) : F.out); }
#undef IN
#undef BOTH
}

__global__ void k_shim_proj(const bf16* __restrict__ pb, float* __restrict__ pf) {
    const size_t i = (size_t)blockIdx.x * blockDim.x + threadIdx.x; if (i >= (size_t)T * NPROJ) return;
    const int tok = (int)(i / NPROJ), c = (int)(i % NPROJ);
    pf[(size_t)tok * INW + (c < 2048 ? c : c + 16)] = bf2f(pb[i]);
}
}

extern "C" void kernel_launch(void* const* d_in, const int* in_sizes, int n_in, void* d_out, int out_size, void* d_ws, size_t ws_size, hipStream_t stream) {
    using namespace mk;
    static int grid = 0;
    if (grid == 0) {
        if (n_in != 17 || out_size != T * D || ws_size < 511 * MiB) { fprintf(stderr, "kernel_launch: unexpected sizes (n_in %d out %d ws %zu)\n", n_in, out_size, ws_size); grid = -1; return; }
        int dev = 0, cus = 0, per_cu = 0;
        if (hipGetDevice(&dev) != hipSuccess || hipDeviceGetAttribute(&cus, hipDeviceAttributeMultiprocessorCount, dev) != hipSuccess) { grid = -1; return; }
        if (hipFuncSetAttribute((const void*)mk_fwd, hipFuncAttributeMaxDynamicSharedMemorySize, LDS_BYTES) != hipSuccess) { fprintf(stderr, "kernel_launch: hipFuncSetAttribute failed\n"); grid = -1; return; }
        if (hipOccupancyMaxActiveBlocksPerMultiprocessor(&per_cu, (const void*)mk_fwd, NTHR, LDS_BYTES) != hipSuccess || per_cu < 1) { fprintf(stderr, "kernel_launch: occupancy query says %d blocks/CU\n", per_cu); grid = -1; (void)hipGetLastError(); return; }
        grid = cus;
    }
    if (grid < 0) return;
    (void)hipMemsetAsync((char*)d_ws + WS_CTL, 0, CTL_ZERO_BYTES, stream);
    Args a{};
    for (int i = 0; i < 17; ++i) a.in[i] = (const float*)d_in[i];
    a.out = (float*)d_out; a.ws = (unsigned char*)d_ws; a.pad = 0;
#ifndef LAUNCH_PLAN
#define LAUNCH_PLAN {0, 11}
#endif
    const int plan[] = LAUNCH_PLAN; const int nl = (int)(sizeof(plan) / sizeof(int)) / 2;
    for (int li = 0; li < nl; ++li) {
        a.ph_lo = plan[2 * li]; a.ph_hi = plan[2 * li + 1]; a.li = li;
        void* kargs[] = {&a};
        hipError_t e = hipLaunchCooperativeKernel((const void*)mk_fwd, dim3(grid), dim3(NTHR), kargs, LDS_BYTES, stream);
        if (e != hipSuccess) { fprintf(stderr, "cooperative launch failed: %s (grid %d)\n", hipGetErrorString(e), grid); return; }
    }
}
```

```cpp
#include <hip/hip_runtime.h>
#include <cstdint>
#include <cstdio>
namespace pg8 {
#define PG8_LAS __attribute__((address_space(3)))
typedef unsigned short bf16_t;
typedef short bf16x8 __attribute__((ext_vector_type(8)));
typedef float f32x4 __attribute__((ext_vector_type(4)));
typedef unsigned u32x4 __attribute__((ext_vector_type(4)));
constexpr int BM = 256, BK = 64, HALF = 128, HTB = HALF * BK * 2  , STAGE_BYTES = 8 * HTB, NXCD = 8, WGM = 8;

__host__ __device__ __forceinline__ int lds_byte(int r, int c) { const int st = (r >> 4) * 2 + (c >> 5), rr = r & 15, cc = c & 31, ob = rr * 64 + cc * 2; return st * 1024 + (ob ^ (((ob >> 9) & 1) << 5)); }
__host__ __device__ __forceinline__ void stage_rc(int b, int& R, int& C) { const int st = b / 1024, sb = b % 1024, swz = sb ^ (((sb >> 9) & 1) << 5); R = (st >> 1) * 16 + swz / 64; C = (st & 1) * 32 + (swz % 64) / 2; }
__host__ __device__ __forceinline__ int perm32(int rho) { const int n = rho >> 4, i = rho & 15; return 8 * (i >> 2) + 4 * n + (i & 3); }

struct Unit { int pm, pn; };
struct Gemm { const bf16_t* A; const bf16_t* Bt; int M, N, K; };

struct StaticOrder {
    static constexpr bool GATHER = false;
    int nM, nN, nwg, G, c;
    __device__ __forceinline__ unsigned row_off(const Unit&, int) const { return 0u; }
    __host__ __device__ void init(int M, int N, int G_, int c_) { nM = M / BM; nN = N / BM; nwg = nM * nN; G = G_; c = c_; }
    __host__ __device__ bool next(int i, Unit& u) const {
        const long L = (long)i * G + c; if (L >= nwg) return false;
        int wgid = (int)L; { const int q = nwg / NXCD, r = nwg % NXCD, xcd = wgid % NXCD, off = wgid / NXCD; wgid = (xcd < r ? xcd * (q + 1) : r * (q + 1) + (xcd - r) * q) + off; }
        const int nig = WGM * nN, gid = wgid / nig, fm = gid * WGM, gsz = (nM - fm) < WGM ? (nM - fm) : WGM;
        u.pm = fm + ((wgid % nig) % gsz); u.pn = (wgid % nig) / gsz; return true;
    }
    __device__ __forceinline__ void a_ready(const Unit&) const {}
    __device__ __forceinline__ void done(const Unit&) const {}
};

__device__ __forceinline__ unsigned cvt_pk_bf16(float lo, float hi) { unsigned r; asm volatile("v_cvt_pk_bf16_f32 %0, %1, %2" : "=v"(r) : "v"(lo), "v"(hi)); return r; }
typedef float f32x2 __attribute__((ext_vector_type(2)));
__device__ __forceinline__ f32x2 gelu_pk(f32x2 v) {
    const f32x2 av = __builtin_elementwise_abs(v), d = av * 0.2316418882f + 1.0f;
    f32x2 t; t.x = __builtin_amdgcn_rcpf(d.x); t.y = __builtin_amdgcn_rcpf(d.y);
    f32x2 q = t * 0.5307027145f + (-0.7265760135f); q = q * t + 0.7107068705f; q = q * t + (-0.142248368f); q = q * t + 0.127414796f; q = q * t;
    const f32x2 s = (v * v) * (-0.72134752044f);
    f32x2 e; e.x = __builtin_amdgcn_exp2f(s.x); e.y = __builtin_amdgcn_exp2f(s.y);
    const f32x2 m = v * (q * e), r = v - m;
    f32x2 o; o.x = v.x < 0.f ? m.x : r.x; o.y = v.y < 0.f ? m.y : r.y; return o;
}

template <int ACT  > struct EpiBf16 {
    static constexpr bool PERM = true, AFTER_DRAIN = false; static_assert(ACT == 0 || ACT == 1, "EpiBf16: ACT is 0 (none) or 1 (gelu_pk)");
    bf16_t* O; int ldc; const float* bias; int split_cols; size_t split_stride; float scale0;
    __device__ __forceinline__ void operator()(const f32x4 (&acc)[2][2][4][2], const Unit& u, int wr, int wc, int fr, int fq) const {
        const int row0 = u.pm * BM + wr * 64 + fr; int colt = u.pn * BM; bf16_t* base = O;
        float sc = 1.f; if (split_cols) { const int t = colt / split_cols; base += (size_t)t * split_stride; colt -= t * split_cols; if (t == 0) sc = scale0; }
        const int col0 = colt + wc * 32 + 8 * fq, bcol0 = u.pn * BM + wc * 32 + 8 * fq;
        f32x4 bv[2][2];
#pragma unroll
        for (int bj = 0; bj < 2; ++bj)
#pragma unroll
            for (int n = 0; n < 2; ++n) bv[bj][n] = bias ? *(const f32x4*)(bias + bcol0 + bj * HALF + 4 * n) : (f32x4){0.f, 0.f, 0.f, 0.f};
#pragma unroll
        for (int ai = 0; ai < 2; ++ai)
#pragma unroll
            for (int m = 0; m < 4; ++m) { bf16_t* rowp = base + (size_t)(row0 + ai * HALF + m * 16) * ldc + col0;
#pragma unroll
                for (int bj = 0; bj < 2; ++bj) { f32x4 v0 = acc[ai][bj][m][0] + bv[bj][0], v1 = acc[ai][bj][m][1] + bv[bj][1];
                    if (ACT == 1) { f32x2 a = gelu_pk((f32x2){v0[0], v0[1]}), b = gelu_pk((f32x2){v0[2], v0[3]}), c = gelu_pk((f32x2){v1[0], v1[1]}), d = gelu_pk((f32x2){v1[2], v1[3]});
                        v0 = (f32x4){a.x, a.y, b.x, b.y}; v1 = (f32x4){c.x, c.y, d.x, d.y}; }
                    v0 = v0 * sc; v1 = v1 * sc; u32x4 w; w.x = cvt_pk_bf16(v0[0], v0[1]); w.y = cvt_pk_bf16(v0[2], v0[3]); w.z = cvt_pk_bf16(v1[0], v1[1]); w.w = cvt_pk_bf16(v1[2], v1[3]);
                    *(u32x4*)(rowp + bj * HALF) = w; } }
    }
};
template <class Epi, class Sched, bool ALIGN_EPI = false, bool SP2 = false>
__device__ __forceinline__ void gemm_phase(PG8_LAS unsigned char* lds, const Gemm g, const Sched& S, const Epi& E) {
    const int tid = threadIdx.x, wid = __builtin_amdgcn_readfirstlane(tid >> 6), lane = tid & 63, wr = wid >> 2, wc = wid & 3, fr = lane & 15, fq = lane >> 4;
    const int K = g.K, nt = K / BK;
    unsigned voffA[2], voffB[2];
    constexpr bool GATHER = Sched::GATHER;
    unsigned gA[2][2], nGA[2][2]; int rowA[2], colA[2];
#pragma unroll
    for (int i = 0; i < 2; ++i) { int R, C; stage_rc(tid * 16 + i * 8192, R, C); const int Rb = Epi::PERM ? ((R & ~31) + perm32(R & 31)) : R;
        voffA[i] = (unsigned)(R * K + C) * 2u; voffB[i] = (unsigned)(Rb * K + C) * 2u; rowA[i] = R; colA[i] = C; }
    const size_t kstep = (size_t)(BK * 2);
    const size_t hstep = (size_t)HALF * K * 2;
    const size_t tstep = 2 * hstep;
    const size_t hstepA = GATHER ? 0 : hstep, tstepA = GATHER ? 0 : tstep;
    const unsigned ldsw = (unsigned)wid * 1024u;
    const int aoff = lds_byte(wr * 64 + fr, fq * 8), boff = lds_byte(wc * 32 + fr, fq * 8);
#define PG8_SA(b, h) (((b) * 2 + (h)) * HTB)
#define PG8_SB(b, h) ((4 + (b) * 2 + (h)) * HTB)
#define PG8_STAGE(bufoff, gbase, voff) do { _Pragma("unroll") for (int _i = 0; _i < 2; ++_i) \
        __builtin_amdgcn_global_load_lds((const unsigned*)((const char*)(gbase) + (voff)[_i]), (PG8_LAS unsigned*)(lds + (bufoff) + ldsw + _i * 8192), 16, 0, 0); } while (0)
#define PG8_STAGE_A(bufoff, gbase, h, nx) do { if constexpr (GATHER) { if (nx) PG8_STAGE(bufoff, gbase, nGA[h]); else PG8_STAGE(bufoff, gbase, gA[h]); } else PG8_STAGE(bufoff, gbase, voffA); } while (0)
#define PG8_GOFF(dst, unit) do { if constexpr (GATHER) { _Pragma("unroll") for (int h_ = 0; h_ < 2; ++h_) _Pragma("unroll") for (int i_ = 0; i_ < 2; ++i_) dst[h_][i_] = S.row_off(unit, h_ * HALF + rowA[i_]) + (unsigned)colA[i_] * 2u; \
        asm volatile("s_waitcnt vmcnt(0)" : "+v"(dst[0][0]), "+v"(dst[0][1]), "+v"(dst[1][0]), "+v"(dst[1][1]) :: "memory"); } } while (0)
#define PG8_LDA(dst, b, h) do { _Pragma("unroll") for (int m = 0; m < 4; ++m) _Pragma("unroll") for (int k = 0; k < 2; ++k) dst[m][k] = *(const PG8_LAS bf16x8*)(lds + PG8_SA(b, h) + aoff + m * 2048 + k * 1024); } while (0)
#define PG8_LDB(dst, b, h) do { _Pragma("unroll") for (int n = 0; n < 2; ++n) _Pragma("unroll") for (int k = 0; k < 2; ++k) dst[n][k] = *(const PG8_LAS bf16x8*)(lds + PG8_SB(b, h) + boff + n * 2048 + k * 1024); } while (0)
#define PG8_MMA(ai, bj, At, Bt) do { __builtin_amdgcn_s_setprio(1); _Pragma("unroll") for (int m = 0; m < 4; ++m) _Pragma("unroll") for (int n = 0; n < 2; ++n) _Pragma("unroll") for (int k = 0; k < 2; ++k) \
        acc[ai][bj][m][n] = __builtin_amdgcn_mfma_f32_16x16x32_bf16(Bt[n][k], At[m][k], acc[ai][bj][m][n], 0, 0, 0); __builtin_amdgcn_s_setprio(0); } while (0)
#define PG8_WAIT_V(n) asm volatile("s_waitcnt vmcnt(" #n ")" ::: "memory")
#define PG8_WAIT_L(n) asm volatile("s_waitcnt lgkmcnt(" #n ")" ::: "memory")
#define PG8_BAR __builtin_amdgcn_s_barrier()
#define PG8_SCHED __builtin_amdgcn_sched_barrier(0)
    Unit cur, nxt; int ui = 0;
    if (!S.next(0, cur)) return;
    f32x4 acc[2][2][4][2];
#pragma unroll
    for (int a = 0; a < 2; ++a)
#pragma unroll
        for (int b = 0; b < 2; ++b)
#pragma unroll
            for (int m = 0; m < 4; ++m)
#pragma unroll
                for (int n = 0; n < 2; ++n) acc[a][b][m][n] = (f32x4){0.f, 0.f, 0.f, 0.f};
    bf16x8 At[4][2], B0[2][2], B1[2][2];
    const char* cA = (const char*)g.A + (size_t)cur.pm * tstepA; const char* cB = (const char*)g.Bt + (size_t)cur.pn * tstep;
    PG8_GOFF(gA, cur);
    S.a_ready(cur);
    if constexpr (SP2) {
        PG8_STAGE(PG8_SB(0, 0), cB, voffB); PG8_STAGE(PG8_SB(0, 1), cB + hstep, voffB); PG8_STAGE_A(PG8_SA(0, 0), cA, 0, false); PG8_STAGE_A(PG8_SA(0, 1), cA + hstepA, 1, false);
        if (wr == 1) PG8_BAR;
        PG8_WAIT_V(2); PG8_BAR;
        PG8_STAGE(PG8_SB(1, 0), cB + kstep, voffB); PG8_STAGE_A(PG8_SA(1, 0), cA + kstep, 0, false); PG8_STAGE(PG8_SB(1, 1), cB + hstep + kstep, voffB);
        PG8_WAIT_V(6); PG8_BAR;
    } else {
        PG8_STAGE(PG8_SB(0, 0), cB, voffB); PG8_STAGE_A(PG8_SA(0, 0), cA, 0, false); PG8_STAGE(PG8_SB(0, 1), cB + hstep, voffB); PG8_STAGE_A(PG8_SA(0, 1), cA + hstepA, 1, false);
        if (wr == 1) PG8_BAR;
        PG8_WAIT_V(4); PG8_BAR;
        PG8_STAGE(PG8_SB(1, 0), cB + kstep, voffB); PG8_STAGE_A(PG8_SA(1, 0), cA + kstep, 0, false); PG8_STAGE(PG8_SB(1, 1), cB + hstep + kstep, voffB);
        PG8_WAIT_V(6); PG8_BAR;
    }
    for (;;) {
        const bool has_next = S.next(ui + 1, nxt);
        if constexpr (GATHER) { if (has_next) PG8_GOFF(nGA, nxt); else { _Pragma("unroll") for (int h_ = 0; h_ < 2; ++h_) _Pragma("unroll") for (int i_ = 0; i_ < 2; ++i_) nGA[h_][i_] = gA[h_][i_]; } }
        const char* nA = has_next ? (const char*)g.A + (size_t)nxt.pm * tstepA : cA; const char* nB = has_next ? (const char*)g.Bt + (size_t)nxt.pn * tstep : cB;
        for (int t = 0; t < nt; t += 2) {
            const bool last = (t == nt - 2);
            const char* a1 = cA + (size_t)(t + 1) * kstep;
            const char* a2 = last ? nA : cA + (size_t)(t + 2) * kstep; const char* b2 = last ? nB : cB + (size_t)(t + 2) * kstep;
            const char* a3 = a2 + kstep; const char* b3 = b2 + kstep;
            if (last && has_next) S.a_ready(nxt);
            if constexpr (SP2) {
            PG8_LDB(B0, 0, 0); PG8_LDB(B1, 0, 1); PG8_SCHED; PG8_LDA(At, 0, 0); PG8_STAGE_A(PG8_SA(1, 1), a1 + hstepA, 1, false);
            PG8_WAIT_V(8); PG8_WAIT_L(0); PG8_BAR; PG8_MMA(0, 0, At, B0); PG8_MMA(0, 1, At, B1); PG8_BAR; PG8_SCHED;
            PG8_LDA(At, 0, 1); PG8_STAGE(PG8_SB(0, 0), b2, voffB); PG8_STAGE(PG8_SB(0, 1), b2 + hstep, voffB); PG8_STAGE_A(PG8_SA(0, 0), a2, 0, last);
            PG8_WAIT_V(8); PG8_WAIT_L(0); PG8_BAR; PG8_MMA(1, 0, At, B0); PG8_MMA(1, 1, At, B1); PG8_BAR; PG8_SCHED;
            PG8_LDB(B0, 1, 0); PG8_LDB(B1, 1, 1); PG8_SCHED; PG8_LDA(At, 1, 0); PG8_STAGE_A(PG8_SA(0, 1), a2 + hstepA, 1, last);
            PG8_WAIT_V(8); PG8_WAIT_L(0); PG8_BAR; PG8_MMA(0, 0, At, B0); PG8_MMA(0, 1, At, B1); PG8_BAR; PG8_SCHED;
            PG8_LDA(At, 1, 1); PG8_STAGE(PG8_SB(1, 0), b3, voffB); PG8_STAGE(PG8_SB(1, 1), b3 + hstep, voffB); PG8_STAGE_A(PG8_SA(1, 0), a3, 0, last);
            PG8_WAIT_V(8); PG8_WAIT_L(0); PG8_BAR; PG8_MMA(1, 0, At, B0); PG8_MMA(1, 1, At, B1); PG8_BAR; PG8_SCHED;
            } else {
            PG8_LDB(B0, 0, 0); PG8_SCHED; PG8_LDA(At, 0, 0); PG8_STAGE_A(PG8_SA(1, 1), a1 + hstepA, 1, false);
            PG8_WAIT_L(8); PG8_BAR; PG8_WAIT_L(0); PG8_MMA(0, 0, At, B0); PG8_BAR; PG8_SCHED;
            PG8_LDB(B1, 0, 1); PG8_STAGE(PG8_SB(0, 0), b2, voffB);
            PG8_BAR; PG8_WAIT_L(0); PG8_MMA(0, 1, At, B1); PG8_BAR;
            PG8_LDA(At, 0, 1); PG8_STAGE_A(PG8_SA(0, 0), a2, 0, last);
            PG8_BAR; PG8_WAIT_L(0); PG8_MMA(1, 0, At, B0); PG8_BAR; PG8_SCHED;
            PG8_STAGE(PG8_SB(0, 1), b2 + hstep, voffB);
            PG8_WAIT_V(6); PG8_BAR; PG8_MMA(1, 1, At, B1); PG8_BAR;
            PG8_LDB(B0, 1, 0); PG8_SCHED; PG8_LDA(At, 1, 0); PG8_STAGE_A(PG8_SA(0, 1), a2 + hstepA, 1, last);
            PG8_WAIT_L(8); PG8_BAR; PG8_WAIT_L(0); PG8_MMA(0, 0, At, B0); PG8_BAR; PG8_SCHED;
            PG8_LDB(B1, 1, 1); PG8_STAGE(PG8_SB(1, 0), b3, voffB);
            PG8_BAR; PG8_WAIT_L(0); PG8_MMA(0, 1, At, B1); PG8_BAR;
            PG8_LDA(At, 1, 1); PG8_STAGE_A(PG8_SA(1, 0), a3, 0, last);
            PG8_BAR; PG8_WAIT_L(0); PG8_MMA(1, 0, At, B0); PG8_BAR; PG8_SCHED;
            PG8_STAGE(PG8_SB(1, 1), b3 + hstep, voffB);
            PG8_WAIT_V(6); PG8_BAR; PG8_MMA(1, 1, At, B1); PG8_BAR;
            }
        }
        if constexpr (ALIGN_EPI) { if (wr == 0) PG8_BAR; }
        if constexpr (!Epi::AFTER_DRAIN) { E(acc, cur, wr, wc, fr, fq); S.done(cur); }
        if (!has_next) break;
#pragma unroll
        for (int a = 0; a < 2; ++a)
#pragma unroll
            for (int b = 0; b < 2; ++b)
#pragma unroll
                for (int m = 0; m < 4; ++m)
#pragma unroll
                    for (int n = 0; n < 2; ++n) acc[a][b][m][n] = (f32x4){0.f, 0.f, 0.f, 0.f};
        cur = nxt; cA = nA; cB = nB; ++ui;
        if constexpr (GATHER) { _Pragma("unroll") for (int h_ = 0; h_ < 2; ++h_) _Pragma("unroll") for (int i_ = 0; i_ < 2; ++i_) gA[h_][i_] = nGA[h_][i_]; }
        if constexpr (ALIGN_EPI) { if (wr == 1) PG8_BAR; }
    }
    PG8_WAIT_V(0);
    if constexpr (!ALIGN_EPI) { if (wr == 0) PG8_BAR; }
    PG8_BAR;
    if constexpr (Epi::AFTER_DRAIN) { E.fused(acc, cur, wr, wc, fr, fq, lds, wid, lane); S.done(cur); }
#undef PG8_SA
#undef PG8_SB
#undef PG8_STAGE
#undef PG8_STAGE_A
#undef PG8_GOFF
#undef PG8_LDA
#undef PG8_LDB
#undef PG8_MMA
#undef PG8_WAIT_V
#undef PG8_WAIT_L
#undef PG8_BAR
#undef PG8_SCHED
}
}
namespace mk {
constexpr int D = 1024, BATCH = 2, SEQ = 8192, T = BATCH * SEQ;
constexpr int INW = 2832, NPROJ = 2816;
constexpr int PJ_Q = 0, PJ_K = 512, PJ_V = 1024, PJ_Z = 1536, PJ_AQ = 2048, PJ_AK = 2560, PJ_AV = 2688;
constexpr int NEXP = 64, EFF = 256;
constexpr float EPS = 1e-6f;
constexpr int NWAVES = 8, NTHR = 512;
constexpr size_t MiB = 1u << 20;
constexpr size_t WS_CTL = 0, CTL_ZERO_BYTES = 1 * MiB;
constexpr size_t WS_WIN = 1 * MiB, WS_WOUT = 7 * MiB, WS_WGU = 9 * MiB, WS_WD = 73 * MiB;
constexpr size_t WS_HN = 105 * MiB, WS_BG = 137 * MiB, WS_MISC = 138 * MiB, WS_PROJ = 144 * MiB;
constexpr size_t WS_DN = 232 * MiB, WS_MIX = 456 * MiB, WS_END = 488 * MiB;
constexpr int CW_BAR = 4096;
constexpr int LDS_BYTES = 163840, RING_BYTES = 159744, LDSCTL_OFF = RING_BYTES, MISC_OFF = LDSCTL_OFF + 320;

#define GAS __attribute__((address_space(1)))
#define LAS __attribute__((address_space(3)))
typedef unsigned short bf16;
typedef unsigned v4u __attribute__((ext_vector_type(4)));
typedef float f32x4 __attribute__((ext_vector_type(4)));
typedef GAS unsigned gu32;
#define RLX_AGENT __ATOMIC_RELAXED, __HIP_MEMORY_SCOPE_AGENT
#define LDS_WAIT() asm volatile("s_waitcnt lgkmcnt(0)" ::: "memory")
#define VM_WAIT() asm volatile("s_waitcnt vmcnt(0)" ::: "memory")
__device__ __forceinline__ unsigned f2bf(float f) { unsigned u = __builtin_bit_cast(unsigned, f); return (u + 0x7fffu + ((u >> 16) & 1u)) >> 16; }
typedef float f32x2_t __attribute__((ext_vector_type(2))); typedef __bf16 bf16x2_t __attribute__((ext_vector_type(2)));
__device__ __forceinline__ unsigned pk2(float lo, float hi) { f32x2_t v = {lo, hi}; bf16x2_t b = __builtin_convertvector(v, bf16x2_t); return __builtin_bit_cast(unsigned, b); }
__device__ __forceinline__ float bf2f(unsigned short b) { return __builtin_bit_cast(float, (unsigned)b << 16); }
__device__ __forceinline__ float wave_sum(float v) {
#pragma unroll
    for (int o = 1; o < 64; o <<= 1) v += __shfl_xor(v, o);
    return v;
}
__device__ __forceinline__ float reduce16(float (&v)[16], int lane) {
    { const bool h = (lane & 32) != 0;
#pragma unroll
      for (int i = 0; i < 8; ++i) { const float keep = h ? v[i + 8] : v[i], send = h ? v[i] : v[i + 8]; v[i] = keep + __shfl_xor(send, 32); } }
    { const bool h = (lane & 16) != 0;
#pragma unroll
      for (int i = 0; i < 4; ++i) { const float keep = h ? v[i + 4] : v[i], send = h ? v[i] : v[i + 4]; v[i] = keep + __shfl_xor(send, 16); } }
    { const bool h = (lane & 8) != 0;
#pragma unroll
      for (int i = 0; i < 2; ++i) { const float keep = h ? v[i + 2] : v[i], send = h ? v[i] : v[i + 2]; v[i] = keep + __shfl_xor(send, 8); } }
    { const bool h = (lane & 4) != 0; const float keep = h ? v[1] : v[0], send = h ? v[0] : v[1]; v[0] = keep + __shfl_xor(send, 4); }
    v[0] += __shfl_xor(v[0], 2); v[0] += __shfl_xor(v[0], 1);
    return v[0];
}
__device__ __forceinline__ float silu_f(float x) { return x / (1.f + __expf(-x)); }
__device__ __forceinline__ float softplus_f(float x) { return fmaxf(x, 0.f) + log1pf(expf(-fabsf(x))); }

#define XB_TMO      128
#define XB_XCNT(j)  (256  + 64 * (j))
#define XB_XSUB(j)  (1280 + 64 * (j))
#define XB_XGEN(j)  (2304 + 64 * (j))
#define XB_TOP      3328
#define XB_TOPGEN   3392
#define XCD_BAR_WORDS 3456
#define XB_SPIN_CAP (1u << 22)
__device__ __forceinline__ unsigned xb_ld(unsigned* p)              { return __hip_atomic_load(p, __ATOMIC_RELAXED, __HIP_MEMORY_SCOPE_AGENT); }
__device__ __forceinline__ unsigned xb_add(unsigned* p, unsigned v) { return __hip_atomic_fetch_add(p, v, __ATOMIC_RELAXED, __HIP_MEMORY_SCOPE_AGENT); }
__device__ __forceinline__ unsigned xb_xcc_id() { return (unsigned)__builtin_amdgcn_s_getreg((3 << 11) | 20) & 0xFu; }
#define XB_SPIN(cond, bar) do { unsigned _sp = 0; while (cond) { __builtin_amdgcn_s_sleep(1); \
    if ((++_sp & 255u) == 0u) { if (xb_ld(&(bar)[XB_TMO])) break; if (_sp > XB_SPIN_CAP) { atomicAdd(&(bar)[XB_TMO], 1u); break; } } } } while (0)
struct XcdBarrier { unsigned* bar; unsigned x; volatile LAS unsigned* st; };
__device__ __forceinline__ XcdBarrier xcd_barrier_post(unsigned* bar, volatile LAS unsigned* st) {
    XcdBarrier b; b.bar = bar; b.x = xb_xcc_id(); b.st = st;
    if (threadIdx.x == 0) (void)xb_add(&bar[XB_XCNT(b.x)], 1u);
    return b;
}
__device__ __forceinline__ void xcd_barrier_complete(unsigned* bar, unsigned x, unsigned& nloc, unsigned& nx) {
    const unsigned G = gridDim.x * gridDim.y * gridDim.z;
    unsigned sum, cnt, mine, sp = 0u;
    for (;;) {
        sum = 0u; cnt = 0u; mine = 0u;
#pragma unroll
        for (unsigned j = 0; j < 16; ++j) { const unsigned c = xb_ld(&bar[XB_XCNT(j)]); sum += c; cnt += (c > 0u) ? 1u : 0u; mine = (j == x) ? c : mine; }
        if (sum == G) break;
        __builtin_amdgcn_s_sleep(1);
        if ((++sp & 255u) == 0u) { if (xb_ld(&bar[XB_TMO])) break; if (sp > XB_SPIN_CAP) { atomicAdd(&bar[XB_TMO], 1u); break; } }
    }
    nloc = mine > 0u ? mine : 1u; nx = cnt > 0u ? cnt : 1u;
}
__device__ __forceinline__ void xcd_barrier(const XcdBarrier& b) {
    asm volatile("s_waitcnt vmcnt(0)" ::: "memory");
    __syncthreads();
    if (threadIdx.x == 0) {
        unsigned* bar = b.bar;
        __builtin_amdgcn_s_waitcnt(0);
        unsigned nloc = b.st[0], nx = b.st[1];
        if (nloc == 0u) { xcd_barrier_complete(bar, b.x, nloc, nx); b.st[0] = nloc; b.st[1] = nx; }
        const unsigned old = xb_add(&bar[XB_XSUB(b.x)], 1u);
        const unsigned gen = old / nloc;
        if (old + 1u == (gen + 1u) * nloc) {
            __builtin_amdgcn_fence(__ATOMIC_RELEASE, "agent");
            asm volatile("s_waitcnt vmcnt(0)" ::: "memory");
            const unsigned og = xb_add(&bar[XB_TOP], 1u);
            const unsigned tg = og / nx;
            if (og + 1u == (tg + 1u) * nx) xb_add(&bar[XB_TOPGEN], 1u);
            else XB_SPIN(xb_ld(&bar[XB_TOPGEN]) == tg, bar);
            __builtin_amdgcn_fence(__ATOMIC_ACQUIRE, "agent");
            xb_add(&bar[XB_XGEN(b.x)], 1u);
            asm volatile("s_waitcnt vmcnt(0)" ::: "memory");
        } else {
            XB_SPIN(xb_ld(&bar[XB_XGEN(b.x)]) == gen, bar);
            __builtin_amdgcn_fence(__ATOMIC_ACQUIRE, "agent");
            asm volatile("s_waitcnt vmcnt(0)" ::: "memory");
        }
    }
    __syncthreads();
}

struct Frame {
    LAS unsigned char* lds;
    volatile LAS unsigned* MISC;
    gu32* ctl;
    int tid, lane, wave;
    int vcu, G, li;
    float* out; unsigned char* ws;
};
enum { I_X = 0, I_LNMIX, I_WIN, I_CONV, I_ALOG, I_DTB, I_DNNORM, I_SINK, I_WOUT, I_LNFFN, I_WG, I_BG, I_WE, I_BE, I_WGU, I_WD, I_LNF };

__device__ __forceinline__ void transpose_item(const float* W, int ldn, int src_col0, int k0, bf16* WT, int ldk, int dst_row0, LAS float* scr, int lane) {
#pragma unroll 8
    for (int i = 0; i < 32; ++i) { const int kk = 2 * i + (lane >> 5); scr[kk * 33 + (lane & 31)] = __builtin_nontemporal_load(W + (size_t)(k0 + kk) * ldn + src_col0 + (lane & 31)); }
    LDS_WAIT(); asm volatile("" ::: "memory");
    const int c = lane & 7;
#pragma unroll
    for (int j = 0; j < 4; ++j) { const int n = (lane >> 3) + 8 * j; const LAS float* s = scr + (8 * c) * 33 + n;
        v4u o; o.x = pk2(s[0 * 33], s[1 * 33]); o.y = pk2(s[2 * 33], s[3 * 33]); o.z = pk2(s[4 * 33], s[5 * 33]); o.w = pk2(s[6 * 33], s[7 * 33]);
        __builtin_nontemporal_store(o, (v4u*)(WT + (size_t)(dst_row0 + n) * ldk + k0 + 8 * c)); }
    LDS_WAIT(); asm volatile("" ::: "memory");
}
__device__ __forceinline__ void p0_prologue(Frame& F, const float* x_in, const float* lnw, const float* w_in, const float* w_out, const float* a_log, const float* dt_b) {
    LAS float* scr = (LAS float*)(F.lds + F.wave * 16384);
    const int gw = F.vcu * NWAVES + F.wave, NGW = F.G * NWAVES;
    bf16* Win_t = (bf16*)(F.ws + WS_WIN); bf16* Wout_t = (bf16*)(F.ws + WS_WOUT);
    constexpr int I_IN = 16 * 88, I_OUT = 16 * 32, NITEMS = I_IN + I_OUT;
    for (int it = gw; it < NITEMS; it += NGW) {
        int r = it;
        if (r < I_IN) { const int kb = r / 88, nb = r % 88, n0 = 32 * nb; transpose_item(w_in, INW, n0 + (n0 >= 2048 ? 16 : 0), 64 * kb, Win_t, D, n0, scr, F.lane); continue; } r -= I_IN;
        { const int kb = r / 32, nb = r % 32; transpose_item(w_out, D, 32 * nb, 64 * kb, Wout_t, D, 32 * nb, scr, F.lane); }
    }
    __syncthreads();
    LAS float* w16T = (LAS float*)F.lds;
    for (int i = F.tid; i < D * 4; i += NTHR) { const int k = i >> 2, c4 = (i & 3) * 4; const f32x4 w = *(const f32x4*)(w_in + (size_t)k * INW + 2048 + c4);
        w16T[(c4 + 0) * D + k] = w.x; w16T[(c4 + 1) * D + k] = w.y; w16T[(c4 + 2) * D + k] = w.z; w16T[(c4 + 3) * D + k] = w.w; }
    __syncthreads();
    bf16* hn = (bf16*)(F.ws + WS_HN); float* bg = (float*)(F.ws + WS_BG);
    f32x4 lw[4];
#pragma unroll
    for (int j = 0; j < 4; ++j) lw[j] = ((const f32x4*)lnw)[F.lane + 64 * j];
    f32x4 vn[4];
    if (gw < T) { const GAS f32x4* xr = (const GAS f32x4*)(x_in + (size_t)gw * D) + F.lane;
#pragma unroll
        for (int j = 0; j < 4; ++j) vn[j] = xr[64 * j]; }
#pragma unroll 1
    for (int m = gw; m < T; m += NGW) {
        f32x4 v[4]; float s = 0.f;
#pragma unroll
        for (int j = 0; j < 4; ++j) v[j] = vn[j];
        if (m + NGW < T) { const GAS f32x4* xr = (const GAS f32x4*)(x_in + (size_t)(m + NGW) * D) + F.lane;
#pragma unroll
            for (int j = 0; j < 4; ++j) vn[j] = xr[64 * j]; }
#pragma unroll
        for (int j = 0; j < 4; ++j) s += (v[j].x * v[j].x + v[j].y * v[j].y) + (v[j].z * v[j].z + v[j].w * v[j].w);
        const float rstd = rsqrtf(wave_sum(s) * (1.f / D) + EPS);
#pragma unroll
        for (int j = 0; j < 4; ++j) v[j] = v[j] * rstd * lw[j];
        GAS unsigned long long* o8 = (GAS unsigned long long*)(hn + (size_t)m * D) + F.lane;
#pragma unroll
        for (int j = 0; j < 4; ++j) o8[64 * j] = (unsigned long long)pk2(v[j].x, v[j].y) | ((unsigned long long)pk2(v[j].z, v[j].w) << 32);
        float acc[16];
#pragma unroll
        for (int c = 0; c < 16; ++c) { float a = 0.f;
#pragma unroll
            for (int j = 0; j < 4; ++j) { const f32x4 w = *(const LAS f32x4*)(w16T + c * D + 4 * F.lane + 256 * j); a += (v[j].x * w.x + v[j].y * w.y) + (v[j].z * w.z + v[j].w * w.w); }
            acc[c] = a; if ((c & 3) == 3) asm volatile("" ::: "memory"); }
        const float tot = reduce16(acc, F.lane);
        if ((F.lane & 3) == 0) { const int idx = ((F.lane >> 5) & 1) * 8 + ((F.lane >> 4) & 1) * 4 + ((F.lane >> 3) & 1) * 2 + ((F.lane >> 2) & 1);
            if (idx < 8) bg[(size_t)m * 16 + idx] = 1.f / (1.f + expf(-tot));
            else bg[(size_t)m * 16 + idx] = -expf(a_log[idx - 8]) * softplus_f(tot + dt_b[idx - 8]); }
    }
}

typedef short bf16x8 __attribute__((ext_vector_type(8)));
typedef short bf16x4 __attribute__((ext_vector_type(4)));
typedef unsigned v2u __attribute__((ext_vector_type(2)));
constexpr size_t DN_QS = WS_DN, DN_KT = WS_DN + 32 * MiB, DN_U = WS_DN + 64 * MiB, DN_W = WS_DN + 128 * MiB, DN_AT = WS_DN + 192 * MiB;
constexpr size_t DN_GV = WS_MISC;
constexpr size_t SC_KKQK = WS_WGU, SC_VT = WS_WD;
#define MFMA16(a, b, c) __builtin_amdgcn_mfma_f32_16x16x32_bf16((a), (b), (c), 0, 0, 0)
#define RAW_BAR() do { asm volatile("s_waitcnt lgkmcnt(0)" ::: "memory"); __builtin_amdgcn_s_barrier(); asm volatile("" ::: "memory"); } while (0)

__device__ __forceinline__ void glds16(const void* gsrc, LAS unsigned char* ldst) {
    __builtin_amdgcn_global_load_lds((const unsigned*)gsrc, (LAS unsigned*)ldst, 16, 0, 0);
}
__device__ __forceinline__ void p2_group(Frame& F, int grp, const float* convw, const float* bgp, int stmask = 3) {
    const int tid = F.tid, lane = F.lane, w = F.wave;
    const bf16* proj = (const bf16*)(F.ws + WS_PROJ);
    LAS bf16* QL = (LAS bf16*)(F.lds + 52224);
    LAS bf16* KL = (LAS bf16*)(F.lds + 52224 + 17408);
    LAS float* CWL = (LAS float*)(F.lds + 139264);
    auto xin_issue = [&](int ui, LAS unsigned char* XB) {
        const int un = grp * 4 + ui, n = un & 127, bh = un >> 7, h = bh & 3, b = bh >> 2;
#pragma unroll 1
        for (int k = 0; k < 7; ++k) { const int pc = k * 8 + w;
            if (pc < 51) { const int c = pc * 64 + lane, rr = c / 48, rem = c - rr * 48, p = rem >> 4, c16 = rem & 15, s = 64 * n - 2 + rr;
                if (s >= 0 && s < SEQ) glds16(proj + (size_t)(b * SEQ + s) * NPROJ + p * 512 + h * 128 + c16 * 8, XB + pc * 1024);
                else *(LAS v4u*)(XB + c * 16) = (v4u){0u, 0u, 0u, 0u}; } }
    };
    if (stmask & 1) {
        xin_issue(0, F.lds);
        if (tid < 480) { const int pj = tid >> 5, c4 = tid & 31, p = pj / 5, j = pj - p * 5, h = ((grp * 4) >> 7) & 3;
            *(LAS f32x4*)(CWL + pj * 128 + 4 * c4) = *(const f32x4*)(convw + j * 1536 + p * 512 + h * 128 + 4 * c4); }
    }
#pragma unroll 1
    for (int ui = 0; ui < ((stmask & 1) ? 4 : 0); ++ui) {
        const int un = grp * 4 + ui, n = un & 127, bh = un >> 7, h = bh & 3, b = bh >> 2;
        LAS bf16* XIN = (LAS bf16*)(F.lds + (ui & 1) * 87040);
        asm volatile("s_waitcnt vmcnt(0) lgkmcnt(0)" ::: "memory"); __syncthreads();
        if (ui + 1 < 4) xin_issue(ui + 1, F.lds + ((ui + 1) & 1) * 87040);
        {
            float val[3][8][2];
#pragma unroll
            for (int p = 0; p < 3; ++p) {
                float cw[5][2];
#pragma unroll
                for (int j = 0; j < 5; ++j) { const LAS float* cp = CWL + (p * 5 + j) * 128 + 2 * lane; cw[j][0] = cp[0]; cw[j][1] = cp[1]; }
                float xr[12][2];
#pragma unroll
                for (int r = 0; r < 12; ++r) { const unsigned u2 = *(const LAS unsigned*)(XIN + (8 * w + r) * 384 + p * 128 + 2 * lane); xr[r][0] = bf2f((unsigned short)(u2 & 0xffffu)); xr[r][1] = bf2f((unsigned short)(u2 >> 16)); }
#pragma unroll
                for (int i = 0; i < 8; ++i) { float a0 = 0.f, a1 = 0.f;
#pragma unroll
                    for (int j = 0; j < 5; ++j) { a0 = fmaf(xr[i + j][0], cw[j][0], a0); a1 = fmaf(xr[i + j][1], cw[j][1], a1); }
                    val[p][i][0] = silu_f(a0); val[p][i][1] = silu_f(a1); }
            }
#pragma unroll
            for (int i = 0; i < 8; ++i) {
                const float sq = wave_sum(val[0][i][0] * val[0][i][0] + val[0][i][1] * val[0][i][1]);
                const float sk = wave_sum(val[1][i][0] * val[1][i][0] + val[1][i][1] * val[1][i][1]);
                const float rq = rsqrtf(sq + EPS) * 0.08838834764831845f, rk = rsqrtf(sk + EPS);
                val[0][i][0] *= rq; val[0][i][1] *= rq; val[1][i][0] *= rk; val[1][i][1] *= rk;
                const unsigned qp = pk2(val[0][i][0], val[0][i][1]), kp = pk2(val[1][i][0], val[1][i][1]);
                *(LAS unsigned*)(QL + (8 * w + i) * 136 + 2 * lane) = qp; *(LAS unsigned*)(KL + (8 * w + i) * 136 + 2 * lane) = kp;
                *(GAS unsigned*)((bf16*)(F.ws + DN_QS) + ((size_t)un * 64 + 8 * w + i) * 128 + 2 * lane) = qp;
            }
#pragma unroll
            for (int c = 0; c < 2; ++c) {
                v4u kt, vt;
                kt.x = pk2(val[1][0][c], val[1][1][c]); kt.y = pk2(val[1][2][c], val[1][3][c]); kt.z = pk2(val[1][4][c], val[1][5][c]); kt.w = pk2(val[1][6][c], val[1][7][c]);
                vt.x = pk2(val[2][0][c], val[2][1][c]); vt.y = pk2(val[2][2][c], val[2][3][c]); vt.z = pk2(val[2][4][c], val[2][5][c]); vt.w = pk2(val[2][6][c], val[2][7][c]);
                { bf16* kp = (bf16*)(F.ws + DN_KT) + ((size_t)un * 128 + 2 * lane + c) * 64 + 32 * (w >> 2) + 16 * (w & 1) + 4 * ((w & 3) >> 1);
                  *(GAS v2u*)kp = (v2u){kt.x, kt.y}; *(GAS v2u*)(kp + 8) = (v2u){kt.z, kt.w}; }
                *(GAS v4u*)((bf16*)(F.ws + SC_VT) + ((size_t)un * 128 + 2 * lane + c) * 64 + 8 * w) = vt;
            }
        }
        __syncthreads();
        {
            const int type = w >> 2, tr = w & 3, fr = lane & 15, fq = lane >> 4;
            const LAS bf16* Asrc = type ? QL : KL;
            bf16x8 af[4];
#pragma unroll
            for (int ks = 0; ks < 4; ++ks) af[ks] = *(const LAS bf16x8*)(Asrc + (16 * tr + fr) * 136 + 32 * ks + 8 * fq);
            float* G = (float*)(F.ws + SC_KKQK) + ((size_t)un * 2 + type) * 4096;
#pragma unroll
            for (int tc = 0; tc < 4; ++tc) { f32x4 acc = (f32x4){0.f, 0.f, 0.f, 0.f};
#pragma unroll
                for (int ks = 0; ks < 4; ++ks) { const bf16x8 bfr = *(const LAS bf16x8*)(KL + (16 * tc + fr) * 136 + 32 * ks + 8 * fq); acc = MFMA16(af[ks], bfr, acc); }
#pragma unroll
                for (int r = 0; r < 4; ++r) G[(16 * tr + 4 * fq + r) * 64 + 16 * tc + fr] = acc[r]; }
        }
    }
    VM_WAIT(); __syncthreads();
    if (tid == 0) { __builtin_amdgcn_fence(__ATOMIC_ACQUIRE, "agent"); VM_WAIT(); }
    __syncthreads();
    if (stmask & 2) {
        int lane = F.lane; asm volatile("" : "+v"(lane));
        const int un = grp * 4 + (w >> 1), dir = w & 1, n = un & 127, bh = un >> 7, h = bh & 3, b = bh >> 2, item = un * 2 + dir;
        const int rl = dir ? 63 - lane : lane;
        const size_t tok = (size_t)b * SEQ + 64 * n + rl;
        const float beta = bgp[tok * 16 + dir * 4 + h], g = bgp[tok * 16 + 8 + dir * 4 + h];
        float gc = g;
#pragma unroll
        for (int o = 1; o < 64; o <<= 1) { const float t = __shfl_up(gc, o); if (lane >= o) gc += t; }
        const float gcl = __shfl(gc, 63), egc = __expf(gc), ekd = __expf(gcl - gc);
        float* gv = (float*)(F.ws + DN_GV) + (size_t)item * 128; gv[lane] = egc; gv[64 + lane] = ekd;
        const float* KKp = (const float*)(F.ws + SC_KKQK) + (size_t)un * 8192; const float* QKp = KKp + 4096;
        bf16* ATp = (bf16*)(F.ws + DN_AT) + (size_t)item * 4096;
        float Tr[64];
        float kkc[8], qkc[8];
        const char* KKb = (const char*)KKp; char* ATb = (char*)ATp;
        const int kstep = dir ? -256 : 256;
        const unsigned kk0 = (unsigned)(((dir ? 63 : 0) * 64 + rl) * 4);
        {   unsigned o2 = kk0; asm volatile("" : "+v"(o2));
#pragma unroll
            for (int r = 0; r < 8; ++r) { kkc[r] = *(const float*)(KKb + (o2 + (unsigned)(r * kstep))); qkc[r] = *(const float*)(KKb + (o2 + (unsigned)(r * kstep) + 16384u)); } }
#pragma unroll
        for (int blk = 0; blk < 8; ++blk) {
            float kkn[8], qkn[8];
            {   unsigned o2 = kk0 + (unsigned)((blk < 7 ? 8 * (blk + 1) : 0) * kstep); asm volatile("" : "+v"(o2));
#pragma unroll
                for (int r = 0; r < 8; ++r) { kkn[r] = *(const float*)(KKb + (o2 + (unsigned)(r * kstep))); qkn[r] = *(const float*)(KKb + (o2 + (unsigned)(r * kstep) + 16384u)); } }
            unsigned ao = (unsigned)(lane * 2 + blk * 1024); asm volatile("" : "+v"(ao));
            asm volatile("" ::: "memory");
#pragma unroll
            for (int r = 0; r < 8; ++r) {
                const int i = 8 * blk + r;
                const float kk = kkc[r], qk = qkc[r];
                const float gci = __builtin_bit_cast(float, __builtin_amdgcn_readlane(__builtin_bit_cast(int, gc), i));
                const float bi = __builtin_bit_cast(float, __builtin_amdgcn_readlane(__builtin_bit_cast(int, beta), i));
                const float dec = __expf(fminf(gci - gc, 0.f));
                const float arow = (lane < i) ? bi * kk * dec : 0.f;
                *(bf16*)(ATb + (ao + (unsigned)(r * 128))) = (bf16)f2bf((lane <= i) ? qk * dec : 0.f);
                float t = (lane == i) ? 1.f : 0.f;
#pragma unroll
                for (int j = 0; j < i; ++j) { const float sv = __builtin_bit_cast(float, __builtin_amdgcn_readlane(__builtin_bit_cast(int, arow), j)); t = fmaf(-sv, Tr[j], t); }
                Tr[i] = t;
            }
            asm volatile("" ::: "memory");
#pragma unroll
            for (int r = 0; r < 8; ++r) { kkc[r] = kkn[r]; qkc[r] = qkn[r]; }
        }
        LAS bf16* TB = (LAS bf16*)(F.lds + w * 16384); LAS bf16* TG = TB + 4096;
        const float cb = beta, cg = beta * egc;
        const int rp = (rl & 32) | (((rl >> 2) & 3) << 3) | (((rl >> 4) & 1) << 2) | (rl & 3);
#pragma unroll
        for (int i = 0; i < 64; ++i) { const int off = i * 64 + ((((rl >> 3) ^ (i & 7))) << 3) + (rl & 7), offg = i * 64 + ((((rp >> 3) ^ (i & 7))) << 3) + (rp & 7);
            TB[off] = (bf16)f2bf(Tr[i] * cb); TG[offg] = (bf16)f2bf(Tr[i] * cg); }
        LDS_WAIT(); asm volatile("" ::: "memory");
        const int fr = lane & 15, fq = lane >> 4;
        bf16x8 ab[4][2], ag[4][2];
#pragma unroll
        for (int m = 0; m < 4; ++m)
#pragma unroll
            for (int ks = 0; ks < 2; ++ks) { const int row = 16 * m + fr, off = row * 64 + (((4 * ks + fq) ^ (row & 7)) << 3); ab[m][ks] = *(const LAS bf16x8*)(TB + off); ag[m][ks] = *(const LAS bf16x8*)(TG + off); }
        const bf16* VTp = (const bf16*)(F.ws + SC_VT) + (size_t)un * 8192; const bf16* KTp = (const bf16*)(F.ws + DN_KT) + (size_t)un * 8192;
        bf16* Up = (bf16*)(F.ws + DN_U) + (size_t)item * 8192; bf16* Wp = (bf16*)(F.ws + DN_W) + (size_t)item * 8192;
#pragma unroll 4
        for (int nn = 0; nn < 8; ++nn) {
            bf16x8 bv[2], bk[2];
#pragma unroll
            for (int ks = 0; ks < 2; ++ks) { bv[ks] = *(const GAS bf16x8*)(VTp + (16 * nn + fr) * 64 + 32 * ks + 8 * fq); bk[ks] = *(const GAS bf16x8*)(KTp + (16 * nn + fr) * 64 + 32 * ks + 8 * fq); }
#pragma unroll
            for (int m = 0; m < 4; ++m) {
                f32x4 au = (f32x4){0.f, 0.f, 0.f, 0.f}, aw = (f32x4){0.f, 0.f, 0.f, 0.f};
#pragma unroll
                for (int ks = 0; ks < 2; ++ks) { au = MFMA16(ab[m][ks], bv[ks], au); aw = MFMA16(bk[ks], ag[m][ks], aw); }
                v2u uo; uo.x = pk2(au[0], au[1]); uo.y = pk2(au[2], au[3]);
                *(GAS v2u*)(Up + ((m * 8 + nn) * 64 + lane) * 4) = uo;
                v2u wo; wo.x = pk2(aw[0], aw[1]); wo.y = pk2(aw[2], aw[3]);
                *(GAS v2u*)(Wp + (16 * m + fr) * 128 + 32 * (nn >> 1) + 8 * fq + 4 * (nn & 1)) = wo;
            }
        }
    }
    __syncthreads();
}

constexpr int CW_PROG = 36864;
constexpr int RB_W = 0, RB_KT = 16384, RB_U = 32768, RB_GV = 40960, RB_SIZE = 41984;
static_assert(3 * RB_SIZE <= RING_BYTES, "scan ring");
constexpr size_t DN_SX0 = DN_U + 32 * MiB, DN_SX1 = DN_W + 32 * MiB, DN_VX0 = DN_QS + 16 * MiB, DN_VX1 = DN_KT + 16 * MiB;
__device__ __forceinline__ void glds16_sc1(const void* gsrc, LAS unsigned char* ldst) {
    __builtin_amdgcn_global_load_lds((const unsigned*)gsrc, (LAS unsigned*)ldst, 16, 0, 16);
}
template <int OFF>
__device__ __forceinline__ void store16_sc1(void* gdst, v4u v) {
    asm volatile("global_store_dwordx4 %0, %1, off offset:%2 sc1\n\ts_nop 1" :: "v"(gdst), "v"(v), "n"(OFF) : "memory");
}
__device__ __forceinline__ bf16x8 ld2x8(const LAS unsigned char* p0, const LAS unsigned char* p1) {
    const v2u lo = *(const LAS v2u*)p0, hi = *(const LAS v2u*)p1; v4u v; v.x = lo.x; v.y = lo.y; v.z = hi.x; v.w = hi.y; return __builtin_bit_cast(bf16x8, v);
}
struct ScanOff { unsigned w0[4], k0[2], u, gk; };
template <int DIR, int BUF>
__device__ __forceinline__ void scan_step(LAS unsigned char* L, const ScanOff& O, f32x4 (&S)[8], unsigned char*& sxp, unsigned char*& vxp, bool ex) {
    const LAS unsigned char* B = L + BUF * RB_SIZE;
    v4u sbv[4];
#pragma unroll
    for (int ks = 0; ks < 4; ++ks) { sbv[ks].x = pk2(S[2 * ks][0], S[2 * ks][1]); sbv[ks].y = pk2(S[2 * ks][2], S[2 * ks][3]); sbv[ks].z = pk2(S[2 * ks + 1][0], S[2 * ks + 1][1]); sbv[ks].w = pk2(S[2 * ks + 1][2], S[2 * ks + 1][3]); }
    if (ex) { store16_sc1<0>(sxp, sbv[0]); store16_sc1<1024>(sxp, sbv[1]); store16_sc1<2048>(sxp, sbv[2]); store16_sc1<3072>(sxp, sbv[3]); }
    bf16x8 fw[4][4]; v2u ucv[4]; f32x4 ekv[4];
#pragma unroll
    for (int it = 0; it < 4; ++it) {
#pragma unroll
        for (int ks = 0; ks < 4; ++ks) fw[it][ks] = *(const LAS bf16x8*)(B + RB_W + O.w0[ks] + it * 4096);
        ucv[it] = *(const LAS v2u*)(B + RB_U + O.u + it * 2048); ekv[it] = *(const LAS f32x4*)(B + RB_GV + O.gk + it * 64); }
    const float dch = ((const LAS float*)(B + RB_GV))[63];
    f32x4 aW[4];
#pragma unroll
    for (int it = 0; it < 4; ++it) { aW[it] = (f32x4){0.f, 0.f, 0.f, 0.f};
#pragma unroll
        for (int ks = 0; ks < 4; ++ks) aW[it] = MFMA16(fw[it][ks], __builtin_bit_cast(bf16x8, sbv[ks]), aW[it]); }
    bf16x8 fk[8][2];
#pragma unroll
    for (int dt = 0; dt < 8; ++dt)
#pragma unroll
        for (int k2 = 0; k2 < 2; ++k2) fk[dt][k2] = *(const LAS bf16x8*)(B + RB_KT + O.k0[k2] + dt * 2048);
    f32x4 vs[4]; v2u vnp[4];
#pragma unroll
    for (int it = 0; it < 4; ++it) {
        const v2u uc = ucv[it]; const f32x4 ek = ekv[it];
        f32x4 vn;
        vn[0] = bf2f((unsigned short)(uc.x & 0xffffu)) - aW[it][0]; vn[1] = bf2f((unsigned short)(uc.x >> 16)) - aW[it][1];
        vn[2] = bf2f((unsigned short)(uc.y & 0xffffu)) - aW[it][2]; vn[3] = bf2f((unsigned short)(uc.y >> 16)) - aW[it][3];
        vnp[it] = (v2u){pk2(vn[0], vn[1]), pk2(vn[2], vn[3])};
        vs[it] = vn * ek;
    }
    if (ex) { store16_sc1<0>(vxp, (v4u){vnp[0].x, vnp[0].y, vnp[1].x, vnp[1].y}); store16_sc1<1024>(vxp, (v4u){vnp[2].x, vnp[2].y, vnp[3].x, vnp[3].y}); }
    sxp += DIR ? -32768 : 32768; vxp += DIR ? -16384 : 16384;
    bf16x8 Vsb[2];
#pragma unroll
    for (int k2 = 0; k2 < 2; ++k2) { v4u t;
        if (DIR) { t.x = pk2(vs[2 * k2 + 1][3], vs[2 * k2 + 1][2]); t.y = pk2(vs[2 * k2 + 1][1], vs[2 * k2 + 1][0]); t.z = pk2(vs[2 * k2][3], vs[2 * k2][2]); t.w = pk2(vs[2 * k2][1], vs[2 * k2][0]); }
        else { t.x = pk2(vs[2 * k2][0], vs[2 * k2][1]); t.y = pk2(vs[2 * k2][2], vs[2 * k2][3]); t.z = pk2(vs[2 * k2 + 1][0], vs[2 * k2 + 1][1]); t.w = pk2(vs[2 * k2 + 1][2], vs[2 * k2 + 1][3]); }
        Vsb[k2] = __builtin_bit_cast(bf16x8, t); }
#pragma unroll
    for (int dt = 0; dt < 8; ++dt) { S[dt] = S[dt] * dch;
#pragma unroll
        for (int k2 = 0; k2 < 2; ++k2) S[dt] = MFMA16(fk[dt][k2], Vsb[k2], S[dt]); }
    asm volatile("s_waitcnt vmcnt(12) lgkmcnt(0)" ::: "memory"); __builtin_amdgcn_s_barrier(); asm volatile("" ::: "memory");
}
template <int DIR>
__device__ __forceinline__ void scan_compute(Frame& F, LAS unsigned char* L, int hf, int bh, int mode) {
    const int lane = F.lane, w = F.wave, fr = lane & 15, fq = lane >> 4;
    ScanOff O;
    const int s7 = (fr >> 1) & 7;
#pragma unroll
    for (int ks = 0; ks < 4; ++ks) O.w0[ks] = (unsigned)(fr * 256 + (((4 * ks + fq) ^ fr) << 4));
#pragma unroll
    for (int k2 = 0; k2 < 2; ++k2) {
        const int ck = DIR ? 4 * (1 - k2) + (3 - fq) : 4 * k2 + fq;
        O.k0[k2] = (unsigned)(fr * 128 + ((ck ^ s7) << 4));
    }
    O.u = (unsigned)((w * 64 + lane) * 8); O.gk = (unsigned)((64 + 4 * fq) * 4);
    const int item0 = (bh * 128 + (DIR ? 127 : 0)) * 2 + DIR;
    unsigned char* sxp = F.ws + (hf ? DN_SX1 : DN_SX0) + (size_t)item0 * 16384 + w * 4096 + lane * 16;
    unsigned char* vxp = F.ws + (hf ? DN_VX1 : DN_VX0) + (size_t)item0 * 8192 + w * 2048 + lane * 16;
    const bool ex = !(mode & 1);
    f32x4 S[8];
#pragma unroll
    for (int t = 0; t < 8; ++t) S[t] = (f32x4){0.f, 0.f, 0.f, 0.f};
    __builtin_amdgcn_s_barrier(); asm volatile("" ::: "memory");
#pragma unroll 1
    for (int step = 0; step < 126; step += 3) { scan_step<DIR, 0>(L, O, S, sxp, vxp, ex); scan_step<DIR, 1>(L, O, S, sxp, vxp, ex); scan_step<DIR, 2>(L, O, S, sxp, vxp, ex); }
    scan_step<DIR, 0>(L, O, S, sxp, vxp, ex); scan_step<DIR, 1>(L, O, S, sxp, vxp, ex);
}
__device__ __forceinline__ void scan_loader(Frame& F, LAS unsigned char* L, int c, int hf, int dir, int bh, int mode) {
    const int lane = F.lane, lw = F.wave - 4;
    unsigned goff[11];
#pragma unroll
    for (int k = 0; k < 11; ++k) { const int p = lw + 4 * k, q = (p & 15) * 64 + lane;
        if (p < 16) { const int row = q >> 4, ch = (q & 15) ^ (row & 15); goff[k] = (unsigned)(row * 256 + ch * 16); }
        else if (p < 32) { const int row = q >> 3, ch = (q & 7) ^ ((row >> 1) & 7); goff[k] = (unsigned)(row * 128 + ch * 16); }
        else if (p < 40) { const int pu = p - 32; goff[k] = (unsigned)((((pu >> 1) * 8 + 4 * hf) * 512) + (pu & 1) * 1024 + lane * 16); }
        else goff[k] = (unsigned)(lane * 16); }
    unsigned* prog = (unsigned*)(F.ctl + CW_PROG + 2048 * F.li + 64 * (c * 2 + hf));
    auto issue = [&](int t, LAS unsigned char* B) {
        const int nc = dir ? 127 - t : t, un = bh * 128 + nc, item = un * 2 + dir;
        const unsigned char* gW = F.ws + DN_W + (size_t)item * 16384; const unsigned char* gK = F.ws + DN_KT + (size_t)un * 16384;
        const unsigned char* gU = F.ws + DN_U + (size_t)item * 16384; const unsigned char* gG = F.ws + DN_GV + (size_t)item * 512;
#pragma unroll
        for (int k = 0; k < 11; ++k) { const int p = lw + 4 * k;
            if (k < 4) glds16(gW + goff[k], B + RB_W + p * 1024);
            else if (k < 8) glds16(gK + goff[k], B + RB_KT + (p - 16) * 1024);
            else if (k < 10) glds16(gU + goff[k], B + RB_U + (p - 32) * 1024);
            else if (lw == 0) glds16(gG + goff[k], B + RB_GV); }
    };
    if (!(mode & 2)) issue(0, L);
    int nb = 1;
#pragma unroll 1
    for (int k = 0; k <= 128; ++k) {
        if (k + 1 < 128 && !(mode & 2)) { issue(k + 1, L + nb * RB_SIZE);
            if (lw == 0) asm volatile("s_waitcnt vmcnt(11)" ::: "memory"); else asm volatile("s_waitcnt vmcnt(10)" ::: "memory"); }
        else asm volatile("s_waitcnt vmcnt(0)" ::: "memory");
        if (++nb == 3) nb = 0;
        __builtin_amdgcn_s_barrier(); asm volatile("" ::: "memory");
        if (lw == 0 && lane == 0 && k >= 3 && !(mode & 1)) __hip_atomic_store(prog, (unsigned)(k - 2), RLX_AGENT);
    }
}
__device__ __forceinline__ void p3_scan(Frame& F, int c, int hf, int mode  ) {
    const int b = c >> 3, h = (c >> 1) & 3, dir = c & 1, bh = b * 4 + h;
    LAS unsigned char* L = F.lds;
    if (F.wave >= 4) scan_loader(F, L, c, hf, dir, bh, mode);
    else if (dir) scan_compute<1>(F, L, hf, bh, mode); else scan_compute<0>(F, L, hf, bh, mode);
    asm volatile("s_waitcnt vmcnt(0) lgkmcnt(0)" ::: "memory"); __syncthreads();
    if (F.tid == 256 && !(mode & 1)) __hip_atomic_store((unsigned*)(F.ctl + CW_PROG + 2048 * F.li + 64 * (c * 2 + hf)), 128u, RLX_AGENT);
    __syncthreads();
}

constexpr int OL_Q = 0, OL_AT = 16384, OL_SX = 24576, OL_VX = 40960, OL_GV = 49152, OL_SIZE = 50176;
__device__ __forceinline__ void p3_out_issue(Frame& F, int j, LAS unsigned char* Lb) {
    const int lane = F.lane, w = F.wave;
    const int n = j >> 5, wg = j & 31, c = wg >> 1, hf = wg & 1, b = c >> 3, h = (c >> 1) & 3, dir = c & 1, bh = b * 4 + h;
    const int nc = dir ? 127 - n : n, un = bh * 128 + nc, item = un * 2 + dir;
    const unsigned char* gQ = F.ws + DN_QS + (size_t)un * 16384; const unsigned char* gA = F.ws + DN_AT + (size_t)item * 8192;
    const unsigned char* gS = F.ws + (hf ? DN_SX1 : DN_SX0) + (size_t)item * 16384; const unsigned char* gV = F.ws + (hf ? DN_VX1 : DN_VX0) + (size_t)item * 8192;
#pragma unroll
    for (int k = 0; k < 2; ++k) { const int p = 2 * w + k, q = p * 64 + lane, row = q >> 4, ch = (q & 15) ^ (row & 15);
        glds16(gQ + row * 256 + ch * 16, Lb + OL_Q + p * 1024); glds16_sc1(gS + p * 1024 + lane * 16, Lb + OL_SX + p * 1024); }
    { const int q = w * 64 + lane, row = q >> 3, ch = (q & 7) ^ ((row >> 1) & 7); glds16(gA + row * 128 + ch * 16, Lb + OL_AT + w * 1024); glds16_sc1(gV + w * 1024 + lane * 16, Lb + OL_VX + w * 1024); }
    if (w == 0) glds16(F.ws + DN_GV + (size_t)item * 512 + lane * 16, Lb + OL_GV);
}
__device__ __forceinline__ void p3_out_compute(Frame& F, int j, const LAS unsigned char* Lb, float* odir) {
    const int lane = F.lane, w = F.wave, fr = lane & 15, fq = lane >> 4, mi = w >> 1, eh = w & 1;
    const int n = j >> 5, wg = j & 31, c = wg >> 1, hf = wg & 1, b = c >> 3, h = (c >> 1) & 3, dir = c & 1;
    const int nc = dir ? 127 - n : n;
    const int irow = 16 * mi + fr, qrow = dir ? 63 - irow : irow;
    const int hb = 8 * (fq & 1), fh = fq >> 1;
    f32x4 aQ[2];
#pragma unroll
    for (int t = 0; t < 2; ++t) aQ[t] = (f32x4){0.f, 0.f, 0.f, 0.f};
#pragma unroll
    for (int ks = 0; ks < 4; ++ks) {
        const bf16x8 fqv = ld2x8(Lb + OL_Q + qrow * 256 + (((4 * ks + fh) ^ (qrow & 15)) << 4) + hb, Lb + OL_Q + qrow * 256 + (((4 * ks + 2 + fh) ^ (qrow & 15)) << 4) + hb);
#pragma unroll
        for (int t = 0; t < 2; ++t) { const bf16x8 fs = *(const LAS bf16x8*)(Lb + OL_SX + ((2 * eh + t) * 4 + ks) * 1024 + lane * 16); aQ[t] = MFMA16(fs, fqv, aQ[t]); }
    }
    const float egc_i = ((const LAS float*)(Lb + OL_GV))[irow];
#pragma unroll
    for (int t = 0; t < 2; ++t) aQ[t] = aQ[t] * egc_i;
#pragma unroll
    for (int ks = 0; ks < 2; ++ks) {
        const bf16x8 fa = ld2x8(Lb + OL_AT + irow * 128 + (((4 * ks + fh) ^ ((irow >> 1) & 7)) << 4) + hb, Lb + OL_AT + irow * 128 + (((4 * ks + 2 + fh) ^ ((irow >> 1) & 7)) << 4) + hb);
#pragma unroll
        for (int t = 0; t < 2; ++t) { const bf16x8 fv = *(const LAS bf16x8*)(Lb + OL_VX + ((2 * eh + t) * 2 + ks) * 1024 + lane * 16); aQ[t] = MFMA16(fv, fa, aQ[t]); }
    }
    const size_t tok = (size_t)b * SEQ + 64 * nc + qrow;
    float* op = odir + ((size_t)dir * T + tok) * 512 + h * 128 + 64 * hf + 4 * fq;
#pragma unroll
    for (int t = 0; t < 2; ++t) *(GAS f32x4*)(op + 16 * (2 * eh + t)) = aQ[t];
}
__device__ __forceinline__ void p3_out_batch(Frame& F, int j0, int cnt  , float* odir) {
    const int n = j0 >> 5;
    LAS unsigned char* L = F.lds;
    if (F.tid < 64) { unsigned sp = 0;
        for (;;) { bool ok = true; if (F.tid < cnt) ok = (int)__hip_atomic_load((unsigned*)(F.ctl + CW_PROG + 2048 * F.li + 64 * ((j0 & 31) + F.tid)), RLX_AGENT) > n;
            if (__all(ok) || ++sp > (1u << 22)) break; __builtin_amdgcn_s_sleep(127); __builtin_amdgcn_s_sleep(127); } }
    __syncthreads();
    p3_out_issue(F, j0, L); p3_out_issue(F, j0 + (cnt > 1 ? 1 : 0), L + OL_SIZE);
    int bk = 0;
#pragma unroll 1
    for (int k = 0; k < cnt; ++k) {
        asm volatile("s_waitcnt vmcnt(6) lgkmcnt(0)" ::: "memory"); __builtin_amdgcn_s_barrier(); asm volatile("" ::: "memory");
        { int b2 = bk + 2; if (b2 >= 3) b2 -= 3; const int kn = k + 2 < cnt ? k + 2 : cnt - 1; p3_out_issue(F, j0 + kn, L + b2 * OL_SIZE); }
        p3_out_compute(F, j0 + k, L + bk * OL_SIZE, odir);
        if (++bk == 3) bk = 0;
    }
    asm volatile("s_waitcnt vmcnt(0) lgkmcnt(0)" ::: "memory"); __syncthreads();
}
typedef float f32x16 __attribute__((ext_vector_type(16)));
#define MFMA32(a, b, c) __builtin_amdgcn_mfma_f32_32x32x16_bf16((a), (b), (c), 0, 0, 0)
constexpr size_t WS_ROT = WS_CTL + 256 * 1024;
constexpr int VT_PITCH = 324;
constexpr int CW_WQ = 49152;
constexpr int LT_WQ = LDSCTL_OFF + 512;

__device__ __forceinline__ void p0_rot_table(Frame& F) {
    float* rot = (float*)(F.ws + WS_ROT);
    for (int i = (F.vcu * NTHR + F.tid); i < SEQ * 8; i += F.G * NTHR) { const int s = i >> 3, k = i & 7;
        const float inv = powf(500000.f, -(float)(2 * k) / 16.f); float sn, cs; sincosf((float)s * inv, &sn, &cs); rot[2 * i] = cs; rot[2 * i + 1] = sn; }
}

__device__ __forceinline__ void p3_attn_unit(Frame& F, int unit, const float* sink) {
    const int tid = F.tid, lane = F.lane, w = F.wave, r = lane & 31, hh = lane >> 5;
    const int b = unit >> 8, kvh = (unit >> 7) & 1, qt = unit & 127, k0 = 64 * qt - 128;
    const bf16* proj = (const bf16*)(F.ws + WS_PROJ); const float* rot = (const float*)(F.ws + WS_ROT);
    LAS bf16* KLs = (LAS bf16*)F.lds;
    LAS bf16* VTs = (LAS bf16*)(F.lds + 40960);
#pragma unroll 1
    for (int idx = tid; idx < 320 * 8; idx += NTHR) {
        const int key = idx >> 3, ch = idx & 7, kp = k0 + key;
        v4u kv = (v4u){0u, 0u, 0u, 0u}, vv = (v4u){0u, 0u, 0u, 0u};
        if (kp >= 0 && kp < SEQ) {
            const bf16* rowp = proj + (size_t)(b * SEQ + kp) * NPROJ;
            vv = *(const GAS v4u*)(rowp + PJ_AV + kvh * 64 + ch * 8);
            if (ch >= 2) kv = *(const GAS v4u*)(rowp + PJ_AK + kvh * 64 + ch * 8);
            else {
                const v4u a = *(const GAS v4u*)(rowp + PJ_AK + kvh * 64), c = *(const GAS v4u*)(rowp + PJ_AK + kvh * 64 + 8);
                const float* rp = rot + (size_t)kp * 16; float o[8];
#pragma unroll
                for (int i = 0; i < 8; ++i) { const unsigned ua = a[i >> 1], uc = c[i >> 1];
                    const float x1 = bf2f((unsigned short)((i & 1) ? (ua >> 16) : (ua & 0xffffu))), x2 = bf2f((unsigned short)((i & 1) ? (uc >> 16) : (uc & 0xffffu)));
                    const float cs = rp[2 * i], sn = rp[2 * i + 1]; o[i] = ch == 0 ? x1 * cs - x2 * sn : x2 * cs + x1 * sn; }
                kv.x = pk2(o[0], o[1]); kv.y = pk2(o[2], o[3]); kv.z = pk2(o[4], o[5]); kv.w = pk2(o[6], o[7]);
            }
        }
        *(LAS v4u*)(KLs + key * 64 + ((ch ^ ((key >> 1) & 7)) << 3)) = kv;
#pragma unroll
        for (int i = 0; i < 8; ++i) { const unsigned u = vv[i >> 1]; VTs[(ch * 8 + i) * VT_PITCH + key] = (bf16)((i & 1) ? (u >> 16) : (u & 0xffffu)); }
    }
    const int hq = kvh * 4 + (w >> 1), qp = 64 * qt + 32 * (w & 1) + r;
    const bf16* qrow = proj + (size_t)(b * SEQ + qp) * NPROJ + PJ_AQ + hq * 64;
    bf16x8 qf[4];
    {
        const v4u a = *(const GAS v4u*)(qrow), c = *(const GAS v4u*)(qrow + 8);
        const float* rp = rot + (size_t)qp * 16; float o[8];
#pragma unroll
        for (int i = 0; i < 8; ++i) { const unsigned ua = a[i >> 1], uc = c[i >> 1];
            const float x1 = bf2f((unsigned short)((i & 1) ? (ua >> 16) : (ua & 0xffffu))), x2 = bf2f((unsigned short)((i & 1) ? (uc >> 16) : (uc & 0xffffu)));
            const float cs = rp[2 * i], sn = rp[2 * i + 1]; o[i] = (hh == 0 ? x1 * cs - x2 * sn : x2 * cs + x1 * sn) * 0.125f; }
        v4u q0; q0.x = pk2(o[0], o[1]); q0.y = pk2(o[2], o[3]); q0.z = pk2(o[4], o[5]); q0.w = pk2(o[6], o[7]);
        qf[0] = __builtin_bit_cast(bf16x8, q0);
#pragma unroll
        for (int s = 1; s < 4; ++s) { const v4u q = *(const GAS v4u*)(qrow + 16 * s + 8 * hh); float t[8];
#pragma unroll
            for (int i = 0; i < 8; ++i) { const unsigned u = q[i >> 1]; t[i] = bf2f((unsigned short)((i & 1) ? (u >> 16) : (u & 0xffffu))) * 0.125f; }
            v4u qq; qq.x = pk2(t[0], t[1]); qq.y = pk2(t[2], t[3]); qq.z = pk2(t[4], t[5]); qq.w = pk2(t[6], t[7]); qf[s] = __builtin_bit_cast(bf16x8, qq); }
    }
    __syncthreads();
    float m = sink[hq], l = hh == 0 ? 1.f : 0.f;
    f32x16 O[2];
#pragma unroll
    for (int i = 0; i < 16; ++i) { O[0][i] = 0.f; O[1][i] = 0.f; }
#pragma unroll 1
    for (int kb = (w & 1); kb < (w & 1) + 9; ++kb) {
        f32x16 X;
#pragma unroll
        for (int i = 0; i < 16; ++i) X[i] = 0.f;
        const int krow = 32 * kb + r;
#pragma unroll
        for (int s = 0; s < 4; ++s) { const bf16x8 ka = *(const LAS bf16x8*)(KLs + krow * 64 + (((2 * s + hh) ^ ((krow >> 1) & 7)) << 3)); X = MFMA32(ka, qf[s], X); }
        float bm = -1e30f;
#pragma unroll
        for (int i = 0; i < 16; ++i) { const int kp = k0 + 32 * kb + (i & 3) + 8 * (i >> 2) + 4 * hh, dlt = qp - kp;
            const bool ok = (dlt <= 128) && (dlt >= -128) && (kp >= 0) && (kp < SEQ); X[i] = ok ? X[i] : -1e30f; bm = fmaxf(bm, X[i]); }
        bm = fmaxf(bm, __shfl_xor(bm, 32));
        const float mn = fmaxf(m, bm), alpha = __expf(m - mn); m = mn;
        float ps = 0.f;
#pragma unroll
        for (int i = 0; i < 16; ++i) { X[i] = __expf(X[i] - mn); ps += X[i]; }
        l = l * alpha + ps;
#pragma unroll
        for (int i = 0; i < 16; ++i) { O[0][i] *= alpha; O[1][i] *= alpha; }
        bf16x8 pk[2];
#pragma unroll
        for (int s = 0; s < 2; ++s) { v4u t; t.x = pk2(X[8 * s], X[8 * s + 1]); t.y = pk2(X[8 * s + 2], X[8 * s + 3]); t.z = pk2(X[8 * s + 4], X[8 * s + 5]); t.w = pk2(X[8 * s + 6], X[8 * s + 7]); pk[s] = __builtin_bit_cast(bf16x8, t); }
#pragma unroll
        for (int dt = 0; dt < 2; ++dt)
#pragma unroll
            for (int s = 0; s < 2; ++s) { const LAS bf16* vp = VTs + (32 * dt + r) * VT_PITCH + 32 * kb + 16 * s + 4 * hh;
                const v2u lo = *(const LAS v2u*)vp, hi = *(const LAS v2u*)(vp + 8); v4u va; va.x = lo.x; va.y = lo.y; va.z = hi.x; va.w = hi.y;
                O[dt] = MFMA32(__builtin_bit_cast(bf16x8, va), pk[s], O[dt]); }
    }
    l += __shfl_xor(l, 32);
    const float inv = 1.f / l;
    bf16* orow = (bf16*)(F.ws + WS_MIX) + (size_t)(b * SEQ + qp) * D + 512 + hq * 64;
#pragma unroll
    for (int dt = 0; dt < 2; ++dt)
#pragma unroll
        for (int g = 0; g < 4; ++g) { v2u o; o.x = pk2(O[dt][4 * g] * inv, O[dt][4 * g + 1] * inv); o.y = pk2(O[dt][4 * g + 2] * inv, O[dt][4 * g + 3] * inv);
            *(GAS v2u*)(orow + 32 * dt + 8 * g + 4 * hh) = o; }
    __syncthreads();
}

__device__ __forceinline__ void p3_moe_weight_items(Frame& F, int first_wave, int n_waves, int end_item, const float* w_gu, const float* w_dn) {
    LAS float* scr = (LAS float*)(F.lds + F.wave * 16384);
    bf16* Wgu_t = (bf16*)(F.ws + WS_WGU); bf16* Wd_t = (bf16*)(F.ws + WS_WD);
    constexpr int I_GU = NEXP * 16 * 16, I_DN = NEXP * 4 * 32;
#pragma unroll 1
    for (int it = first_wave; it < end_item; it += n_waves) {
        if (it < I_GU) { const int e = it >> 8, kb = (it >> 4) & 15, nb = it & 15, n0 = 32 * nb, pn = n0 >> 8, bj = (n0 >> 7) & 1, c = n0 & 127;
            transpose_item(w_gu + (size_t)e * D * 512, 512, bj * 256 + pn * 128 + c, 64 * kb, Wgu_t + (size_t)e * 512 * D, D, n0, scr, F.lane); }
        else { const int r2 = it - I_GU, e = r2 >> 7, kb = (r2 >> 5) & 3, nb = r2 & 31; transpose_item(w_dn + (size_t)e * EFF * D, D, 32 * nb, 64 * kb, Wd_t + (size_t)e * D * EFF, EFF, 32 * nb, scr, F.lane); }
    }
}

__device__ __forceinline__ void p4_combine(Frame& F, const float* odir, const float* normw) {
    const int gw = F.vcu * NWAVES + F.wave, NGW = F.G * NWAVES, lane = F.lane;
    const bf16* proj = (const bf16*)(F.ws + WS_PROJ); bf16* mix = (bf16*)(F.ws + WS_MIX);
    const f32x4 nw0 = *(const f32x4*)(normw + 8 * (lane & 15)), nw1 = *(const f32x4*)(normw + 8 * (lane & 15) + 4);
#pragma unroll 1
    for (int tok = gw; tok < T; tok += NGW) {
        const float* of = odir + (size_t)tok * 512 + 8 * lane; const float* ob = of + (size_t)T * 512;
        const f32x4 a0 = *(const GAS f32x4*)of + *(const GAS f32x4*)ob, a1 = *(const GAS f32x4*)(of + 4) + *(const GAS f32x4*)(ob + 4);
        float s = (a0.x * a0.x + a0.y * a0.y) + (a0.z * a0.z + a0.w * a0.w) + (a1.x * a1.x + a1.y * a1.y) + (a1.z * a1.z + a1.w * a1.w);
        s += __shfl_xor(s, 1); s += __shfl_xor(s, 2); s += __shfl_xor(s, 4); s += __shfl_xor(s, 8);
        const float rs = rsqrtf(s * (1.f / 128.f) + EPS);
        const v4u zz = *(const GAS v4u*)(proj + (size_t)tok * NPROJ + PJ_Z + 8 * lane);
        float z[8];
#pragma unroll
        for (int i = 0; i < 8; ++i) { const unsigned u = zz[i >> 1]; z[i] = bf2f((unsigned short)((i & 1) ? (u >> 16) : (u & 0xffffu))); }
        v4u o;
        o.x = pk2(a0.x * rs * nw0.x * silu_f(z[0]), a0.y * rs * nw0.y * silu_f(z[1])); o.y = pk2(a0.z * rs * nw0.z * silu_f(z[2]), a0.w * rs * nw0.w * silu_f(z[3]));
        o.z = pk2(a1.x * rs * nw1.x * silu_f(z[4]), a1.y * rs * nw1.y * silu_f(z[5])); o.w = pk2(a1.z * rs * nw1.z * silu_f(z[6]), a1.w * rs * nw1.w * silu_f(z[7]));
        *(GAS v4u*)(mix + (size_t)tok * D + 8 * lane) = o;
    }
}
constexpr size_t WS_RW = 488 * MiB;
constexpr size_t RW_HI = WS_RW, RW_LO = WS_RW + 256 * 1024, RW_RSTD = WS_RW + 512 * 1024, RW_GATE = WS_RW + 640 * 1024;
constexpr size_t WS_LIST = WS_MISC + 2 * MiB;
constexpr size_t WS_XS = WS_DN, WS_HMID = WS_DN + 96 * MiB, WS_Y2 = WS_DN + 120 * MiB;
constexpr int CW_CNT = 32768;
constexpr int LT_PSTART = LDSCTL_OFF + 1024, LT_PTAB = LDSCTL_OFF + 1536;

__device__ __forceinline__ void p0_router_weights(Frame& F, const float* lnw, const float* wg, const float* we) {
    bf16* hi = (bf16*)(F.ws + RW_HI); bf16* lo = (bf16*)(F.ws + RW_LO);
    for (int i = F.vcu * NTHR + F.tid; i < 80 * D; i += F.G * NTHR) { const int n = i >> 10, k = i & 1023;
        float v = 0.f; if (n < 8) v = wg[k * 8 + n] * lnw[k]; else if (n < 72) v = we[k * 64 + (n - 8)] * lnw[k];
        const unsigned h = f2bf(v); const float r = v - bf2f((unsigned short)h); hi[i] = (bf16)h; lo[i] = (bf16)f2bf(r); }
}
__device__ __forceinline__ void split8(const f32x4 a, const f32x4 b, bf16x8& h, bf16x8& l) {
    const float x[8] = {a.x, a.y, a.z, a.w, b.x, b.y, b.z, b.w}; unsigned hh[8], ll[8];
#pragma unroll
    for (int i = 0; i < 8; ++i) { hh[i] = f2bf(x[i]); ll[i] = f2bf(x[i] - bf2f((unsigned short)hh[i])); }
    v4u vh, vl; vh.x = hh[0] | (hh[1] << 16); vh.y = hh[2] | (hh[3] << 16); vh.z = hh[4] | (hh[5] << 16); vh.w = hh[6] | (hh[7] << 16);
    vl.x = ll[0] | (ll[1] << 16); vl.y = ll[2] | (ll[3] << 16); vl.z = ll[4] | (ll[5] << 16); vl.w = ll[6] | (ll[7] << 16);
    h = __builtin_bit_cast(bf16x8, vh); l = __builtin_bit_cast(bf16x8, vl);
}
__device__ __forceinline__ void p6_route(Frame& F, const float* lnw, const float* bgrp, const float* bexp, int dry) {
    const int lane = F.lane, w = F.wave, fr = lane & 15, fq = lane >> 4;
    const float* x1 = F.out; bf16* h2u = (bf16*)(F.ws + WS_HN);
    const bf16* Wh = (const bf16*)(F.ws + RW_HI); const bf16* Wl = (const bf16*)(F.ws + RW_LO);
    LAS float* PL = (LAS float*)F.lds;
    LAS float* PS = PL + 8 * 32 * 80;
    LAS float* LG = PS + 8 * 32;
    LAS float* RS = LG + 32 * 80;
    LAS int* LC = (LAS int*)(RS + 32);
    LAS int* PK = LC + 64;
    unsigned* cnt = (unsigned*)(F.ctl + CW_CNT + (dry ? 24576 : 0)); int* list = (int*)(F.ws + (dry ? WS_DN + 196 * MiB : WS_LIST)); float* pgate = (float*)(F.ws + RW_GATE); float* rstd_g = (float*)(F.ws + RW_RSTD);
#pragma unroll 1
    for (int grp = blockIdx.x; grp < T / 64; grp += F.G) {
        if (F.tid < 64) LC[F.tid] = 0;
        f32x4 acc[4][5]; float ss[4];
#pragma unroll
        for (int tl = 0; tl < 4; ++tl) { ss[tl] = 0.f;
#pragma unroll
            for (int c = 0; c < 5; ++c) acc[tl][c] = (f32x4){0.f, 0.f, 0.f, 0.f}; }
#pragma unroll 1
        for (int kk = 0; kk < 4; ++kk) {
            const int k0 = 32 * (4 * w + kk) + 8 * fq;
            bf16x8 bh[5], bl[5];
#pragma unroll
            for (int c = 0; c < 5; ++c) { bh[c] = *(const GAS bf16x8*)(Wh + (size_t)(16 * c + fr) * D + k0); bl[c] = *(const GAS bf16x8*)(Wl + (size_t)(16 * c + fr) * D + k0); }
            const f32x4 la = *(const f32x4*)(lnw + k0), lb = *(const f32x4*)(lnw + k0 + 4);
#pragma unroll
            for (int tl = 0; tl < 4; ++tl) {
                const int tok = (grp * 4 + tl) * 16 + fr;
                const f32x4 xa = *(const GAS f32x4*)(x1 + (size_t)tok * D + k0), xb = *(const GAS f32x4*)(x1 + (size_t)tok * D + k0 + 4);
                ss[tl] += (xa.x * xa.x + xa.y * xa.y) + (xa.z * xa.z + xa.w * xa.w) + (xb.x * xb.x + xb.y * xb.y) + (xb.z * xb.z + xb.w * xb.w);
                v4u ho; ho.x = pk2(xa.x * la.x, xa.y * la.y); ho.y = pk2(xa.z * la.z, xa.w * la.w); ho.z = pk2(xb.x * lb.x, xb.y * lb.y); ho.w = pk2(xb.z * lb.z, xb.w * lb.w);
                *(GAS v4u*)(h2u + (size_t)tok * D + k0) = ho;
                bf16x8 ah, al; split8(xa, xb, ah, al);
#pragma unroll
                for (int c = 0; c < 5; ++c) { acc[tl][c] = MFMA16(ah, bh[c], acc[tl][c]); acc[tl][c] = MFMA16(al, bh[c], acc[tl][c]); acc[tl][c] = MFMA16(ah, bl[c], acc[tl][c]); }
            }
        }
#pragma unroll
        for (int tl = 0; tl < 4; ++tl) { ss[tl] += __shfl_xor(ss[tl], 16); ss[tl] += __shfl_xor(ss[tl], 32); }
#pragma unroll
        for (int rd = 0; rd < 2; ++rd) {
#pragma unroll
            for (int t2 = 0; t2 < 2; ++t2) { const int tl = 2 * rd + t2;
#pragma unroll
                for (int c = 0; c < 5; ++c)
#pragma unroll
                    for (int r = 0; r < 4; ++r) PL[(w * 32 + t2 * 16 + 4 * fq + r) * 80 + 16 * c + fr] = acc[tl][c][r];
                if (lane < 16) PS[w * 32 + t2 * 16 + lane] = ss[tl]; }
            __syncthreads();
            for (int i = F.tid; i < 32 * 80; i += NTHR) { float s = 0.f;
#pragma unroll
                for (int ww = 0; ww < 8; ++ww) s += PL[ww * 2560 + i];
                LG[i] = s; }
            if (F.tid < 32) { float s = 0.f;
#pragma unroll
                for (int ww = 0; ww < 8; ++ww) s += PS[ww * 32 + F.tid];
                RS[F.tid] = rsqrtf(s * (1.f / D) + EPS); }
            __syncthreads();
            if (F.tid < 32) {
                const LAS float* lg = LG + F.tid * 80; const float rs = RS[F.tid];
                float gl[8]; int gi = 0; float gm = -1e30f;
#pragma unroll
                for (int g = 0; g < 8; ++g) { gl[g] = lg[g] * rs + bgrp[g]; if (gl[g] > gm) { gm = gl[g]; gi = g; } }
                float gs = 0.f;
#pragma unroll
                for (int g = 0; g < 8; ++g) gs += expf(gl[g] - gm);
                const float pg = 1.f / gs;
                float el[8]; int e1 = 0; float m1 = -1e30f;
#pragma unroll
                for (int e = 0; e < 8; ++e) { el[e] = lg[8 + gi * 8 + e] * rs + bexp[gi * 8 + e]; if (el[e] > m1) { m1 = el[e]; e1 = e; } }
                int e2 = 0; float m2 = -1e30f;
#pragma unroll
                for (int e = 0; e < 8; ++e) if (e != e1 && el[e] > m2) { m2 = el[e]; e2 = e; }
                const float p2 = expf(m2 - m1), inv = 1.f / (1.f + p2);
                const int E1 = gi * 8 + e1, E2 = gi * 8 + e2, lt = 32 * rd + F.tid, tk = grp * 64 + lt;
                const int r1 = __hip_atomic_fetch_add(LC + E1, 1, __ATOMIC_RELAXED, __HIP_MEMORY_SCOPE_WORKGROUP), r2 = __hip_atomic_fetch_add(LC + E2, 1, __ATOMIC_RELAXED, __HIP_MEMORY_SCOPE_WORKGROUP);
                PK[lt * 4] = E1; PK[lt * 4 + 1] = E2; PK[lt * 4 + 2] = r1; PK[lt * 4 + 3] = r2;
                pgate[tk * 2] = pg * inv; pgate[tk * 2 + 1] = pg * p2 * inv; rstd_g[tk] = rs;
            }
            __syncthreads();
        }
        if (F.tid < 64) { const int n = LC[F.tid]; LC[F.tid] = n ? (int)atomicAdd(cnt + 64 * F.tid, (unsigned)n) : 0; }
        __syncthreads();
        if (F.tid < 64) { const int E1 = PK[F.tid * 4], E2 = PK[F.tid * 4 + 1], tk = grp * 64 + F.tid;
            list[E1 * 16384 + LC[E1] + PK[F.tid * 4 + 2]] = tk * 2; list[E2 * 16384 + LC[E2] + PK[F.tid * 4 + 3]] = tk * 2 + 1; }
        __syncthreads();
    }
}
__device__ __forceinline__ int moe_tables(Frame& F) {
    LAS int* pstart = (LAS int*)(F.lds + LT_PSTART); LAS int* ptab = (LAS int*)(F.lds + LT_PTAB);
    if (F.tid < 64) { const int c = (int)__hip_atomic_load((unsigned*)(F.ctl + CW_CNT) + 64 * F.tid, RLX_AGENT); const int np = (c + 255) >> 8; int ps = np;
#pragma unroll
        for (int o = 1; o < 64; o <<= 1) { const int t = __shfl_up(ps, o); if (F.lane >= o) ps += t; }
        const int st = ps - np; pstart[F.tid] = st; if (F.tid == 63) pstart[64] = ps;
        for (int j = 0; j < np; ++j) ptab[st + j] = F.tid | (j << 8); }
    __syncthreads();
    return pstart[64];
}
__device__ __forceinline__ void p7_gather(Frame& F, int NP) {
    const LAS int* ptab = (const LAS int*)(F.lds + LT_PTAB);
    const int gw = F.vcu * NWAVES + F.wave, NGW = F.G * NWAVES, lane = F.lane;
    const bf16* h2u = (const bf16*)(F.ws + WS_HN); bf16* xs = (bf16*)(F.ws + WS_XS); const int* list = (const int*)(F.ws + WS_LIST);
    const unsigned* cnt = (const unsigned*)(F.ctl + CW_CNT);
#pragma unroll 1
    for (int rid = gw; rid < NP * 256; rid += NGW) { const int pt = ptab[rid >> 8], e = pt & 255, local = (pt >> 8) * 256 + (rid & 255);
        if (local < (int)cnt[64 * e]) { const int tok = list[e * 16384 + local] >> 1;
            const GAS v4u* src = (const GAS v4u*)(h2u + (size_t)tok * D); GAS v4u* dst = (GAS v4u*)(xs + (size_t)rid * D);
            const v4u a = src[lane], b = src[lane + 64]; dst[lane] = a; dst[lane + 64] = b; } }
}
constexpr int CW_PAN = 196608, PAN_NEED = 16;
template <bool GATHER_>
struct MoeOrderT {
    static constexpr bool GATHER = GATHER_;
    int nunits, G, c, SH; const LAS int* ptab; const int* list; const unsigned* cnt; unsigned rowbytes;
    unsigned* pan; int pmode;
    __device__ __forceinline__ unsigned row_off(const pg8::Unit& u, int r) const {
        const int pt = ptab[u.pm], e = pt & 255, local = (pt >> 8) * 256 + r;
        return local < (int)cnt[64 * e] ? (unsigned)(list[e * 16384 + local] >> 1) * rowbytes : 0u; }
    __device__ __forceinline__ bool next(int i, pg8::Unit& u) const { const int L = i * G + c; if (L >= nunits) return false; const int p = L >> SH; u.pm = p; u.pn = ((ptab[p] & 255) << SH) + (L & ((1 << SH) - 1)); return true; }
    __device__ __forceinline__ void a_ready(const pg8::Unit&) const {}
    __device__ __forceinline__ void wait_panels() const {
        if (threadIdx.x == 0) {
#pragma unroll 1
            for (int L = c; L < nunits; L += G) { unsigned sp = 0;
                while (__hip_atomic_load(pan + 64 * (L >> SH), RLX_AGENT) < (unsigned)PAN_NEED && ++sp < (1u << 22)) __builtin_amdgcn_s_sleep(16); } }
        __syncthreads();
        __builtin_amdgcn_fence(__ATOMIC_ACQUIRE, "agent");
    }
    __device__ __forceinline__ void done(const pg8::Unit& u) const {
        if (pmode == 1) { asm volatile("s_waitcnt vmcnt(0)" ::: "memory");
            if ((threadIdx.x & 63) == 0) __hip_atomic_fetch_add(pan + 64 * u.pm, 1u, __ATOMIC_RELAXED, __HIP_MEMORY_SCOPE_AGENT); } }
};
typedef MoeOrderT<false> MoeOrder; typedef MoeOrderT<true> MoeGatherOrder;
struct EpiSwiGLU {
    static constexpr bool PERM = true, AFTER_DRAIN = false;
    bf16* hmid; const int* list; const unsigned* cnt; const float* rstd; const LAS int* ptab;
    __device__ __forceinline__ void operator()(const pg8::f32x4 (&acc)[2][2][4][2], const pg8::Unit& u, int wr, int wc, int fr, int fq) const {
        const int pt = ptab[u.pm], e = pt & 255, lbase = (pt >> 8) * 256, n_e = (int)cnt[64 * e], pnl = u.pn & 1;
#pragma unroll
        for (int ai = 0; ai < 2; ++ai)
#pragma unroll
            for (int m = 0; m < 4; ++m) { const int rl = ai * 128 + wr * 64 + m * 16 + fr;
                if (lbase + rl < n_e) { const float rs = rstd[list[e * 16384 + lbase + rl] >> 1];
                    float h[8];
#pragma unroll
                    for (int n = 0; n < 2; ++n)
#pragma unroll
                        for (int k = 0; k < 4; ++k) h[4 * n + k] = silu_f(acc[ai][0][m][n][k] * rs) * (acc[ai][1][m][n][k] * rs);
                    v4u o; o.x = pk2(h[0], h[1]); o.y = pk2(h[2], h[3]); o.z = pk2(h[4], h[5]); o.w = pk2(h[6], h[7]);
                    store16_sc1<0>(hmid + (size_t)(u.pm * 256 + rl) * EFF + pnl * 128 + wc * 32 + 8 * fq, o); } }
    }
};
struct EpiDown {
    static constexpr bool PERM = true, AFTER_DRAIN = false;
    bf16* y2; const int* list; const unsigned* cnt; const float* gate; const LAS int* ptab;
    __device__ __forceinline__ void operator()(const pg8::f32x4 (&acc)[2][2][4][2], const pg8::Unit& u, int wr, int wc, int fr, int fq) const {
        const int pt = ptab[u.pm], e = pt & 255, lbase = (pt >> 8) * 256, n_e = (int)cnt[64 * e], pnl = u.pn & 3;
#pragma unroll
        for (int ai = 0; ai < 2; ++ai)
#pragma unroll
            for (int m = 0; m < 4; ++m) { const int rl = ai * 128 + wr * 64 + m * 16 + fr;
                if (lbase + rl < n_e) { const int pair = list[e * 16384 + lbase + rl]; const float g = gate[pair];
#pragma unroll
                    for (int bj = 0; bj < 2; ++bj) { const pg8::f32x4 v0 = acc[ai][bj][m][0] * g, v1 = acc[ai][bj][m][1] * g;
                        v4u o; o.x = pk2(v0[0], v0[1]); o.y = pk2(v0[2], v0[3]); o.z = pk2(v1[0], v1[1]); o.w = pk2(v1[2], v1[3]);
                        *(GAS v4u*)(y2 + (size_t)pair * D + pnl * 256 + bj * 128 + wc * 32 + 8 * fq) = o; } } }
    }
};
__device__ __forceinline__ void p10_final(Frame& F, const float* lnw, float* dst) {
    const int gw = F.vcu * NWAVES + F.wave, NGW = F.G * NWAVES, lane = F.lane;
    const bf16* y2 = (const bf16*)(F.ws + WS_Y2);
    f32x4 lw[4];
#pragma unroll
    for (int j = 0; j < 4; ++j) lw[j] = ((const f32x4*)lnw)[lane + 64 * j];
#pragma unroll 1
    for (int tok = gw; tok < T; tok += NGW) {
        GAS f32x4* xr = (GAS f32x4*)(F.out + (size_t)tok * D) + lane;
        const GAS v2u* ya = (const GAS v2u*)(y2 + (size_t)(2 * tok) * D) + lane; const GAS v2u* yb = (const GAS v2u*)(y2 + (size_t)(2 * tok + 1) * D) + lane;
        f32x4 v[4]; float s = 0.f;
#pragma unroll
        for (int j = 0; j < 4; ++j) { const f32x4 x = xr[64 * j]; const v2u a = ya[64 * j], b = yb[64 * j];
            v[j].x = x.x + (bf2f((unsigned short)(a.x & 0xffffu)) + bf2f((unsigned short)(b.x & 0xffffu))); v[j].y = x.y + (bf2f((unsigned short)(a.x >> 16)) + bf2f((unsigned short)(b.x >> 16)));
            v[j].z = x.z + (bf2f((unsigned short)(a.y & 0xffffu)) + bf2f((unsigned short)(b.y & 0xffffu))); v[j].w = x.w + (bf2f((unsigned short)(a.y >> 16)) + bf2f((unsigned short)(b.y >> 16)));
            s += (v[j].x * v[j].x + v[j].y * v[j].y) + (v[j].z * v[j].z + v[j].w * v[j].w); }
        const float r = rsqrtf(wave_sum(s) * (1.f / D) + EPS);
        GAS f32x4* xo = (GAS f32x4*)(dst + (size_t)tok * D) + lane;
#pragma unroll
        for (int j = 0; j < 4; ++j) xo[64 * j] = v[j] * r * lw[j];
    }
}
struct EpiResF32 {
    static constexpr bool PERM = false, AFTER_DRAIN = false;
    const float* base; float* out; int ldc;
    __device__ __forceinline__ void operator()(const pg8::f32x4 (&acc)[2][2][4][2], const pg8::Unit& u, int wr, int wc, int fr, int fq) const {
        const int col0 = u.pn * 256 + wc * 32 + 4 * fq;
#pragma unroll
        for (int ai = 0; ai < 2; ++ai)
#pragma unroll
            for (int m = 0; m < 4; ++m) { const size_t off = (size_t)(u.pm * 256 + ai * 128 + wr * 64 + m * 16 + fr) * ldc + col0;
#pragma unroll
                for (int bj = 0; bj < 2; ++bj)
#pragma unroll
                    for (int n = 0; n < 2; ++n) { const pg8::f32x4 bs = *(const pg8::f32x4*)(base + off + bj * 128 + n * 16); *(pg8::f32x4*)(out + off + bj * 128 + n * 16) = bs + acc[ai][bj][m][n]; }
                if (m & 1) asm volatile("" ::: "memory"); }
    }
};
struct Args { const float* in[17]; float* out; unsigned char* ws; int ph_lo, ph_hi, li, pad; };
__global__ void __launch_bounds__(NTHR, 2) mk_fwd(Args args) {
    extern __shared__ __attribute__((aligned(16))) unsigned char lds[];
    Frame F;
    F.lds = (LAS unsigned char*)lds;
    F.MISC = (volatile LAS unsigned*)(F.lds + MISC_OFF);
    F.tid = threadIdx.x; F.lane = F.tid & 63; F.wave = __builtin_amdgcn_readfirstlane(F.tid >> 6);
    F.G = gridDim.x; { const int bx = blockIdx.x; F.vcu = (F.G % 8 == 0) ? (bx % 8) * (F.G / 8) + bx / 8 : bx; }
    F.ws = args.ws; F.out = args.out; F.li = args.li; F.ctl = (gu32*)(args.ws + WS_CTL);
    for (int u = F.tid; u < (LDS_BYTES - LDSCTL_OFF) / 4; u += NTHR) ((LAS unsigned*)(F.lds + LDSCTL_OFF))[u] = 0u;
    __syncthreads();
    XcdBarrier bar = xcd_barrier_post((unsigned*)(F.ctl + CW_BAR) + args.li * XCD_BAR_WORDS, F.MISC + 8);
    const int lo = args.ph_lo, hi = args.ph_hi;
#define IN(k) (lo <= (k) && (k) < hi)
#define BOTH(k) (IN(k) && IN((k) + 1))
#define GRID_BAR() xcd_barrier(bar)
#define PHASE_BEGIN() do { int t_ = threadIdx.x; asm volatile("" : "+v"(t_)); F.tid = t_; F.lane = t_ & 63; } while (0)
    if (IN(0)) { PHASE_BEGIN(); p0_prologue(F, args.in[I_X], args.in[I_LNMIX], args.in[I_WIN], args.in[I_WOUT], args.in[I_ALOG], args.in[I_DTB]); p0_rot_table(F); p0_router_weights(F, args.in[I_LNFFN], args.in[I_WG], args.in[I_WE]); if (BOTH(0)) GRID_BAR(); }
    if (IN(1)) { PHASE_BEGIN();
        pg8::Gemm g{(const bf16*)(F.ws + WS_HN), (const bf16*)(F.ws + WS_WIN), T, NPROJ, D}; pg8::StaticOrder S; S.init(T, NPROJ, F.G, (int)blockIdx.x);
        pg8::EpiBf16<0> E{(bf16*)(F.ws + WS_PROJ), NPROJ, nullptr, 0, 0, 1.f};
        pg8::gemm_phase<pg8::EpiBf16<0>, pg8::StaticOrder, true, true>(F.lds, g, S, E);
        if (BOTH(1)) GRID_BAR();
    }
    if (IN(2)) { PHASE_BEGIN();
#pragma unroll 1
        for (int grp = blockIdx.x; grp < 256; grp += F.G) p2_group(F, grp, args.in[I_CONV], (const float*)(F.ws + WS_BG));
        if (BOTH(2)) GRID_BAR();
    }
    if (IN(3) || IN(17) || IN(18)) { PHASE_BEGIN(); const int skipq = IN(17) ? 1 : IN(18) ? 3 : 0;
        const int x = blockIdx.x;
        if (x < 32) p3_scan(F, (x & 7) + 8 * (x >> 4), (x >> 3) & 1, 0);
        {
            LAS int* wq = (LAS int*)(F.lds + LT_WQ);
#pragma unroll 1
            for (;;) {
                if (F.tid == 0) *wq = (int)atomicAdd((unsigned*)(F.ctl + CW_WQ + 64 * F.li), 1u);
                __syncthreads();
                const int it = *wq;
                __syncthreads();
                if (it >= 512 + 384 + 480 + 256) break;
                if (it < 384) { if (!(skipq & 1)) p3_moe_weight_items(F, it * 64 + F.wave, NWAVES, it * 64 + 64, args.in[I_WGU], args.in[I_WD]); }
                else if (it < 384 + 512) { if (!(skipq & 2)) p3_attn_unit(F, it - 384, args.in[I_SINK]); }
                else { const int ob = it - (512 + 384); if (ob < 480) p3_out_batch(F, ob * 8, 8, F.out); else p3_out_batch(F, 3840 + (ob - 480), 1, F.out); }
            }
        }
        if (BOTH(3)) GRID_BAR();
    }
    if (IN(4)) { PHASE_BEGIN(); p4_combine(F, F.out, args.in[I_DNNORM]); if (BOTH(4)) GRID_BAR(); }
    if (IN(5)) { PHASE_BEGIN();
        pg8::Gemm g{(const bf16*)(F.ws + WS_MIX), (const bf16*)(F.ws + WS_WOUT), T, D, D}; pg8::StaticOrder S; S.init(T, D, F.G, (int)blockIdx.x);
        EpiResF32 E{args.in[I_X], F.out, D};
        pg8::gemm_phase<EpiResF32, pg8::StaticOrder, true, true>(F.lds, g, S, E);
        if (BOTH(5)) GRID_BAR();
    }
    if (IN(6) || IN(12)) { PHASE_BEGIN(); p6_route(F, args.in[I_LNFFN], args.in[I_BG], args.in[I_BE], IN(12) ? 1 : 0); if (BOTH(6)) GRID_BAR(); }
    if (IN(8)) { PHASE_BEGIN();
        const int NP = moe_tables(F);
        pg8::Gemm g{(const bf16*)(F.ws + WS_HN), (const bf16*)(F.ws + WS_WGU), NP * 256, NEXP * 512, D};
        MoeGatherOrder S{NP * 2, F.G, (int)blockIdx.x, 1, (const LAS int*)(F.lds + LT_PTAB), (const int*)(F.ws + WS_LIST), (const unsigned*)(F.ctl + CW_CNT), (unsigned)(D * 2), (unsigned*)(F.ctl + CW_PAN), 1};
        EpiSwiGLU E{(bf16*)(F.ws + WS_HMID), (const int*)(F.ws + WS_LIST), (const unsigned*)(F.ctl + CW_CNT), (const float*)(F.ws + RW_RSTD), (const LAS int*)(F.lds + LT_PTAB)};
        pg8::gemm_phase<EpiSwiGLU, MoeGatherOrder, true, true>(F.lds, g, S, E);
    }
    if (IN(9)) { PHASE_BEGIN();
        const int NP = moe_tables(F);
        pg8::Gemm g{(const bf16*)(F.ws + WS_HMID), (const bf16*)(F.ws + WS_WD), NP * 256, NEXP * D, EFF};
        int r8 = NP * 2 - F.G; r8 = r8 < 0 ? 0 : r8; const int pe4 = (NP < F.G / 2 ? NP : F.G / 2) * 4, bx = (int)blockIdx.x;
        const bool late = r8 > 0 && bx < r8 && r8 < F.G;
        MoeOrder S{late ? NP * 4 : (r8 > 0 && r8 < F.G ? pe4 : NP * 4), late ? r8 : (r8 > 0 && r8 < F.G ? F.G - r8 : F.G), late ? pe4 + bx : (r8 > 0 && r8 < F.G ? bx - r8 : bx), 2,
                   (const LAS int*)(F.lds + LT_PTAB), nullptr, nullptr, 0u, (unsigned*)(F.ctl + CW_PAN), 0};
        S.wait_panels();
        EpiDown E{(bf16*)(F.ws + WS_Y2), (const int*)(F.ws + WS_LIST), (const unsigned*)(F.ctl + CW_CNT), (const float*)(F.ws + RW_GATE), (const LAS int*)(F.lds + LT_PTAB)};
        pg8::gemm_phase<EpiDown, MoeOrder, true, true>(F.lds, g, S, E);
        if (BOTH(9)) GRID_BAR();
    }
#ifdef PROBE_PHASES
    if (IN(11) || IN(14) || IN(15) || IN(16)) { PHASE_BEGIN(); const int x = blockIdx.x; if (x < 32) p3_scan(F, (x & 7) + 8 * (x >> 4), (x >> 3) & 1, IN(14) ? 1 : IN(15) ? 3 : IN(16) ? 5 : 0); }
#endif
    if (IN(10) || IN(13)) { PHASE_BEGIN(); p10_final(F, args.in[I_LNF], IN(13) ? (float*)(F.ws + WS_PROJ) : F.out); }
#undef IN
#undef BOTH
}

__global__ void k_shim_proj(const bf16* __restrict__ pb, float* __restrict__ pf) {
    const size_t i = (size_t)blockIdx.x * blockDim.x + threadIdx.x; if (i >= (size_t)T * NPROJ) return;
    const int tok = (int)(i / NPROJ), c = (int)(i % NPROJ);
    pf[(size_t)tok * INW + (c < 2048 ? c : c + 16)] = bf2f(pb[i]);
}
}

extern "C" void kernel_launch(void* const* d_in, const int* in_sizes, int n_in, void* d_out, int out_size, void* d_ws, size_t ws_size, hipStream_t stream) {
    using namespace mk;
    static int grid = 0;
    if (grid == 0) {
        if (n_in != 17 || out_size != T * D || ws_size < 511 * MiB) { fprintf(stderr, "kernel_launch: unexpected sizes (n_in %d out %d ws %zu)\n", n_in, out_size, ws_size); grid = -1; return; }
        int dev = 0, cus = 0, per_cu = 0;
        if (hipGetDevice(&dev) != hipSuccess || hipDeviceGetAttribute(&cus, hipDeviceAttributeMultiprocessorCount, dev) != hipSuccess) { grid = -1; return; }
        if (hipFuncSetAttribute((const void*)mk_fwd, hipFuncAttributeMaxDynamicSharedMemorySize, LDS_BYTES) != hipSuccess) { fprintf(stderr, "kernel_launch: hipFuncSetAttribute failed\n"); grid = -1; return; }
        if (hipOccupancyMaxActiveBlocksPerMultiprocessor(&per_cu, (const void*)mk_fwd, NTHR, LDS_BYTES) != hipSuccess || per_cu < 1) { fprintf(stderr, "kernel_launch: occupancy query says %d blocks/CU\n", per_cu); grid = -1; (void)hipGetLastError(); return; }
        grid = cus;
    }
    if (grid < 0) return;
    (void)hipMemsetAsync((char*)d_ws + WS_CTL, 0, CTL_ZERO_BYTES, stream);
    Args a{};
    for (int i = 0; i < 17; ++i) a.in[i] = (const float*)d_in[i];
    a.out = (float*)d_out; a.ws = (unsigned char*)d_ws; a.pad = 0;
#ifndef LAUNCH_PLAN
#define LAUNCH_PLAN {0, 11}
#endif
    const int plan[] = LAUNCH_PLAN; const int nl = (int)(sizeof(plan) / sizeof(int)) / 2;
    for (int li = 0; li < nl; ++li) {
        a.ph_lo = plan[2 * li]; a.ph_hi = plan[2 * li + 1]; a.li = li;
        void* kargs[] = {&a};
        hipError_t e = hipLaunchCooperativeKernel((const void*)mk_fwd, dim3(grid), dim3(NTHR), kargs, LDS_BYTES, stream);
        if (e != hipSuccess) { fprintf(stderr, "cooperative launch failed: %s (grid %d)\n", hipGetErrorString(e), grid); return; }
    }
}
```

```cpp
#include <hip/hip_runtime.h>
#include <cstdint>
#include <cstdio>
namespace pg8 {
#define PG8_LAS __attribute__((address_space(3)))
typedef unsigned short bf16_t;
typedef short bf16x8 __attribute__((ext_vector_type(8)));
typedef float f32x4 __attribute__((ext_vector_type(4)));
typedef unsigned u32x4 __attribute__((ext_vector_type(4)));
constexpr int BM = 256, BK = 64, HALF = 128, HTB = HALF * BK * 2  , STAGE_BYTES = 8 * HTB, NXCD = 8, WGM = 8;

__host__ __device__ __forceinline__ int lds_byte(int r, int c) { const int st = (r >> 4) * 2 + (c >> 5), rr = r & 15, cc = c & 31, ob = rr * 64 + cc * 2; return st * 1024 + (ob ^ (((ob >> 9) & 1) << 5)); }
__host__ __device__ __forceinline__ void stage_rc(int b, int& R, int& C) { const int st = b / 1024, sb = b % 1024, swz = sb ^ (((sb >> 9) & 1) << 5); R = (st >> 1) * 16 + swz / 64; C = (st & 1) * 32 + (swz % 64) / 2; }
__host__ __device__ __forceinline__ int perm32(int rho) { const int n = rho >> 4, i = rho & 15; return 8 * (i >> 2) + 4 * n + (i & 3); }

struct Unit { int pm, pn; };
struct Gemm { const bf16_t* A; const bf16_t* Bt; int M, N, K; };

struct StaticOrder {
    static constexpr bool GATHER = false;
    int nM, nN, nwg, G, c;
    __device__ __forceinline__ unsigned row_off(const Unit&, int) const { return 0u; }
    __host__ __device__ void init(int M, int N, int G_, int c_) { nM = M / BM; nN = N / BM; nwg = nM * nN; G = G_; c = c_; }
    __host__ __device__ bool next(int i, Unit& u) const {
        const long L = (long)i * G + c; if (L >= nwg) return false;
        int wgid = (int)L; { const int q = nwg / NXCD, r = nwg % NXCD, xcd = wgid % NXCD, off = wgid / NXCD; wgid = (xcd < r ? xcd * (q + 1) : r * (q + 1) + (xcd - r) * q) + off; }
        const int nig = WGM * nN, gid = wgid / nig, fm = gid * WGM, gsz = (nM - fm) < WGM ? (nM - fm) : WGM;
        u.pm = fm + ((wgid % nig) % gsz); u.pn = (wgid % nig) / gsz; return true;
    }
    __device__ __forceinline__ void a_ready(const Unit&) const {}
    __device__ __forceinline__ void done(const Unit&) const {}
};

__device__ __forceinline__ unsigned cvt_pk_bf16(float lo, float hi) { unsigned r; asm volatile("v_cvt_pk_bf16_f32 %0, %1, %2" : "=v"(r) : "v"(lo), "v"(hi)); return r; }
typedef float f32x2 __attribute__((ext_vector_type(2)));
__device__ __forceinline__ f32x2 gelu_pk(f32x2 v) {
    const f32x2 av = __builtin_elementwise_abs(v), d = av * 0.2316418882f + 1.0f;
    f32x2 t; t.x = __builtin_amdgcn_rcpf(d.x); t.y = __builtin_amdgcn_rcpf(d.y);
    f32x2 q = t * 0.5307027145f + (-0.7265760135f); q = q * t + 0.7107068705f; q = q * t + (-0.142248368f); q = q * t + 0.127414796f; q = q * t;
    const f32x2 s = (v * v) * (-0.72134752044f);
    f32x2 e; e.x = __builtin_amdgcn_exp2f(s.x); e.y = __builtin_amdgcn_exp2f(s.y);
    const f32x2 m = v * (q * e), r = v - m;
    f32x2 o; o.x = v.x < 0.f ? m.x : r.x; o.y = v.y < 0.f ? m.y : r.y; return o;
}

template <int ACT  > struct EpiBf16 {
    static constexpr bool PERM = true, AFTER_DRAIN = false; static_assert(ACT == 0 || ACT == 1, "EpiBf16: ACT is 0 (none) or 1 (gelu_pk)");
    bf16_t* O; int ldc; const float* bias; int split_cols; size_t split_stride; float scale0;
    __device__ __forceinline__ void operator()(const f32x4 (&acc)[2][2][4][2], const Unit& u, int wr, int wc, int fr, int fq) const {
        const int row0 = u.pm * BM + wr * 64 + fr; int colt = u.pn * BM; bf16_t* base = O;
        float sc = 1.f; if (split_cols) { const int t = colt / split_cols; base += (size_t)t * split_stride; colt -= t * split_cols; if (t == 0) sc = scale0; }
        const int col0 = colt + wc * 32 + 8 * fq, bcol0 = u.pn * BM + wc * 32 + 8 * fq;
        f32x4 bv[2][2];
#pragma unroll
        for (int bj = 0; bj < 2; ++bj)
#pragma unroll
            for (int n = 0; n < 2; ++n) bv[bj][n] = bias ? *(const f32x4*)(bias + bcol0 + bj * HALF + 4 * n) : (f32x4){0.f, 0.f, 0.f, 0.f};
#pragma unroll
        for (int ai = 0; ai < 2; ++ai)
#pragma unroll
            for (int m = 0; m < 4; ++m) { bf16_t* rowp = base + (size_t)(row0 + ai * HALF + m * 16) * ldc + col0;
#pragma unroll
                for (int bj = 0; bj < 2; ++bj) { f32x4 v0 = acc[ai][bj][m][0] + bv[bj][0], v1 = acc[ai][bj][m][1] + bv[bj][1];
                    if (ACT == 1) { f32x2 a = gelu_pk((f32x2){v0[0], v0[1]}), b = gelu_pk((f32x2){v0[2], v0[3]}), c = gelu_pk((f32x2){v1[0], v1[1]}), d = gelu_pk((f32x2){v1[2], v1[3]});
                        v0 = (f32x4){a.x, a.y, b.x, b.y}; v1 = (f32x4){c.x, c.y, d.x, d.y}; }
                    v0 = v0 * sc; v1 = v1 * sc; u32x4 w; w.x = cvt_pk_bf16(v0[0], v0[1]); w.y = cvt_pk_bf16(v0[2], v0[3]); w.z = cvt_pk_bf16(v1[0], v1[1]); w.w = cvt_pk_bf16(v1[2], v1[3]);
                    *(u32x4*)(rowp + bj * HALF) = w; } }
    }
};
template <class Epi, class Sched, bool ALIGN_EPI = false, bool SP2 = false>
__device__ __forceinline__ void gemm_phase(PG8_LAS unsigned char* lds, const Gemm g, const Sched& S, const Epi& E) {
    int tid_ = threadIdx.x; asm volatile("" : "+v"(tid_));
    const int tid = tid_, wid = __builtin_amdgcn_readfirstlane(tid >> 6), lane = tid & 63, wr = wid >> 2, wc = wid & 3, fr = lane & 15, fq = lane >> 4;
    const int K = g.K, nt = K / BK;
    unsigned voffA[2], voffB[2];
    constexpr bool GATHER = Sched::GATHER;
    unsigned gA[2][2], nGA[2][2]; int rowA[2], colA[2];
#pragma unroll
    for (int i = 0; i < 2; ++i) { int R, C; stage_rc(tid * 16 + i * 8192, R, C); const int Rb = Epi::PERM ? ((R & ~31) + perm32(R & 31)) : R;
        voffA[i] = (unsigned)(R * K + C) * 2u; voffB[i] = (unsigned)(Rb * K + C) * 2u; rowA[i] = R; colA[i] = C; }
    const size_t kstep = (size_t)(BK * 2);
    const size_t hstep = (size_t)HALF * K * 2;
    const size_t tstep = 2 * hstep;
    const size_t hstepA = GATHER ? 0 : hstep, tstepA = GATHER ? 0 : tstep;
    const unsigned ldsw = (unsigned)wid * 1024u;
    const int aoff = lds_byte(wr * 64 + fr, fq * 8), boff = lds_byte(wc * 32 + fr, fq * 8);
#define PG8_SA(b, h) (((b) * 2 + (h)) * HTB)
#define PG8_SB(b, h) ((4 + (b) * 2 + (h)) * HTB)
#define PG8_STAGE(bufoff, gbase, voff) do { _Pragma("unroll") for (int _i = 0; _i < 2; ++_i) \
        __builtin_amdgcn_global_load_lds((const unsigned*)((const char*)(gbase) + (voff)[_i]), (PG8_LAS unsigned*)(lds + (bufoff) + ldsw + _i * 8192), 16, 0, 0); } while (0)
#define PG8_STAGE_A(bufoff, gbase, h, nx) do { if constexpr (GATHER) { if (nx) PG8_STAGE(bufoff, gbase, nGA[h]); else PG8_STAGE(bufoff, gbase, gA[h]); } else PG8_STAGE(bufoff, gbase, voffA); } while (0)
#define PG8_GOFF(dst, unit) do { if constexpr (GATHER) { _Pragma("unroll") for (int h_ = 0; h_ < 2; ++h_) _Pragma("unroll") for (int i_ = 0; i_ < 2; ++i_) dst[h_][i_] = S.row_off(unit, h_ * HALF + rowA[i_]) + (unsigned)colA[i_] * 2u; \
        asm volatile("s_waitcnt vmcnt(0)" : "+v"(dst[0][0]), "+v"(dst[0][1]), "+v"(dst[1][0]), "+v"(dst[1][1]) :: "memory"); } } while (0)
#define PG8_LDA(dst, b, h) do { _Pragma("unroll") for (int m = 0; m < 4; ++m) _Pragma("unroll") for (int k = 0; k < 2; ++k) dst[m][k] = *(const PG8_LAS bf16x8*)(lds + PG8_SA(b, h) + aoff + m * 2048 + k * 1024); } while (0)
#define PG8_LDB(dst, b, h) do { _Pragma("unroll") for (int n = 0; n < 2; ++n) _Pragma("unroll") for (int k = 0; k < 2; ++k) dst[n][k] = *(const PG8_LAS bf16x8*)(lds + PG8_SB(b, h) + boff + n * 2048 + k * 1024); } while (0)
#define PG8_MMA(ai, bj, At, Bt) do { __builtin_amdgcn_s_setprio(1); _Pragma("unroll") for (int m = 0; m < 4; ++m) _Pragma("unroll") for (int n = 0; n < 2; ++n) _Pragma("unroll") for (int k = 0; k < 2; ++k) \
        acc[ai][bj][m][n] = __builtin_amdgcn_mfma_f32_16x16x32_bf16(Bt[n][k], At[m][k], acc[ai][bj][m][n], 0, 0, 0); __builtin_amdgcn_s_setprio(0); } while (0)
#define PG8_WAIT_V(n) asm volatile("s_waitcnt vmcnt(" #n ")" ::: "memory")
#define PG8_WAIT_L(n) asm volatile("s_waitcnt lgkmcnt(" #n ")" ::: "memory")
#define PG8_BAR __builtin_amdgcn_s_barrier()
#define PG8_SCHED __builtin_amdgcn_sched_barrier(0)
    Unit cur, nxt; int ui = 0;
    if (!S.next(0, cur)) return;
    f32x4 acc[2][2][4][2];
#pragma unroll
    for (int a = 0; a < 2; ++a)
#pragma unroll
        for (int b = 0; b < 2; ++b)
#pragma unroll
            for (int m = 0; m < 4; ++m)
#pragma unroll
                for (int n = 0; n < 2; ++n) acc[a][b][m][n] = (f32x4){0.f, 0.f, 0.f, 0.f};
    bf16x8 At[4][2], B0[2][2], B1[2][2];
    const char* cA = (const char*)g.A + (size_t)cur.pm * tstepA; const char* cB = (const char*)g.Bt + (size_t)cur.pn * tstep;
    PG8_GOFF(gA, cur);
    S.a_ready(cur);
    if constexpr (SP2) {
        PG8_STAGE(PG8_SB(0, 0), cB, voffB); PG8_STAGE(PG8_SB(0, 1), cB + hstep, voffB); PG8_STAGE_A(PG8_SA(0, 0), cA, 0, false); PG8_STAGE_A(PG8_SA(0, 1), cA + hstepA, 1, false);
        if (wr == 1) PG8_BAR;
        PG8_WAIT_V(2); PG8_BAR;
        PG8_STAGE(PG8_SB(1, 0), cB + kstep, voffB); PG8_STAGE_A(PG8_SA(1, 0), cA + kstep, 0, false); PG8_STAGE(PG8_SB(1, 1), cB + hstep + kstep, voffB);
        PG8_WAIT_V(6); PG8_BAR;
    } else {
        PG8_STAGE(PG8_SB(0, 0), cB, voffB); PG8_STAGE_A(PG8_SA(0, 0), cA, 0, false); PG8_STAGE(PG8_SB(0, 1), cB + hstep, voffB); PG8_STAGE_A(PG8_SA(0, 1), cA + hstepA, 1, false);
        if (wr == 1) PG8_BAR;
        PG8_WAIT_V(4); PG8_BAR;
        PG8_STAGE(PG8_SB(1, 0), cB + kstep, voffB); PG8_STAGE_A(PG8_SA(1, 0), cA + kstep, 0, false); PG8_STAGE(PG8_SB(1, 1), cB + hstep + kstep, voffB);
        PG8_WAIT_V(6); PG8_BAR;
    }
    for (;;) {
        const bool has_next = S.next(ui + 1, nxt);
        if constexpr (GATHER) { if (has_next) PG8_GOFF(nGA, nxt); else { _Pragma("unroll") for (int h_ = 0; h_ < 2; ++h_) _Pragma("unroll") for (int i_ = 0; i_ < 2; ++i_) nGA[h_][i_] = gA[h_][i_]; } }
        const char* nA = has_next ? (const char*)g.A + (size_t)nxt.pm * tstepA : cA; const char* nB = has_next ? (const char*)g.Bt + (size_t)nxt.pn * tstep : cB;
        for (int t = 0; t < nt; t += 2) {
            const bool last = (t == nt - 2);
            const char* a1 = cA + (size_t)(t + 1) * kstep;
            const char* a2 = last ? nA : cA + (size_t)(t + 2) * kstep; const char* b2 = last ? nB : cB + (size_t)(t + 2) * kstep;
            const char* a3 = a2 + kstep; const char* b3 = b2 + kstep;
            if (last && has_next) S.a_ready(nxt);
            if constexpr (SP2) {
            PG8_LDB(B0, 0, 0); PG8_LDB(B1, 0, 1); PG8_SCHED; PG8_LDA(At, 0, 0); PG8_STAGE_A(PG8_SA(1, 1), a1 + hstepA, 1, false);
            PG8_WAIT_V(8); PG8_WAIT_L(0); PG8_BAR; PG8_MMA(0, 0, At, B0); PG8_MMA(0, 1, At, B1); PG8_BAR; PG8_SCHED;
            PG8_LDA(At, 0, 1); PG8_STAGE(PG8_SB(0, 0), b2, voffB); PG8_STAGE(PG8_SB(0, 1), b2 + hstep, voffB); PG8_STAGE_A(PG8_SA(0, 0), a2, 0, last);
            PG8_WAIT_V(8); PG8_WAIT_L(0); PG8_BAR; PG8_MMA(1, 0, At, B0); PG8_MMA(1, 1, At, B1); PG8_BAR; PG8_SCHED;
            PG8_LDB(B0, 1, 0); PG8_LDB(B1, 1, 1); PG8_SCHED; PG8_LDA(At, 1, 0); PG8_STAGE_A(PG8_SA(0, 1), a2 + hstepA, 1, last);
            PG8_WAIT_V(8); PG8_WAIT_L(0); PG8_BAR; PG8_MMA(0, 0, At, B0); PG8_MMA(0, 1, At, B1); PG8_BAR; PG8_SCHED;
            PG8_LDA(At, 1, 1); PG8_STAGE(PG8_SB(1, 0), b3, voffB); PG8_STAGE(PG8_SB(1, 1), b3 + hstep, voffB); PG8_STAGE_A(PG8_SA(1, 0), a3, 0, last);
            PG8_WAIT_V(8); PG8_WAIT_L(0); PG8_BAR; PG8_MMA(1, 0, At, B0); PG8_MMA(1, 1, At, B1); PG8_BAR; PG8_SCHED;
            } else {
            PG8_LDB(B0, 0, 0); PG8_SCHED; PG8_LDA(At, 0, 0); PG8_STAGE_A(PG8_SA(1, 1), a1 + hstepA, 1, false);
            PG8_WAIT_L(8); PG8_BAR; PG8_WAIT_L(0); PG8_MMA(0, 0, At, B0); PG8_BAR; PG8_SCHED;
            PG8_LDB(B1, 0, 1); PG8_STAGE(PG8_SB(0, 0), b2, voffB);
            PG8_BAR; PG8_WAIT_L(0); PG8_MMA(0, 1, At, B1); PG8_BAR;
            PG8_LDA(At, 0, 1); PG8_STAGE_A(PG8_SA(0, 0), a2, 0, last);
            PG8_BAR; PG8_WAIT_L(0); PG8_MMA(1, 0, At, B0); PG8_BAR; PG8_SCHED;
            PG8_STAGE(PG8_SB(0, 1), b2 + hstep, voffB);
            PG8_WAIT_V(6); PG8_BAR; PG8_MMA(1, 1, At, B1); PG8_BAR;
            PG8_LDB(B0, 1, 0); PG8_SCHED; PG8_LDA(At, 1, 0); PG8_STAGE_A(PG8_SA(0, 1), a2 + hstepA, 1, last);
            PG8_WAIT_L(8); PG8_BAR; PG8_WAIT_L(0); PG8_MMA(0, 0, At, B0); PG8_BAR; PG8_SCHED;
            PG8_LDB(B1, 1, 1); PG8_STAGE(PG8_SB(1, 0), b3, voffB);
            PG8_BAR; PG8_WAIT_L(0); PG8_MMA(0, 1, At, B1); PG8_BAR;
            PG8_LDA(At, 1, 1); PG8_STAGE_A(PG8_SA(1, 0), a3, 0, last);
            PG8_BAR; PG8_WAIT_L(0); PG8_MMA(1, 0, At, B0); PG8_BAR; PG8_SCHED;
            PG8_STAGE(PG8_SB(1, 1), b3 + hstep, voffB);
            PG8_WAIT_V(6); PG8_BAR; PG8_MMA(1, 1, At, B1); PG8_BAR;
            }
        }
        if constexpr (ALIGN_EPI) { if (wr == 0) PG8_BAR; }
        if constexpr (!Epi::AFTER_DRAIN) { E(acc, cur, wr, wc, fr, fq); S.done(cur); }
        if (!has_next) break;
#pragma unroll
        for (int a = 0; a < 2; ++a)
#pragma unroll
            for (int b = 0; b < 2; ++b)
#pragma unroll
                for (int m = 0; m < 4; ++m)
#pragma unroll
                    for (int n = 0; n < 2; ++n) acc[a][b][m][n] = (f32x4){0.f, 0.f, 0.f, 0.f};
        cur = nxt; cA = nA; cB = nB; ++ui;
        if constexpr (GATHER) { _Pragma("unroll") for (int h_ = 0; h_ < 2; ++h_) _Pragma("unroll") for (int i_ = 0; i_ < 2; ++i_) gA[h_][i_] = nGA[h_][i_]; }
        if constexpr (ALIGN_EPI) { if (wr == 1) PG8_BAR; }
    }
    PG8_WAIT_V(0);
    if constexpr (!ALIGN_EPI) { if (wr == 0) PG8_BAR; }
    PG8_BAR;
    if constexpr (Epi::AFTER_DRAIN) { E.fused(acc, cur, wr, wc, fr, fq, lds, wid, lane); S.done(cur); }
#undef PG8_SA
#undef PG8_SB
#undef PG8_STAGE
#undef PG8_STAGE_A
#undef PG8_GOFF
#undef PG8_LDA
#undef PG8_LDB
#undef PG8_MMA
#undef PG8_WAIT_V
#undef PG8_WAIT_L
#undef PG8_BAR
#undef PG8_SCHED
}
}
namespace mk {
constexpr int D = 1024, BATCH = 2, SEQ = 8192, T = BATCH * SEQ;
constexpr int INW = 2832, NPROJ = 2816;
constexpr int PJ_Q = 0, PJ_K = 512, PJ_V = 1024, PJ_Z = 1536, PJ_AQ = 2048, PJ_AK = 2560, PJ_AV = 2688;
constexpr int NEXP = 64, EFF = 256;
constexpr float EPS = 1e-6f;
constexpr int NWAVES = 8, NTHR = 512;
constexpr size_t MiB = 1u << 20;
constexpr size_t WS_CTL = 0, CTL_ZERO_BYTES = 1 * MiB;
constexpr size_t WS_WIN = 1 * MiB, WS_WOUT = 7 * MiB, WS_WGU = 9 * MiB, WS_WD = 73 * MiB;
constexpr size_t WS_HN = 105 * MiB, WS_BG = 137 * MiB, WS_MISC = 138 * MiB, WS_PROJ = 144 * MiB;
constexpr size_t WS_DN = 232 * MiB, WS_MIX = 456 * MiB, WS_END = 488 * MiB;
constexpr int CW_BAR = 4096;
constexpr int LDS_BYTES = 163840, RING_BYTES = 159744, LDSCTL_OFF = RING_BYTES, MISC_OFF = LDSCTL_OFF + 320;

#define GAS __attribute__((address_space(1)))
#define LAS __attribute__((address_space(3)))
typedef unsigned short bf16;
typedef unsigned v4u __attribute__((ext_vector_type(4)));
typedef float f32x4 __attribute__((ext_vector_type(4)));
typedef GAS unsigned gu32;
#define RLX_AGENT __ATOMIC_RELAXED, __HIP_MEMORY_SCOPE_AGENT
#define LDS_WAIT() asm volatile("s_waitcnt lgkmcnt(0)" ::: "memory")
#define VM_WAIT() asm volatile("s_waitcnt vmcnt(0)" ::: "memory")
__device__ __forceinline__ unsigned f2bf(float f) { unsigned u = __builtin_bit_cast(unsigned, f); return (u + 0x7fffu + ((u >> 16) & 1u)) >> 16; }
typedef float f32x2_t __attribute__((ext_vector_type(2))); typedef __bf16 bf16x2_t __attribute__((ext_vector_type(2)));
__device__ __forceinline__ unsigned pk2(float lo, float hi) { f32x2_t v = {lo, hi}; bf16x2_t b = __builtin_convertvector(v, bf16x2_t); return __builtin_bit_cast(unsigned, b); }
__device__ __forceinline__ float bf2f(unsigned short b) { return __builtin_bit_cast(float, (unsigned)b << 16); }
__device__ __forceinline__ float wave_sum(float v) {
#pragma unroll
    for (int o = 1; o < 64; o <<= 1) v += __shfl_xor(v, o);
    return v;
}
__device__ __forceinline__ float reduce16(float (&v)[16], int lane) {
    { const bool h = (lane & 32) != 0;
#pragma unroll
      for (int i = 0; i < 8; ++i) { const float keep = h ? v[i + 8] : v[i], send = h ? v[i] : v[i + 8]; v[i] = keep + __shfl_xor(send, 32); } }
    { const bool h = (lane & 16) != 0;
#pragma unroll
      for (int i = 0; i < 4; ++i) { const float keep = h ? v[i + 4] : v[i], send = h ? v[i] : v[i + 4]; v[i] = keep + __shfl_xor(send, 16); } }
    { const bool h = (lane & 8) != 0;
#pragma unroll
      for (int i = 0; i < 2; ++i) { const float keep = h ? v[i + 2] : v[i], send = h ? v[i] : v[i + 2]; v[i] = keep + __shfl_xor(send, 8); } }
    { const bool h = (lane & 4) != 0; const float keep = h ? v[1] : v[0], send = h ? v[0] : v[1]; v[0] = keep + __shfl_xor(send, 4); }
    v[0] += __shfl_xor(v[0], 2); v[0] += __shfl_xor(v[0], 1);
    return v[0];
}
__device__ __forceinline__ float silu_f(float x) { return x / (1.f + __expf(-x)); }
__device__ __forceinline__ float softplus_f(float x) { return fmaxf(x, 0.f) + log1pf(expf(-fabsf(x))); }

#define XB_TMO      128
#define XB_XCNT(j)  (256  + 64 * (j))
#define XB_XSUB(j)  (1280 + 64 * (j))
#define XB_XGEN(j)  (2304 + 64 * (j))
#define XB_TOP      3328
#define XB_TOPGEN   3392
#define XCD_BAR_WORDS 3456
#define XB_SPIN_CAP (1u << 22)
__device__ __forceinline__ unsigned xb_ld(unsigned* p)              { return __hip_atomic_load(p, __ATOMIC_RELAXED, __HIP_MEMORY_SCOPE_AGENT); }
__device__ __forceinline__ unsigned xb_add(unsigned* p, unsigned v) { return __hip_atomic_fetch_add(p, v, __ATOMIC_RELAXED, __HIP_MEMORY_SCOPE_AGENT); }
__device__ __forceinline__ unsigned xb_xcc_id() { return (unsigned)__builtin_amdgcn_s_getreg((3 << 11) | 20) & 0xFu; }
#define XB_SPIN(cond, bar) do { unsigned _sp = 0; while (cond) { __builtin_amdgcn_s_sleep(1); \
    if ((++_sp & 255u) == 0u) { if (xb_ld(&(bar)[XB_TMO])) break; if (_sp > XB_SPIN_CAP) { atomicAdd(&(bar)[XB_TMO], 1u); break; } } } } while (0)
struct XcdBarrier { unsigned* bar; unsigned x; volatile LAS unsigned* st; };
__device__ __forceinline__ XcdBarrier xcd_barrier_post(unsigned* bar, volatile LAS unsigned* st) {
    XcdBarrier b; b.bar = bar; b.x = xb_xcc_id(); b.st = st;
    if (threadIdx.x == 0) (void)xb_add(&bar[XB_XCNT(b.x)], 1u);
    return b;
}
__device__ __forceinline__ void xcd_barrier_complete(unsigned* bar, unsigned x, unsigned& nloc, unsigned& nx) {
    const unsigned G = gridDim.x * gridDim.y * gridDim.z;
    unsigned sum, cnt, mine, sp = 0u;
    for (;;) {
        sum = 0u; cnt = 0u; mine = 0u;
#pragma unroll
        for (unsigned j = 0; j < 16; ++j) { const unsigned c = xb_ld(&bar[XB_XCNT(j)]); sum += c; cnt += (c > 0u) ? 1u : 0u; mine = (j == x) ? c : mine; }
        if (sum == G) break;
        __builtin_amdgcn_s_sleep(1);
        if ((++sp & 255u) == 0u) { if (xb_ld(&bar[XB_TMO])) break; if (sp > XB_SPIN_CAP) { atomicAdd(&bar[XB_TMO], 1u); break; } }
    }
    nloc = mine > 0u ? mine : 1u; nx = cnt > 0u ? cnt : 1u;
}
__device__ __forceinline__ void xcd_barrier(const XcdBarrier& b) {
    asm volatile("s_waitcnt vmcnt(0)" ::: "memory");
    __syncthreads();
    if (threadIdx.x == 0) {
        unsigned* bar = b.bar;
        __builtin_amdgcn_s_waitcnt(0);
        unsigned nloc = b.st[0], nx = b.st[1];
        if (nloc == 0u) { xcd_barrier_complete(bar, b.x, nloc, nx); b.st[0] = nloc; b.st[1] = nx; }
        const unsigned old = xb_add(&bar[XB_XSUB(b.x)], 1u);
        const unsigned gen = old / nloc;
        if (old + 1u == (gen + 1u) * nloc) {
            __builtin_amdgcn_fence(__ATOMIC_RELEASE, "agent");
            asm volatile("s_waitcnt vmcnt(0)" ::: "memory");
            const unsigned og = xb_add(&bar[XB_TOP], 1u);
            const unsigned tg = og / nx;
            if (og + 1u == (tg + 1u) * nx) xb_add(&bar[XB_TOPGEN], 1u);
            else XB_SPIN(xb_ld(&bar[XB_TOPGEN]) == tg, bar);
            __builtin_amdgcn_fence(__ATOMIC_ACQUIRE, "agent");
            xb_add(&bar[XB_XGEN(b.x)], 1u);
            asm volatile("s_waitcnt vmcnt(0)" ::: "memory");
        } else {
            XB_SPIN(xb_ld(&bar[XB_XGEN(b.x)]) == gen, bar);
            __builtin_amdgcn_fence(__ATOMIC_ACQUIRE, "agent");
            asm volatile("s_waitcnt vmcnt(0)" ::: "memory");
        }
    }
    __syncthreads();
}

struct Frame {
    LAS unsigned char* lds;
    volatile LAS unsigned* MISC;
    gu32* ctl;
    int tid, lane, wave;
    int vcu, G, li;
    float* out; unsigned char* ws;
};
enum { I_X = 0, I_LNMIX, I_WIN, I_CONV, I_ALOG, I_DTB, I_DNNORM, I_SINK, I_WOUT, I_LNFFN, I_WG, I_BG, I_WE, I_BE, I_WGU, I_WD, I_LNF };

template <int UNR, bool NTST = true>
__device__ __forceinline__ void transpose_item(const float* W, int ldn, int src_col0, int k0, bf16* WT, int ldk, int dst_row0, LAS float* scr, int lane) {
#pragma unroll UNR
    for (int i = 0; i < 32; ++i) { const int kk = 2 * i + (lane >> 5); scr[kk * 33 + (lane & 31)] = __builtin_nontemporal_load(W + (size_t)(k0 + kk) * ldn + src_col0 + (lane & 31)); }
    LDS_WAIT(); asm volatile("" ::: "memory");
    const int c = lane & 7;
#pragma unroll
    for (int j = 0; j < 4; ++j) { const int n = (lane >> 3) + 8 * j; const LAS float* s = scr + (8 * c) * 33 + n;
        v4u o; o.x = pk2(s[0 * 33], s[1 * 33]); o.y = pk2(s[2 * 33], s[3 * 33]); o.z = pk2(s[4 * 33], s[5 * 33]); o.w = pk2(s[6 * 33], s[7 * 33]);
        if (NTST) __builtin_nontemporal_store(o, (v4u*)(WT + (size_t)(dst_row0 + n) * ldk + k0 + 8 * c)); else *(GAS v4u*)(WT + (size_t)(dst_row0 + n) * ldk + k0 + 8 * c) = o; }
    LDS_WAIT(); asm volatile("" ::: "memory");
}
__device__ __forceinline__ void p0_prologue(Frame& F, const float* x_in, const float* lnw, const float* w_in, const float* w_out, const float* a_log, const float* dt_b) {
    LAS float* scr = (LAS float*)(F.lds + F.wave * 16384);
    const int gw = F.vcu * NWAVES + F.wave, NGW = F.G * NWAVES;
    bf16* Win_t = (bf16*)(F.ws + WS_WIN); bf16* Wout_t = (bf16*)(F.ws + WS_WOUT);
    constexpr int I_IN = 16 * 88, I_OUT = 16 * 32, NITEMS = I_IN + I_OUT;
    for (int it = gw; it < NITEMS; it += NGW) {
        int r = it;
        if (r < I_IN) { const int kb = r / 88, nb = r % 88, n0 = 32 * nb; transpose_item<32, false>(w_in, INW, n0 + (n0 >= 2048 ? 16 : 0), 64 * kb, Win_t, D, n0, scr, F.lane); continue; } r -= I_IN;
        { const int kb = r / 32, nb = r % 32; transpose_item<32>(w_out, D, 32 * nb, 64 * kb, Wout_t, D, 32 * nb, scr, F.lane); }
    }
    __syncthreads();
    LAS float* w16T = (LAS float*)F.lds;
    for (int i = F.tid; i < D * 4; i += NTHR) { const int k = i >> 2, c4 = (i & 3) * 4; const f32x4 w = *(const f32x4*)(w_in + (size_t)k * INW + 2048 + c4);
        w16T[(c4 + 0) * D + k] = w.x; w16T[(c4 + 1) * D + k] = w.y; w16T[(c4 + 2) * D + k] = w.z; w16T[(c4 + 3) * D + k] = w.w; }
    __syncthreads();
    bf16* hn = (bf16*)(F.ws + WS_HN); float* bg = (float*)(F.ws + WS_BG);
    f32x4 lw[4];
#pragma unroll
    for (int j = 0; j < 4; ++j) lw[j] = ((const f32x4*)lnw)[F.lane + 64 * j];
    f32x4 vn[4];
    if (gw < T) { const GAS f32x4* xr = (const GAS f32x4*)(x_in + (size_t)gw * D) + F.lane;
#pragma unroll
        for (int j = 0; j < 4; ++j) vn[j] = xr[64 * j]; }
#pragma unroll 1
    for (int m = gw; m < T; m += NGW) {
        f32x4 v[4]; float s = 0.f;
#pragma unroll
        for (int j = 0; j < 4; ++j) v[j] = vn[j];
        if (m + NGW < T) { const GAS f32x4* xr = (const GAS f32x4*)(x_in + (size_t)(m + NGW) * D) + F.lane;
#pragma unroll
            for (int j = 0; j < 4; ++j) vn[j] = xr[64 * j]; }
#pragma unroll
        for (int j = 0; j < 4; ++j) s += (v[j].x * v[j].x + v[j].y * v[j].y) + (v[j].z * v[j].z + v[j].w * v[j].w);
        const float rstd = rsqrtf(wave_sum(s) * (1.f / D) + EPS);
#pragma unroll
        for (int j = 0; j < 4; ++j) v[j] = v[j] * rstd * lw[j];
        GAS unsigned long long* o8 = (GAS unsigned long long*)(hn + (size_t)m * D) + F.lane;
#pragma unroll
        for (int j = 0; j < 4; ++j) o8[64 * j] = (unsigned long long)pk2(v[j].x, v[j].y) | ((unsigned long long)pk2(v[j].z, v[j].w) << 32);
        float acc[16];
#pragma unroll
        for (int c = 0; c < 16; ++c) { float a = 0.f;
#pragma unroll
            for (int j = 0; j < 4; ++j) { const f32x4 w = *(const LAS f32x4*)(w16T + c * D + 4 * F.lane + 256 * j); a += (v[j].x * w.x + v[j].y * w.y) + (v[j].z * w.z + v[j].w * w.w); }
            acc[c] = a; if ((c & 3) == 3) asm volatile("" ::: "memory"); }
        const float tot = reduce16(acc, F.lane);
        if ((F.lane & 3) == 0) { const int idx = ((F.lane >> 5) & 1) * 8 + ((F.lane >> 4) & 1) * 4 + ((F.lane >> 3) & 1) * 2 + ((F.lane >> 2) & 1);
            if (idx < 8) bg[(size_t)m * 16 + idx] = 1.f / (1.f + expf(-tot));
            else bg[(size_t)m * 16 + idx] = -expf(a_log[idx - 8]) * softplus_f(tot + dt_b[idx - 8]); }
    }
}

typedef short bf16x8 __attribute__((ext_vector_type(8)));
typedef short bf16x4 __attribute__((ext_vector_type(4)));
typedef unsigned v2u __attribute__((ext_vector_type(2)));
constexpr size_t DN_QS = WS_DN, DN_KT = WS_DN + 32 * MiB, DN_U = WS_DN + 64 * MiB, DN_W = WS_DN + 128 * MiB, DN_AT = WS_DN + 192 * MiB;
constexpr size_t DN_GV = WS_MISC;
constexpr size_t SC_KKQK = WS_WGU, SC_VT = WS_WD;
#define MFMA16(a, b, c) __builtin_amdgcn_mfma_f32_16x16x32_bf16((a), (b), (c), 0, 0, 0)
#define RAW_BAR() do { asm volatile("s_waitcnt lgkmcnt(0)" ::: "memory"); __builtin_amdgcn_s_barrier(); asm volatile("" ::: "memory"); } while (0)

__device__ __forceinline__ void glds16(const void* gsrc, LAS unsigned char* ldst) {
    __builtin_amdgcn_global_load_lds((const unsigned*)gsrc, (LAS unsigned*)ldst, 16, 0, 0);
}
__device__ __forceinline__ void p2_group(Frame& F, int grp, const float* convw, const float* bgp, int stmask = 3) {
    const int tid = F.tid, lane = F.lane, w = F.wave;
    const bf16* proj = (const bf16*)(F.ws + WS_PROJ);
    LAS bf16* QL = (LAS bf16*)(F.lds + 52224);
    LAS bf16* KL = (LAS bf16*)(F.lds + 52224 + 17408);
    LAS float* CWL = (LAS float*)(F.lds + 139264);
    auto xin_issue = [&](int ui, LAS unsigned char* XB) {
        const int un = grp * 4 + ui, n = un & 127, bh = un >> 7, h = bh & 3, b = bh >> 2;
#pragma unroll 1
        for (int k = 0; k < 7; ++k) { const int pc = k * 8 + w;
            if (pc < 51) { const int c = pc * 64 + lane, rr = c / 48, rem = c - rr * 48, p = rem >> 4, c16 = rem & 15, s = 64 * n - 2 + rr;
                if (s >= 0 && s < SEQ) glds16(proj + (size_t)(b * SEQ + s) * NPROJ + p * 512 + h * 128 + c16 * 8, XB + pc * 1024);
                else *(LAS v4u*)(XB + c * 16) = (v4u){0u, 0u, 0u, 0u}; } }
    };
    if (stmask & 1) {
        xin_issue(0, F.lds);
        if (tid < 480) { const int pj = tid >> 5, c4 = tid & 31, p = pj / 5, j = pj - p * 5, h = ((grp * 4) >> 7) & 3;
            *(LAS f32x4*)(CWL + pj * 128 + 4 * c4) = *(const f32x4*)(convw + j * 1536 + p * 512 + h * 128 + 4 * c4); }
    }
#pragma unroll 1
    for (int ui = 0; ui < ((stmask & 1) ? 4 : 0); ++ui) {
        const int un = grp * 4 + ui, n = un & 127, bh = un >> 7, h = bh & 3, b = bh >> 2;
        LAS bf16* XIN = (LAS bf16*)(F.lds + (ui & 1) * 87040);
        asm volatile("s_waitcnt vmcnt(0) lgkmcnt(0)" ::: "memory"); __syncthreads();
        if (ui + 1 < 4) xin_issue(ui + 1, F.lds + ((ui + 1) & 1) * 87040);
        {
            float val[3][8][2];
#pragma unroll
            for (int p = 0; p < 3; ++p) {
                float cw[5][2];
#pragma unroll
                for (int j = 0; j < 5; ++j) { const LAS float* cp = CWL + (p * 5 + j) * 128 + 2 * lane; cw[j][0] = cp[0]; cw[j][1] = cp[1]; }
                float xr[12][2];
#pragma unroll
                for (int r = 0; r < 12; ++r) { const unsigned u2 = *(const LAS unsigned*)(XIN + (8 * w + r) * 384 + p * 128 + 2 * lane); xr[r][0] = bf2f((unsigned short)(u2 & 0xffffu)); xr[r][1] = bf2f((unsigned short)(u2 >> 16)); }
#pragma unroll
                for (int i = 0; i < 8; ++i) { float a0 = 0.f, a1 = 0.f;
#pragma unroll
                    for (int j = 0; j < 5; ++j) { a0 = fmaf(xr[i + j][0], cw[j][0], a0); a1 = fmaf(xr[i + j][1], cw[j][1], a1); }
                    val[p][i][0] = silu_f(a0); val[p][i][1] = silu_f(a1); }
            }
#pragma unroll
            for (int i = 0; i < 8; ++i) {
                const float sq = wave_sum(val[0][i][0] * val[0][i][0] + val[0][i][1] * val[0][i][1]);
                const float sk = wave_sum(val[1][i][0] * val[1][i][0] + val[1][i][1] * val[1][i][1]);
                const float rq = rsqrtf(sq + EPS) * 0.08838834764831845f, rk = rsqrtf(sk + EPS);
                val[0][i][0] *= rq; val[0][i][1] *= rq; val[1][i][0] *= rk; val[1][i][1] *= rk;
                const unsigned qp = pk2(val[0][i][0], val[0][i][1]), kp = pk2(val[1][i][0], val[1][i][1]);
                *(LAS unsigned*)(QL + (8 * w + i) * 136 + 2 * lane) = qp; *(LAS unsigned*)(KL + (8 * w + i) * 136 + 2 * lane) = kp;
                *(GAS unsigned*)((bf16*)(F.ws + DN_QS) + ((size_t)un * 64 + 8 * w + i) * 128 + 2 * lane) = qp;
            }
#pragma unroll
            for (int c = 0; c < 2; ++c) {
                v4u kt, vt;
                kt.x = pk2(val[1][0][c], val[1][1][c]); kt.y = pk2(val[1][2][c], val[1][3][c]); kt.z = pk2(val[1][4][c], val[1][5][c]); kt.w = pk2(val[1][6][c], val[1][7][c]);
                vt.x = pk2(val[2][0][c], val[2][1][c]); vt.y = pk2(val[2][2][c], val[2][3][c]); vt.z = pk2(val[2][4][c], val[2][5][c]); vt.w = pk2(val[2][6][c], val[2][7][c]);
                { bf16* kp = (bf16*)(F.ws + DN_KT) + ((size_t)un * 128 + 2 * lane + c) * 64 + 32 * (w >> 2) + 16 * (w & 1) + 4 * ((w & 3) >> 1);
                  *(GAS v2u*)kp = (v2u){kt.x, kt.y}; *(GAS v2u*)(kp + 8) = (v2u){kt.z, kt.w}; }
                *(GAS v4u*)((bf16*)(F.ws + SC_VT) + ((size_t)un * 128 + 2 * lane + c) * 64 + 8 * w) = vt;
            }
        }
        __syncthreads();
        {
            const int type = w >> 2, tr = w & 3, fr = lane & 15, fq = lane >> 4;
            const LAS bf16* Asrc = type ? QL : KL;
            bf16x8 af[4];
#pragma unroll
            for (int ks = 0; ks < 4; ++ks) af[ks] = *(const LAS bf16x8*)(Asrc + (16 * tr + fr) * 136 + 32 * ks + 8 * fq);
            float* G = (float*)(F.ws + SC_KKQK) + ((size_t)un * 2 + type) * 4096;
#pragma unroll
            for (int tc = 0; tc < 4; ++tc) { f32x4 acc = (f32x4){0.f, 0.f, 0.f, 0.f};
#pragma unroll
                for (int ks = 0; ks < 4; ++ks) { const bf16x8 bfr = *(const LAS bf16x8*)(KL + (16 * tc + fr) * 136 + 32 * ks + 8 * fq); acc = MFMA16(af[ks], bfr, acc); }
#pragma unroll
                for (int r = 0; r < 4; ++r) G[(16 * tr + 4 * fq + r) * 64 + 16 * tc + fr] = acc[r]; }
        }
    }
    VM_WAIT(); __syncthreads();
    if (tid == 0) { __builtin_amdgcn_fence(__ATOMIC_ACQUIRE, "agent"); VM_WAIT(); }
    __syncthreads();
    if (stmask & 2) {
        int lane = F.lane; asm volatile("" : "+v"(lane));
        const int un = grp * 4 + (w >> 1), dir = w & 1, n = un & 127, bh = un >> 7, h = bh & 3, b = bh >> 2, item = un * 2 + dir;
        const int rl = dir ? 63 - lane : lane;
        const size_t tok = (size_t)b * SEQ + 64 * n + rl;
        const float beta = bgp[tok * 16 + dir * 4 + h], g = bgp[tok * 16 + 8 + dir * 4 + h];
        float gc = g;
#pragma unroll
        for (int o = 1; o < 64; o <<= 1) { const float t = __shfl_up(gc, o); if (lane >= o) gc += t; }
        const float gcl = __shfl(gc, 63), egc = __expf(gc), ekd = __expf(gcl - gc);
        float* gv = (float*)(F.ws + DN_GV) + (size_t)item * 128; gv[lane] = egc; gv[64 + lane] = ekd;
        const float* KKp = (const float*)(F.ws + SC_KKQK) + (size_t)un * 8192; const float* QKp = KKp + 4096;
        bf16* ATp = (bf16*)(F.ws + DN_AT) + (size_t)item * 4096;
        float Tr[64];
        LAS float* AL = (LAS float*)(F.lds + w * 16384);
        float kkc[8], qkc[8];
        const char* KKb = (const char*)KKp; char* ATb = (char*)ATp;
        const int kstep = dir ? -256 : 256;
        const unsigned kk0 = (unsigned)(((dir ? 63 : 0) * 64 + rl) * 4);
        {   unsigned o2 = kk0; asm volatile("" : "+v"(o2));
#pragma unroll
            for (int r = 0; r < 8; ++r) { kkc[r] = *(const float*)(KKb + (o2 + (unsigned)(r * kstep))); qkc[r] = *(const float*)(KKb + (o2 + (unsigned)(r * kstep) + 16384u)); } }
#pragma unroll
        for (int blk = 0; blk < 8; ++blk) {
            float kkn[8], qkn[8];
            {   unsigned o2 = kk0 + (unsigned)((blk < 7 ? 8 * (blk + 1) : 0) * kstep); asm volatile("" : "+v"(o2));
#pragma unroll
                for (int r = 0; r < 8; ++r) { kkn[r] = *(const float*)(KKb + (o2 + (unsigned)(r * kstep))); qkn[r] = *(const float*)(KKb + (o2 + (unsigned)(r * kstep) + 16384u)); } }
            unsigned ao = (unsigned)(lane * 2 + blk * 1024); asm volatile("" : "+v"(ao));
            asm volatile("" ::: "memory");
#pragma unroll
            for (int r = 0; r < 8; ++r) {
                const int i = 8 * blk + r;
                const float kk = kkc[r], qk = qkc[r];
                const float gci = __builtin_bit_cast(float, __builtin_amdgcn_readlane(__builtin_bit_cast(int, gc), i));
                const float bi = __builtin_bit_cast(float, __builtin_amdgcn_readlane(__builtin_bit_cast(int, beta), i));
                const float dec = __expf(fminf(gci - gc, 0.f));
                const float arow = (lane < i) ? bi * kk * dec : 0.f;
                *(bf16*)(ATb + (ao + (unsigned)(r * 128))) = (bf16)f2bf((lane <= i) ? qk * dec : 0.f);
                AL[i * 64 + lane] = arow;
            }
            asm volatile("" ::: "memory");
#pragma unroll
            for (int r = 0; r < 8; ++r) { kkc[r] = kkn[r]; qkc[r] = qkn[r]; }
        }
        LDS_WAIT(); asm volatile("" ::: "memory");
        {   unsigned ab = (unsigned)(w * 16384); asm volatile("" : "+v"(ab));
            const LAS unsigned char* ALb = F.lds;
#pragma unroll
            for (int i = 0; i < 64; ++i) {
                float t = (lane == i) ? 1.f : 0.f;
#pragma unroll
                for (int j4 = 0; j4 < (i + 3) / 4; ++j4) { const f32x4 a = *(const LAS f32x4*)(ALb + (ab + (unsigned)(i * 256 + j4 * 16)));
                    t = fmaf(-a.x, Tr[4 * j4], t); if (4 * j4 + 1 < i) t = fmaf(-a.y, Tr[4 * j4 + 1], t); if (4 * j4 + 2 < i) t = fmaf(-a.z, Tr[4 * j4 + 2], t); if (4 * j4 + 3 < i) t = fmaf(-a.w, Tr[4 * j4 + 3], t); }
                Tr[i] = t;
                if ((i & 7) == 7) asm volatile("" ::: "memory");
            }
        }
        LDS_WAIT(); asm volatile("" ::: "memory");
        LAS bf16* TB = (LAS bf16*)(F.lds + w * 16384); LAS bf16* TG = TB + 4096;
        const float cb = beta, cg = beta * egc;
        const int rp = (rl & 32) | (((rl >> 2) & 3) << 3) | (((rl >> 4) & 1) << 2) | (rl & 3);
#pragma unroll
        for (int i = 0; i < 64; ++i) { const int off = i * 64 + ((((rl >> 3) ^ (i & 7))) << 3) + (rl & 7), offg = i * 64 + ((((rp >> 3) ^ (i & 7))) << 3) + (rp & 7);
            TB[off] = (bf16)f2bf(Tr[i] * cb); TG[offg] = (bf16)f2bf(Tr[i] * cg); }
        LDS_WAIT(); asm volatile("" ::: "memory");
        const int fr = lane & 15, fq = lane >> 4;
        bf16x8 ab[4][2], ag[4][2];
#pragma unroll
        for (int m = 0; m < 4; ++m)
#pragma unroll
            for (int ks = 0; ks < 2; ++ks) { const int row = 16 * m + fr, off = row * 64 + (((4 * ks + fq) ^ (row & 7)) << 3); ab[m][ks] = *(const LAS bf16x8*)(TB + off); ag[m][ks] = *(const LAS bf16x8*)(TG + off); }
        const bf16* VTp = (const bf16*)(F.ws + SC_VT) + (size_t)un * 8192; const bf16* KTp = (const bf16*)(F.ws + DN_KT) + (size_t)un * 8192;
        bf16* Up = (bf16*)(F.ws + DN_U) + (size_t)item * 8192; bf16* Wp = (bf16*)(F.ws + DN_W) + (size_t)item * 8192;
#pragma unroll 4
        for (int nn = 0; nn < 8; ++nn) {
            bf16x8 bv[2], bk[2];
#pragma unroll
            for (int ks = 0; ks < 2; ++ks) { bv[ks] = *(const GAS bf16x8*)(VTp + (16 * nn + fr) * 64 + 32 * ks + 8 * fq); bk[ks] = *(const GAS bf16x8*)(KTp + (16 * nn + fr) * 64 + 32 * ks + 8 * fq); }
#pragma unroll
            for (int m = 0; m < 4; ++m) {
                f32x4 au = (f32x4){0.f, 0.f, 0.f, 0.f}, aw = (f32x4){0.f, 0.f, 0.f, 0.f};
#pragma unroll
                for (int ks = 0; ks < 2; ++ks) { au = MFMA16(ab[m][ks], bv[ks], au); aw = MFMA16(bk[ks], ag[m][ks], aw); }
                v2u uo; uo.x = pk2(au[0], au[1]); uo.y = pk2(au[2], au[3]);
                *(GAS v2u*)(Up + ((m * 8 + nn) * 64 + lane) * 4) = uo;
                v2u wo; wo.x = pk2(aw[0], aw[1]); wo.y = pk2(aw[2], aw[3]);
                *(GAS v2u*)(Wp + (16 * m + fr) * 128 + 32 * (nn >> 1) + 8 * fq + 4 * (nn & 1)) = wo;
            }
        }
    }
    __syncthreads();
}

constexpr int CW_PROG = 36864;
constexpr int RB_W = 0, RB_KT = 16384, RB_U = 32768, RB_GV = 40960, RB_SIZE = 41984;
static_assert(3 * RB_SIZE <= RING_BYTES, "scan ring");
constexpr size_t DN_SX0 = DN_U + 32 * MiB, DN_SX1 = DN_W + 32 * MiB, DN_VX0 = DN_QS + 16 * MiB, DN_VX1 = DN_KT + 16 * MiB;
__device__ __forceinline__ void glds16_sc1(const void* gsrc, LAS unsigned char* ldst) {
    __builtin_amdgcn_global_load_lds((const unsigned*)gsrc, (LAS unsigned*)ldst, 16, 0, 16);
}
template <int OFF>
__device__ __forceinline__ void store16_sc1(void* gdst, v4u v) {
    asm volatile("global_store_dwordx4 %0, %1, off offset:%2 sc1\n\ts_nop 1" :: "v"(gdst), "v"(v), "n"(OFF) : "memory");
}
template <int OFF>
__device__ __forceinline__ void store16_sc1nt(void* gdst, v4u v) {
    asm volatile("global_store_dwordx4 %0, %1, off offset:%2 sc1 nt\n\ts_nop 1" :: "v"(gdst), "v"(v), "n"(OFF) : "memory");
}
__device__ __forceinline__ bf16x8 ld2x8(const LAS unsigned char* p0, const LAS unsigned char* p1) {
    const v2u lo = *(const LAS v2u*)p0, hi = *(const LAS v2u*)p1; v4u v; v.x = lo.x; v.y = lo.y; v.z = hi.x; v.w = hi.y; return __builtin_bit_cast(bf16x8, v);
}
struct ScanOff { unsigned w0[4], k0[2], u, gk; };
template <int DIR, int BUF>
__device__ __forceinline__ void scan_step(LAS unsigned char* L, const ScanOff& O, f32x4 (&S)[8], unsigned char*& sxp, unsigned char*& vxp, bool ex) {
    const LAS unsigned char* B = L + BUF * RB_SIZE;
    v4u sbv[4];
#pragma unroll
    for (int ks = 0; ks < 4; ++ks) { sbv[ks].x = pk2(S[2 * ks][0], S[2 * ks][1]); sbv[ks].y = pk2(S[2 * ks][2], S[2 * ks][3]); sbv[ks].z = pk2(S[2 * ks + 1][0], S[2 * ks + 1][1]); sbv[ks].w = pk2(S[2 * ks + 1][2], S[2 * ks + 1][3]); }
    if (ex) { store16_sc1nt<0>(sxp, sbv[0]); store16_sc1nt<1024>(sxp, sbv[1]); store16_sc1nt<2048>(sxp, sbv[2]); store16_sc1nt<3072>(sxp, sbv[3]); }
    bf16x8 fw[4][4]; v2u ucv[4]; f32x4 ekv[4];
#pragma unroll
    for (int it = 0; it < 4; ++it) {
#pragma unroll
        for (int ks = 0; ks < 4; ++ks) fw[it][ks] = *(const LAS bf16x8*)(B + RB_W + O.w0[ks] + it * 4096);
        ucv[it] = *(const LAS v2u*)(B + RB_U + O.u + it * 2048); ekv[it] = *(const LAS f32x4*)(B + RB_GV + O.gk + it * 64); }
    const float dch = ((const LAS float*)(B + RB_GV))[63];
    f32x4 aW[4];
#pragma unroll
    for (int it = 0; it < 4; ++it) { aW[it] = (f32x4){0.f, 0.f, 0.f, 0.f};
#pragma unroll
        for (int ks = 0; ks < 4; ++ks) aW[it] = MFMA16(fw[it][ks], __builtin_bit_cast(bf16x8, sbv[ks]), aW[it]); }
    bf16x8 fk[8][2];
#pragma unroll
    for (int dt = 0; dt < 8; ++dt)
#pragma unroll
        for (int k2 = 0; k2 < 2; ++k2) fk[dt][k2] = *(const LAS bf16x8*)(B + RB_KT + O.k0[k2] + dt * 2048);
    f32x4 vs[4]; v2u vnp[4];
#pragma unroll
    for (int it = 0; it < 4; ++it) {
        const v2u uc = ucv[it]; const f32x4 ek = ekv[it];
        f32x4 vn;
        vn[0] = bf2f((unsigned short)(uc.x & 0xffffu)) - aW[it][0]; vn[1] = bf2f((unsigned short)(uc.x >> 16)) - aW[it][1];
        vn[2] = bf2f((unsigned short)(uc.y & 0xffffu)) - aW[it][2]; vn[3] = bf2f((unsigned short)(uc.y >> 16)) - aW[it][3];
        vnp[it] = (v2u){pk2(vn[0], vn[1]), pk2(vn[2], vn[3])};
        vs[it] = vn * ek;
    }
    if (ex) { store16_sc1nt<0>(vxp, (v4u){vnp[0].x, vnp[0].y, vnp[1].x, vnp[1].y}); store16_sc1nt<1024>(vxp, (v4u){vnp[2].x, vnp[2].y, vnp[3].x, vnp[3].y}); }
    sxp += DIR ? -32768 : 32768; vxp += DIR ? -16384 : 16384;
    bf16x8 Vsb[2];
#pragma unroll
    for (int k2 = 0; k2 < 2; ++k2) { v4u t;
        if (DIR) { t.x = pk2(vs[2 * k2 + 1][3], vs[2 * k2 + 1][2]); t.y = pk2(vs[2 * k2 + 1][1], vs[2 * k2 + 1][0]); t.z = pk2(vs[2 * k2][3], vs[2 * k2][2]); t.w = pk2(vs[2 * k2][1], vs[2 * k2][0]); }
        else { t.x = pk2(vs[2 * k2][0], vs[2 * k2][1]); t.y = pk2(vs[2 * k2][2], vs[2 * k2][3]); t.z = pk2(vs[2 * k2 + 1][0], vs[2 * k2 + 1][1]); t.w = pk2(vs[2 * k2 + 1][2], vs[2 * k2 + 1][3]); }
        Vsb[k2] = __builtin_bit_cast(bf16x8, t); }
#pragma unroll
    for (int dt = 0; dt < 8; ++dt) { S[dt] = S[dt] * dch;
#pragma unroll
        for (int k2 = 0; k2 < 2; ++k2) S[dt] = MFMA16(fk[dt][k2], Vsb[k2], S[dt]); }
    asm volatile("s_waitcnt vmcnt(12) lgkmcnt(0)" ::: "memory"); __builtin_amdgcn_s_barrier(); asm volatile("" ::: "memory");
}
template <int DIR>
__device__ __forceinline__ void scan_compute(Frame& F, LAS unsigned char* L, int hf, int bh, int mode) {
    const int lane = F.lane, w = F.wave, fr = lane & 15, fq = lane >> 4;
    ScanOff O;
    const int s7 = (fr >> 1) & 7;
#pragma unroll
    for (int ks = 0; ks < 4; ++ks) O.w0[ks] = (unsigned)(fr * 256 + (((4 * ks + fq) ^ fr) << 4));
#pragma unroll
    for (int k2 = 0; k2 < 2; ++k2) {
        const int ck = DIR ? 4 * (1 - k2) + (3 - fq) : 4 * k2 + fq;
        O.k0[k2] = (unsigned)(fr * 128 + ((ck ^ s7) << 4));
    }
    O.u = (unsigned)((w * 64 + lane) * 8); O.gk = (unsigned)((64 + 4 * fq) * 4);
    const int item0 = (bh * 128 + (DIR ? 127 : 0)) * 2 + DIR;
    unsigned char* sxp = F.ws + (hf ? DN_SX1 : DN_SX0) + (size_t)item0 * 16384 + w * 4096 + lane * 16;
    unsigned char* vxp = F.ws + (hf ? DN_VX1 : DN_VX0) + (size_t)item0 * 8192 + w * 2048 + lane * 16;
    const bool ex = !(mode & 1);
    f32x4 S[8];
#pragma unroll
    for (int t = 0; t < 8; ++t) S[t] = (f32x4){0.f, 0.f, 0.f, 0.f};
    __builtin_amdgcn_s_barrier(); asm volatile("" ::: "memory");
#pragma unroll 1
    for (int step = 0; step < 126; step += 3) { scan_step<DIR, 0>(L, O, S, sxp, vxp, ex); scan_step<DIR, 1>(L, O, S, sxp, vxp, ex); scan_step<DIR, 2>(L, O, S, sxp, vxp, ex); }
    scan_step<DIR, 0>(L, O, S, sxp, vxp, ex); scan_step<DIR, 1>(L, O, S, sxp, vxp, ex);
}
__device__ __forceinline__ void scan_loader(Frame& F, LAS unsigned char* L, int c, int hf, int dir, int bh, int mode) {
    const int lane = F.lane, lw = F.wave - 4;
    unsigned goff[11];
#pragma unroll
    for (int k = 0; k < 11; ++k) { const int p = lw + 4 * k, q = (p & 15) * 64 + lane;
        if (p < 16) { const int row = q >> 4, ch = (q & 15) ^ (row & 15); goff[k] = (unsigned)(row * 256 + ch * 16); }
        else if (p < 32) { const int row = q >> 3, ch = (q & 7) ^ ((row >> 1) & 7); goff[k] = (unsigned)(row * 128 + ch * 16); }
        else if (p < 40) { const int pu = p - 32; goff[k] = (unsigned)((((pu >> 1) * 8 + 4 * hf) * 512) + (pu & 1) * 1024 + lane * 16); }
        else goff[k] = (unsigned)(lane * 16); }
    unsigned* prog = (unsigned*)(F.ctl + CW_PROG + 2048 * F.li + 64 * (c * 2 + hf));
    auto issue = [&](int t, LAS unsigned char* B) {
        const int nc = dir ? 127 - t : t, un = bh * 128 + nc, item = un * 2 + dir;
        const unsigned char* gW = F.ws + DN_W + (size_t)item * 16384; const unsigned char* gK = F.ws + DN_KT + (size_t)un * 16384;
        const unsigned char* gU = F.ws + DN_U + (size_t)item * 16384; const unsigned char* gG = F.ws + DN_GV + (size_t)item * 512;
#pragma unroll
        for (int k = 0; k < 11; ++k) { const int p = lw + 4 * k;
            if (k < 4) glds16(gW + goff[k], B + RB_W + p * 1024);
            else if (k < 8) glds16(gK + goff[k], B + RB_KT + (p - 16) * 1024);
            else if (k < 10) glds16(gU + goff[k], B + RB_U + (p - 32) * 1024);
            else if (lw == 0) glds16(gG + goff[k], B + RB_GV); }
    };
    if (!(mode & 2)) issue(0, L);
    int nb = 1;
#pragma unroll 1
    for (int k = 0; k <= 128; ++k) {
        if (k + 1 < 128 && !(mode & 2)) { issue(k + 1, L + nb * RB_SIZE);
            if (lw == 0) asm volatile("s_waitcnt vmcnt(11)" ::: "memory"); else asm volatile("s_waitcnt vmcnt(10)" ::: "memory"); }
        else asm volatile("s_waitcnt vmcnt(0)" ::: "memory");
        if (++nb == 3) nb = 0;
        __builtin_amdgcn_s_barrier(); asm volatile("" ::: "memory");
        if (lw == 0 && lane == 0 && k >= 3 && !(mode & 1)) __hip_atomic_store(prog, (unsigned)(k - 2), RLX_AGENT);
    }
}
__device__ __forceinline__ void p3_scan(Frame& F, int c, int hf, int mode  ) {
    const int b = c >> 3, h = (c >> 1) & 3, dir = c & 1, bh = b * 4 + h;
    LAS unsigned char* L = F.lds;
    if (F.wave >= 4) scan_loader(F, L, c, hf, dir, bh, mode);
    else if (dir) scan_compute<1>(F, L, hf, bh, mode); else scan_compute<0>(F, L, hf, bh, mode);
    asm volatile("s_waitcnt vmcnt(0) lgkmcnt(0)" ::: "memory"); __syncthreads();
    if (F.tid == 256 && !(mode & 1)) __hip_atomic_store((unsigned*)(F.ctl + CW_PROG + 2048 * F.li + 64 * (c * 2 + hf)), 128u, RLX_AGENT);
    __syncthreads();
}

constexpr int OL_Q = 0, OL_AT = 16384, OL_SX = 24576, OL_VX = 40960, OL_GV = 49152, OL_SIZE = 50176;
__device__ __forceinline__ void p3_out_issue(Frame& F, int j, LAS unsigned char* Lb) {
    const int lane = F.lane, w = F.wave;
    const int n = j >> 5, wg = j & 31, c = wg >> 1, hf = wg & 1, b = c >> 3, h = (c >> 1) & 3, dir = c & 1, bh = b * 4 + h;
    const int nc = dir ? 127 - n : n, un = bh * 128 + nc, item = un * 2 + dir;
    const unsigned char* gQ = F.ws + DN_QS + (size_t)un * 16384; const unsigned char* gA = F.ws + DN_AT + (size_t)item * 8192;
    const unsigned char* gS = F.ws + (hf ? DN_SX1 : DN_SX0) + (size_t)item * 16384; const unsigned char* gV = F.ws + (hf ? DN_VX1 : DN_VX0) + (size_t)item * 8192;
#pragma unroll
    for (int k = 0; k < 2; ++k) { const int p = 2 * w + k, q = p * 64 + lane, row = q >> 4, ch = (q & 15) ^ (row & 15);
        glds16(gQ + row * 256 + ch * 16, Lb + OL_Q + p * 1024); glds16_sc1(gS + p * 1024 + lane * 16, Lb + OL_SX + p * 1024); }
    { const int q = w * 64 + lane, row = q >> 3, ch = (q & 7) ^ ((row >> 1) & 7); glds16(gA + row * 128 + ch * 16, Lb + OL_AT + w * 1024); glds16_sc1(gV + w * 1024 + lane * 16, Lb + OL_VX + w * 1024); }
    if (w == 0) glds16(F.ws + DN_GV + (size_t)item * 512 + lane * 16, Lb + OL_GV);
}
__device__ __forceinline__ void p3_out_compute(Frame& F, int j, const LAS unsigned char* Lb, float* odir) {
    const int lane = F.lane, w = F.wave, fr = lane & 15, fq = lane >> 4, mi = w >> 1, eh = w & 1;
    const int n = j >> 5, wg = j & 31, c = wg >> 1, hf = wg & 1, b = c >> 3, h = (c >> 1) & 3, dir = c & 1;
    const int nc = dir ? 127 - n : n;
    const int irow = 16 * mi + fr, qrow = dir ? 63 - irow : irow;
    const int hb = 8 * (fq & 1), fh = fq >> 1;
    f32x4 aQ[2];
#pragma unroll
    for (int t = 0; t < 2; ++t) aQ[t] = (f32x4){0.f, 0.f, 0.f, 0.f};
#pragma unroll
    for (int ks = 0; ks < 4; ++ks) {
        const bf16x8 fqv = ld2x8(Lb + OL_Q + qrow * 256 + (((4 * ks + fh) ^ (qrow & 15)) << 4) + hb, Lb + OL_Q + qrow * 256 + (((4 * ks + 2 + fh) ^ (qrow & 15)) << 4) + hb);
#pragma unroll
        for (int t = 0; t < 2; ++t) { const bf16x8 fs = *(const LAS bf16x8*)(Lb + OL_SX + ((2 * eh + t) * 4 + ks) * 1024 + lane * 16); aQ[t] = MFMA16(fs, fqv, aQ[t]); }
    }
    const float egc_i = ((const LAS float*)(Lb + OL_GV))[irow];
#pragma unroll
    for (int t = 0; t < 2; ++t) aQ[t] = aQ[t] * egc_i;
#pragma unroll
    for (int ks = 0; ks < 2; ++ks) {
        const bf16x8 fa = ld2x8(Lb + OL_AT + irow * 128 + (((4 * ks + fh) ^ ((irow >> 1) & 7)) << 4) + hb, Lb + OL_AT + irow * 128 + (((4 * ks + 2 + fh) ^ ((irow >> 1) & 7)) << 4) + hb);
#pragma unroll
        for (int t = 0; t < 2; ++t) { const bf16x8 fv = *(const LAS bf16x8*)(Lb + OL_VX + ((2 * eh + t) * 2 + ks) * 1024 + lane * 16); aQ[t] = MFMA16(fv, fa, aQ[t]); }
    }
    const size_t tok = (size_t)b * SEQ + 64 * nc + qrow;
    float* op = odir + ((size_t)dir * T + tok) * 512 + h * 128 + 64 * hf + 4 * fq;
#pragma unroll
    for (int t = 0; t < 2; ++t) *(GAS f32x4*)(op + 16 * (2 * eh + t)) = aQ[t];
}
__device__ __forceinline__ void p3_out_batch(Frame& F, int j0, int cnt  , float* odir) {
    const int n = j0 >> 5;
    LAS unsigned char* L = F.lds;
    if (F.tid < 64) { unsigned sp = 0;
        for (;;) { bool ok = true; if (F.tid < cnt) ok = (int)__hip_atomic_load((unsigned*)(F.ctl + CW_PROG + 2048 * F.li + 64 * ((j0 & 31) + F.tid)), RLX_AGENT) > n;
            if (__all(ok) || ++sp > (1u << 22)) break; __builtin_amdgcn_s_sleep(127); __builtin_amdgcn_s_sleep(127); } }
    __syncthreads();
    p3_out_issue(F, j0, L); p3_out_issue(F, j0 + (cnt > 1 ? 1 : 0), L + OL_SIZE);
    int bk = 0;
#pragma unroll 1
    for (int k = 0; k < cnt; ++k) {
        asm volatile("s_waitcnt vmcnt(6) lgkmcnt(0)" ::: "memory"); __builtin_amdgcn_s_barrier(); asm volatile("" ::: "memory");
        { int b2 = bk + 2; if (b2 >= 3) b2 -= 3; const int kn = k + 2 < cnt ? k + 2 : cnt - 1; p3_out_issue(F, j0 + kn, L + b2 * OL_SIZE); }
        p3_out_compute(F, j0 + k, L + bk * OL_SIZE, odir);
        if (++bk == 3) bk = 0;
    }
    asm volatile("s_waitcnt vmcnt(0) lgkmcnt(0)" ::: "memory"); __syncthreads();
}
typedef float f32x16 __attribute__((ext_vector_type(16)));
#define MFMA32(a, b, c) __builtin_amdgcn_mfma_f32_32x32x16_bf16((a), (b), (c), 0, 0, 0)
constexpr size_t WS_ROT = WS_CTL + 256 * 1024;
constexpr int VT_PITCH = 324;
constexpr int CW_WQ = 49152;
constexpr int LT_WQ = LDSCTL_OFF + 512;

__device__ __forceinline__ void p0_rot_table(Frame& F) {
    float* rot = (float*)(F.ws + WS_ROT);
    for (int i = (F.vcu * NTHR + F.tid); i < SEQ * 8; i += F.G * NTHR) { const int s = i >> 3, k = i & 7;
        const float inv = powf(500000.f, -(float)(2 * k) / 16.f); float sn, cs; sincosf((float)s * inv, &sn, &cs); rot[2 * i] = cs; rot[2 * i + 1] = sn; }
}

__device__ __forceinline__ void p3_attn_unit(Frame& F, int unit, const float* sink) {
    const int tid = F.tid, lane = F.lane, w = F.wave, r = lane & 31, hh = lane >> 5;
    const int b = unit >> 8, kvh = (unit >> 7) & 1, qt = unit & 127, k0 = 64 * qt - 128;
    const bf16* proj = (const bf16*)(F.ws + WS_PROJ); const float* rot = (const float*)(F.ws + WS_ROT);
    LAS bf16* KLs = (LAS bf16*)F.lds;
    LAS bf16* VTs = (LAS bf16*)(F.lds + 40960);
#pragma unroll 1
    for (int idx = tid; idx < 320 * 8; idx += NTHR) {
        const int key = idx >> 3, ch = idx & 7, kp = k0 + key;
        v4u kv = (v4u){0u, 0u, 0u, 0u}, vv = (v4u){0u, 0u, 0u, 0u};
        if (kp >= 0 && kp < SEQ) {
            const bf16* rowp = proj + (size_t)(b * SEQ + kp) * NPROJ;
            vv = *(const GAS v4u*)(rowp + PJ_AV + kvh * 64 + ch * 8);
            if (ch >= 2) kv = *(const GAS v4u*)(rowp + PJ_AK + kvh * 64 + ch * 8);
            else {
                const v4u a = *(const GAS v4u*)(rowp + PJ_AK + kvh * 64), c = *(const GAS v4u*)(rowp + PJ_AK + kvh * 64 + 8);
                const float* rp = rot + (size_t)kp * 16; float o[8];
#pragma unroll
                for (int i = 0; i < 8; ++i) { const unsigned ua = a[i >> 1], uc = c[i >> 1];
                    const float x1 = bf2f((unsigned short)((i & 1) ? (ua >> 16) : (ua & 0xffffu))), x2 = bf2f((unsigned short)((i & 1) ? (uc >> 16) : (uc & 0xffffu)));
                    const float cs = rp[2 * i], sn = rp[2 * i + 1]; o[i] = ch == 0 ? x1 * cs - x2 * sn : x2 * cs + x1 * sn; }
                kv.x = pk2(o[0], o[1]); kv.y = pk2(o[2], o[3]); kv.z = pk2(o[4], o[5]); kv.w = pk2(o[6], o[7]);
            }
        }
        *(LAS v4u*)(KLs + key * 64 + ((ch ^ ((key >> 1) & 7)) << 3)) = kv;
#pragma unroll
        for (int i = 0; i < 8; ++i) { const unsigned u = vv[i >> 1]; VTs[(ch * 8 + i) * VT_PITCH + key] = (bf16)((i & 1) ? (u >> 16) : (u & 0xffffu)); }
    }
    const int hq = kvh * 4 + (w >> 1), qp = 64 * qt + 32 * (w & 1) + r;
    const bf16* qrow = proj + (size_t)(b * SEQ + qp) * NPROJ + PJ_AQ + hq * 64;
    bf16x8 qf[4];
    {
        const v4u a = *(const GAS v4u*)(qrow), c = *(const GAS v4u*)(qrow + 8);
        const float* rp = rot + (size_t)qp * 16; float o[8];
#pragma unroll
        for (int i = 0; i < 8; ++i) { const unsigned ua = a[i >> 1], uc = c[i >> 1];
            const float x1 = bf2f((unsigned short)((i & 1) ? (ua >> 16) : (ua & 0xffffu))), x2 = bf2f((unsigned short)((i & 1) ? (uc >> 16) : (uc & 0xffffu)));
            const float cs = rp[2 * i], sn = rp[2 * i + 1]; o[i] = (hh == 0 ? x1 * cs - x2 * sn : x2 * cs + x1 * sn) * 0.125f; }
        v4u q0; q0.x = pk2(o[0], o[1]); q0.y = pk2(o[2], o[3]); q0.z = pk2(o[4], o[5]); q0.w = pk2(o[6], o[7]);
        qf[0] = __builtin_bit_cast(bf16x8, q0);
#pragma unroll
        for (int s = 1; s < 4; ++s) { const v4u q = *(const GAS v4u*)(qrow + 16 * s + 8 * hh); float t[8];
#pragma unroll
            for (int i = 0; i < 8; ++i) { const unsigned u = q[i >> 1]; t[i] = bf2f((unsigned short)((i & 1) ? (u >> 16) : (u & 0xffffu))) * 0.125f; }
            v4u qq; qq.x = pk2(t[0], t[1]); qq.y = pk2(t[2], t[3]); qq.z = pk2(t[4], t[5]); qq.w = pk2(t[6], t[7]); qf[s] = __builtin_bit_cast(bf16x8, qq); }
    }
    __syncthreads();
    float m = sink[hq], l = hh == 0 ? 1.f : 0.f;
    f32x16 O[2];
#pragma unroll
    for (int i = 0; i < 16; ++i) { O[0][i] = 0.f; O[1][i] = 0.f; }
#pragma unroll 1
    for (int kb = (w & 1); kb < (w & 1) + 9; ++kb) {
        f32x16 X;
#pragma unroll
        for (int i = 0; i < 16; ++i) X[i] = 0.f;
        const int krow = 32 * kb + r;
#pragma unroll
        for (int s = 0; s < 4; ++s) { const bf16x8 ka = *(const LAS bf16x8*)(KLs + krow * 64 + (((2 * s + hh) ^ ((krow >> 1) & 7)) << 3)); X = MFMA32(ka, qf[s], X); }
        float bm = -1e30f;
#pragma unroll
        for (int i = 0; i < 16; ++i) { const int kp = k0 + 32 * kb + (i & 3) + 8 * (i >> 2) + 4 * hh, dlt = qp - kp;
            const bool ok = (dlt <= 128) && (dlt >= -128) && (kp >= 0) && (kp < SEQ); X[i] = ok ? X[i] : -1e30f; bm = fmaxf(bm, X[i]); }
        bm = fmaxf(bm, __shfl_xor(bm, 32));
        const float mn = fmaxf(m, bm), alpha = __expf(m - mn); m = mn;
        float ps = 0.f;
#pragma unroll
        for (int i = 0; i < 16; ++i) { X[i] = __expf(X[i] - mn); ps += X[i]; }
        l = l * alpha + ps;
#pragma unroll
        for (int i = 0; i < 16; ++i) { O[0][i] *= alpha; O[1][i] *= alpha; }
        bf16x8 pk[2];
#pragma unroll
        for (int s = 0; s < 2; ++s) { v4u t; t.x = pk2(X[8 * s], X[8 * s + 1]); t.y = pk2(X[8 * s + 2], X[8 * s + 3]); t.z = pk2(X[8 * s + 4], X[8 * s + 5]); t.w = pk2(X[8 * s + 6], X[8 * s + 7]); pk[s] = __builtin_bit_cast(bf16x8, t); }
#pragma unroll
        for (int dt = 0; dt < 2; ++dt)
#pragma unroll
            for (int s = 0; s < 2; ++s) { const LAS bf16* vp = VTs + (32 * dt + r) * VT_PITCH + 32 * kb + 16 * s + 4 * hh;
                const v2u lo = *(const LAS v2u*)vp, hi = *(const LAS v2u*)(vp + 8); v4u va; va.x = lo.x; va.y = lo.y; va.z = hi.x; va.w = hi.y;
                O[dt] = MFMA32(__builtin_bit_cast(bf16x8, va), pk[s], O[dt]); }
    }
    l += __shfl_xor(l, 32);
    const float inv = 1.f / l;
    bf16* orow = (bf16*)(F.ws + WS_MIX) + (size_t)(b * SEQ + qp) * D + 512 + hq * 64;
#pragma unroll
    for (int dt = 0; dt < 2; ++dt)
#pragma unroll
        for (int g = 0; g < 4; ++g) { v2u o; o.x = pk2(O[dt][4 * g] * inv, O[dt][4 * g + 1] * inv); o.y = pk2(O[dt][4 * g + 2] * inv, O[dt][4 * g + 3] * inv);
            *(GAS v2u*)(orow + 32 * dt + 8 * g + 4 * hh) = o; }
    __syncthreads();
}

__device__ __forceinline__ void p3_moe_weight_items(Frame& F, int first_wave, int n_waves, int end_item, const float* w_gu, const float* w_dn) {
    LAS float* scr = (LAS float*)(F.lds + F.wave * 16384);
    bf16* Wgu_t = (bf16*)(F.ws + WS_WGU); bf16* Wd_t = (bf16*)(F.ws + WS_WD);
    constexpr int I_GU = NEXP * 16 * 16, I_DN = NEXP * 4 * 32;
#pragma unroll 1
    for (int it = first_wave; it < end_item; it += n_waves) {
        if (it < I_GU) { const int e = it >> 8, kb = (it >> 4) & 15, nb = it & 15, n0 = 32 * nb, pn = n0 >> 8, bj = (n0 >> 7) & 1, c = n0 & 127;
            transpose_item<8>(w_gu + (size_t)e * D * 512, 512, bj * 256 + pn * 128 + c, 64 * kb, Wgu_t + (size_t)e * 512 * D, D, n0, scr, F.lane); }
        else { const int r2 = it - I_GU, e = r2 >> 7, kb = (r2 >> 5) & 3, nb = r2 & 31; transpose_item<8>(w_dn + (size_t)e * EFF * D, D, 32 * nb, 64 * kb, Wd_t + (size_t)e * D * EFF, EFF, 32 * nb, scr, F.lane); }
    }
}

__device__ __forceinline__ void p4_combine(Frame& F, const float* odir, const float* normw) {
    const int gw = F.vcu * NWAVES + F.wave, NGW = F.G * NWAVES, lane = F.lane;
    const bf16* proj = (const bf16*)(F.ws + WS_PROJ); bf16* mix = (bf16*)(F.ws + WS_MIX);
    const f32x4 nw0 = *(const f32x4*)(normw + 8 * (lane & 15)), nw1 = *(const f32x4*)(normw + 8 * (lane & 15) + 4);
    const bool blk = (F.G == 256 && T == 64 * 256);
    const int t0 = blk ? 64 * F.vcu + F.wave : gw, tstep = blk ? NWAVES : NGW, tend = blk ? 64 * F.vcu + 64 : T;
#pragma unroll 1
    for (int tok = t0; tok < tend; tok += tstep) {
        const float* of = odir + (size_t)tok * 512 + 8 * lane; const float* ob = of + (size_t)T * 512;
        const f32x4 a0 = *(const GAS f32x4*)of + *(const GAS f32x4*)ob, a1 = *(const GAS f32x4*)(of + 4) + *(const GAS f32x4*)(ob + 4);
        float s = (a0.x * a0.x + a0.y * a0.y) + (a0.z * a0.z + a0.w * a0.w) + (a1.x * a1.x + a1.y * a1.y) + (a1.z * a1.z + a1.w * a1.w);
        s += __shfl_xor(s, 1); s += __shfl_xor(s, 2); s += __shfl_xor(s, 4); s += __shfl_xor(s, 8);
        const float rs = rsqrtf(s * (1.f / 128.f) + EPS);
        const v4u zz = *(const GAS v4u*)(proj + (size_t)tok * NPROJ + PJ_Z + 8 * lane);
        float z[8];
#pragma unroll
        for (int i = 0; i < 8; ++i) { const unsigned u = zz[i >> 1]; z[i] = bf2f((unsigned short)((i & 1) ? (u >> 16) : (u & 0xffffu))); }
        v4u o;
        o.x = pk2(a0.x * rs * nw0.x * silu_f(z[0]), a0.y * rs * nw0.y * silu_f(z[1])); o.y = pk2(a0.z * rs * nw0.z * silu_f(z[2]), a0.w * rs * nw0.w * silu_f(z[3]));
        o.z = pk2(a1.x * rs * nw1.x * silu_f(z[4]), a1.y * rs * nw1.y * silu_f(z[5])); o.w = pk2(a1.z * rs * nw1.z * silu_f(z[6]), a1.w * rs * nw1.w * silu_f(z[7]));
        *(GAS v4u*)(mix + (size_t)tok * D + 8 * lane) = o;
    }
}
constexpr size_t WS_RW = 488 * MiB;
constexpr size_t RW_HI = WS_RW, RW_LO = WS_RW + 256 * 1024, RW_RSTD = WS_RW + 512 * 1024, RW_GATE = WS_RW + 640 * 1024;
constexpr size_t WS_LIST = WS_MISC + 2 * MiB;
constexpr size_t WS_XS = WS_DN, WS_HMID = WS_DN + 96 * MiB, WS_Y2 = WS_DN + 120 * MiB;
constexpr int CW_CNT = 32768;
constexpr int LT_PSTART = LDSCTL_OFF + 1024, LT_PTAB = LDSCTL_OFF + 1536;

__device__ __forceinline__ void p0_router_weights(Frame& F, const float* lnw, const float* wg, const float* we) {
    bf16* hi = (bf16*)(F.ws + RW_HI); bf16* lo = (bf16*)(F.ws + RW_LO);
    for (int i = F.vcu * NTHR + F.tid; i < 80 * D; i += F.G * NTHR) { const int n = i >> 10, k = i & 1023;
        float v = 0.f; if (n < 8) v = wg[k * 8 + n] * lnw[k]; else if (n < 72) v = we[k * 64 + (n - 8)] * lnw[k];
        const unsigned h = f2bf(v); const float r = v - bf2f((unsigned short)h); hi[i] = (bf16)h; lo[i] = (bf16)f2bf(r); }
}
__device__ __forceinline__ void split8(const f32x4 a, const f32x4 b, bf16x8& h, bf16x8& l) {
    const float x[8] = {a.x, a.y, a.z, a.w, b.x, b.y, b.z, b.w}; unsigned hh[8], ll[8];
#pragma unroll
    for (int i = 0; i < 8; ++i) { hh[i] = f2bf(x[i]); ll[i] = f2bf(x[i] - bf2f((unsigned short)hh[i])); }
    v4u vh, vl; vh.x = hh[0] | (hh[1] << 16); vh.y = hh[2] | (hh[3] << 16); vh.z = hh[4] | (hh[5] << 16); vh.w = hh[6] | (hh[7] << 16);
    vl.x = ll[0] | (ll[1] << 16); vl.y = ll[2] | (ll[3] << 16); vl.z = ll[4] | (ll[5] << 16); vl.w = ll[6] | (ll[7] << 16);
    h = __builtin_bit_cast(bf16x8, vh); l = __builtin_bit_cast(bf16x8, vl);
}
__device__ __forceinline__ void p6_route(Frame& F, const float* lnw, const float* bgrp, const float* bexp, int dry) {
    const int lane = F.lane, w = F.wave, fr = lane & 15, fq = lane >> 4;
    const float* x1 = F.out; bf16* h2u = (bf16*)(F.ws + WS_HN);
    const bf16* Wh = (const bf16*)(F.ws + RW_HI); const bf16* Wl = (const bf16*)(F.ws + RW_LO);
    LAS float* PL = (LAS float*)F.lds;
    LAS float* PS = PL + 8 * 32 * 80;
    LAS float* LG = PS + 8 * 32;
    LAS float* RS = LG + 32 * 80;
    LAS int* LC = (LAS int*)(RS + 32);
    LAS int* PK = LC + 64;
    unsigned* cnt = (unsigned*)(F.ctl + CW_CNT + (dry ? 24576 : 0)); int* list = (int*)(F.ws + (dry ? WS_DN + 196 * MiB : WS_LIST)); float* pgate = (float*)(F.ws + RW_GATE); float* rstd_g = (float*)(F.ws + RW_RSTD);
#pragma unroll 1
    for (int grp = blockIdx.x; grp < T / 64; grp += F.G) {
        if (F.tid < 64) LC[F.tid] = 0;
        f32x4 acc[4][5]; float ss[4];
#pragma unroll
        for (int tl = 0; tl < 4; ++tl) { ss[tl] = 0.f;
#pragma unroll
            for (int c = 0; c < 5; ++c) acc[tl][c] = (f32x4){0.f, 0.f, 0.f, 0.f}; }
#pragma unroll 1
        for (int kk = 0; kk < 4; ++kk) {
            const int k0 = 32 * (4 * w + kk) + 8 * fq;
            bf16x8 bh[5], bl[5];
#pragma unroll
            for (int c = 0; c < 5; ++c) { bh[c] = *(const GAS bf16x8*)(Wh + (size_t)(16 * c + fr) * D + k0); bl[c] = *(const GAS bf16x8*)(Wl + (size_t)(16 * c + fr) * D + k0); }
            const f32x4 la = *(const f32x4*)(lnw + k0), lb = *(const f32x4*)(lnw + k0 + 4);
#pragma unroll
            for (int tl = 0; tl < 4; ++tl) {
                const int tok = (grp * 4 + tl) * 16 + fr;
                const f32x4 xa = *(const GAS f32x4*)(x1 + (size_t)tok * D + k0), xb = *(const GAS f32x4*)(x1 + (size_t)tok * D + k0 + 4);
                ss[tl] += (xa.x * xa.x + xa.y * xa.y) + (xa.z * xa.z + xa.w * xa.w) + (xb.x * xb.x + xb.y * xb.y) + (xb.z * xb.z + xb.w * xb.w);
                v4u ho; ho.x = pk2(xa.x * la.x, xa.y * la.y); ho.y = pk2(xa.z * la.z, xa.w * la.w); ho.z = pk2(xb.x * lb.x, xb.y * lb.y); ho.w = pk2(xb.z * lb.z, xb.w * lb.w);
                *(GAS v4u*)(h2u + (size_t)tok * D + k0) = ho;
                bf16x8 ah, al; split8(xa, xb, ah, al);
#pragma unroll
                for (int c = 0; c < 5; ++c) { acc[tl][c] = MFMA16(ah, bh[c], acc[tl][c]); acc[tl][c] = MFMA16(al, bh[c], acc[tl][c]); acc[tl][c] = MFMA16(ah, bl[c], acc[tl][c]); }
            }
        }
#pragma unroll
        for (int tl = 0; tl < 4; ++tl) { ss[tl] += __shfl_xor(ss[tl], 16); ss[tl] += __shfl_xor(ss[tl], 32); }
#pragma unroll
        for (int rd = 0; rd < 2; ++rd) {
#pragma unroll
            for (int t2 = 0; t2 < 2; ++t2) { const int tl = 2 * rd + t2;
#pragma unroll
                for (int c = 0; c < 5; ++c)
#pragma unroll
                    for (int r = 0; r < 4; ++r) PL[(w * 32 + t2 * 16 + 4 * fq + r) * 80 + 16 * c + fr] = acc[tl][c][r];
                if (lane < 16) PS[w * 32 + t2 * 16 + lane] = ss[tl]; }
            __syncthreads();
            for (int i = F.tid; i < 32 * 80; i += NTHR) { float s = 0.f;
#pragma unroll
                for (int ww = 0; ww < 8; ++ww) s += PL[ww * 2560 + i];
                LG[i] = s; }
            if (F.tid < 32) { float s = 0.f;
#pragma unroll
                for (int ww = 0; ww < 8; ++ww) s += PS[ww * 32 + F.tid];
                RS[F.tid] = rsqrtf(s * (1.f / D) + EPS); }
            __syncthreads();
            if (F.tid < 32) {
                const LAS float* lg = LG + F.tid * 80; const float rs = RS[F.tid];
                float gl[8]; int gi = 0; float gm = -1e30f;
#pragma unroll
                for (int g = 0; g < 8; ++g) { gl[g] = lg[g] * rs + bgrp[g]; if (gl[g] > gm) { gm = gl[g]; gi = g; } }
                float gs = 0.f;
#pragma unroll
                for (int g = 0; g < 8; ++g) gs += expf(gl[g] - gm);
                const float pg = 1.f / gs;
                float el[8]; int e1 = 0; float m1 = -1e30f;
#pragma unroll
                for (int e = 0; e < 8; ++e) { el[e] = lg[8 + gi * 8 + e] * rs + bexp[gi * 8 + e]; if (el[e] > m1) { m1 = el[e]; e1 = e; } }
                int e2 = 0; float m2 = -1e30f;
#pragma unroll
                for (int e = 0; e < 8; ++e) if (e != e1 && el[e] > m2) { m2 = el[e]; e2 = e; }
                const float p2 = expf(m2 - m1), inv = 1.f / (1.f + p2);
                const int E1 = gi * 8 + e1, E2 = gi * 8 + e2, lt = 32 * rd + F.tid, tk = grp * 64 + lt;
                const int r1 = __hip_atomic_fetch_add(LC + E1, 1, __ATOMIC_RELAXED, __HIP_MEMORY_SCOPE_WORKGROUP), r2 = __hip_atomic_fetch_add(LC + E2, 1, __ATOMIC_RELAXED, __HIP_MEMORY_SCOPE_WORKGROUP);
                PK[lt * 4] = E1; PK[lt * 4 + 1] = E2; PK[lt * 4 + 2] = r1; PK[lt * 4 + 3] = r2;
                pgate[tk * 2] = pg * inv; pgate[tk * 2 + 1] = pg * p2 * inv; rstd_g[tk] = rs;
            }
            __syncthreads();
        }
        if (F.tid < 64) { const int n = LC[F.tid]; LC[F.tid] = n ? (int)atomicAdd(cnt + 64 * F.tid, (unsigned)n) : 0; }
        __syncthreads();
        if (F.tid < 64) { const int E1 = PK[F.tid * 4], E2 = PK[F.tid * 4 + 1], tk = grp * 64 + F.tid;
            list[E1 * 16384 + LC[E1] + PK[F.tid * 4 + 2]] = tk * 2; list[E2 * 16384 + LC[E2] + PK[F.tid * 4 + 3]] = tk * 2 + 1; }
        __syncthreads();
    }
}
__device__ __forceinline__ int moe_tables(Frame& F) {
    LAS int* pstart = (LAS int*)(F.lds + LT_PSTART); LAS int* ptab = (LAS int*)(F.lds + LT_PTAB);
    if (F.tid < 64) { const int c = (int)__hip_atomic_load((unsigned*)(F.ctl + CW_CNT) + 64 * F.tid, RLX_AGENT); const int np = (c + 255) >> 8; int ps = np;
#pragma unroll
        for (int o = 1; o < 64; o <<= 1) { const int t = __shfl_up(ps, o); if (F.lane >= o) ps += t; }
        const int st = ps - np; pstart[F.tid] = st; if (F.tid == 63) pstart[64] = ps;
        for (int j = 0; j < np; ++j) ptab[st + j] = F.tid | (j << 8); }
    __syncthreads();
    return pstart[64];
}
__device__ __forceinline__ void p7_gather(Frame& F, int NP) {
    const LAS int* ptab = (const LAS int*)(F.lds + LT_PTAB);
    const int gw = F.vcu * NWAVES + F.wave, NGW = F.G * NWAVES, lane = F.lane;
    const bf16* h2u = (const bf16*)(F.ws + WS_HN); bf16* xs = (bf16*)(F.ws + WS_XS); const int* list = (const int*)(F.ws + WS_LIST);
    const unsigned* cnt = (const unsigned*)(F.ctl + CW_CNT);
#pragma unroll 1
    for (int rid = gw; rid < NP * 256; rid += NGW) { const int pt = ptab[rid >> 8], e = pt & 255, local = (pt >> 8) * 256 + (rid & 255);
        if (local < (int)cnt[64 * e]) { const int tok = list[e * 16384 + local] >> 1;
            const GAS v4u* src = (const GAS v4u*)(h2u + (size_t)tok * D); GAS v4u* dst = (GAS v4u*)(xs + (size_t)rid * D);
            const v4u a = src[lane], b = src[lane + 64]; dst[lane] = a; dst[lane + 64] = b; } }
}
constexpr int CW_PAN = 196608, PAN_NEED = 16;
template <bool GATHER_>
struct MoeOrderT {
    static constexpr bool GATHER = GATHER_;
    int nunits, G, c, SH; const LAS int* ptab; const int* list; const unsigned* cnt; unsigned rowbytes;
    unsigned* pan; int pmode, xtra;
    __device__ __forceinline__ unsigned row_off(const pg8::Unit& u, int r) const {
        const int pt = ptab[u.pm], e = pt & 255, local = (pt >> 8) * 256 + r;
        return local < (int)cnt[64 * e] ? (unsigned)(list[e * 16384 + local] >> 1) * rowbytes : 0u; }
    __device__ __forceinline__ bool next(int i, pg8::Unit& u) const { int L = i * G + c;
        if (L >= nunits) { if (xtra < 0 || L - G >= nunits) return false; L = xtra; }
        const int p = L >> SH; u.pm = p; u.pn = ((ptab[p] & 255) << SH) + (L & ((1 << SH) - 1)); return true; }
    __device__ __forceinline__ void a_ready(const pg8::Unit&) const {}
    __device__ __forceinline__ void wait_panels() const {
        if (threadIdx.x == 0) {
#pragma unroll 1
            for (int L = c;; L += G) { int LL = L; if (L >= nunits) { if (xtra < 0 || L - G >= nunits) break; LL = xtra; }
                unsigned sp = 0;
                while (__hip_atomic_load(pan + 64 * (LL >> SH), RLX_AGENT) < (unsigned)PAN_NEED && ++sp < (1u << 22)) __builtin_amdgcn_s_sleep(16);
                if (L >= nunits) break; } }
        __syncthreads();
        __builtin_amdgcn_fence(__ATOMIC_ACQUIRE, "agent");
    }
    __device__ __forceinline__ void done(const pg8::Unit& u) const {
        if (pmode == 1) { asm volatile("s_waitcnt vmcnt(0)" ::: "memory");
            if ((threadIdx.x & 63) == 0) __hip_atomic_fetch_add(pan + 64 * u.pm, 1u, __ATOMIC_RELAXED, __HIP_MEMORY_SCOPE_AGENT); } }
};
typedef MoeOrderT<false> MoeOrder; typedef MoeOrderT<true> MoeGatherOrder;
struct EpiSwiGLU {
    static constexpr bool PERM = true, AFTER_DRAIN = false;
    bf16* hmid; const int* list; const unsigned* cnt; const float* rstd; const LAS int* ptab;
    __device__ __forceinline__ void operator()(const pg8::f32x4 (&acc)[2][2][4][2], const pg8::Unit& u, int wr, int wc, int fr, int fq) const {
        const int pt = ptab[u.pm], e = pt & 255, lbase = (pt >> 8) * 256, n_e = (int)cnt[64 * e], pnl = u.pn & 1;
#pragma unroll
        for (int ai = 0; ai < 2; ++ai)
#pragma unroll
            for (int m = 0; m < 4; ++m) { const int rl = ai * 128 + wr * 64 + m * 16 + fr;
                if (lbase + rl < n_e) { const float rs = rstd[list[e * 16384 + lbase + rl] >> 1];
                    float h[8];
#pragma unroll
                    for (int n = 0; n < 2; ++n)
#pragma unroll
                        for (int k = 0; k < 4; ++k) h[4 * n + k] = silu_f(acc[ai][0][m][n][k] * rs) * (acc[ai][1][m][n][k] * rs);
                    v4u o; o.x = pk2(h[0], h[1]); o.y = pk2(h[2], h[3]); o.z = pk2(h[4], h[5]); o.w = pk2(h[6], h[7]);
                    store16_sc1<0>(hmid + (size_t)(u.pm * 256 + rl) * EFF + pnl * 128 + wc * 32 + 8 * fq, o); } }
    }
};
struct EpiDown {
    static constexpr bool PERM = true, AFTER_DRAIN = false;
    bf16* y2; const int* list; const unsigned* cnt; const float* gate; const LAS int* ptab;
    __device__ __forceinline__ void operator()(const pg8::f32x4 (&acc)[2][2][4][2], const pg8::Unit& u, int wr, int wc, int fr, int fq) const {
        const int pt = ptab[u.pm], e = pt & 255, lbase = (pt >> 8) * 256, n_e = (int)cnt[64 * e], pnl = u.pn & 3;
#pragma unroll
        for (int ai = 0; ai < 2; ++ai)
#pragma unroll
            for (int m = 0; m < 4; ++m) { const int rl = ai * 128 + wr * 64 + m * 16 + fr;
                if (lbase + rl < n_e) { const int pair = list[e * 16384 + lbase + rl]; const float g = gate[pair];
#pragma unroll
                    for (int bj = 0; bj < 2; ++bj) { const pg8::f32x4 v0 = acc[ai][bj][m][0] * g, v1 = acc[ai][bj][m][1] * g;
                        v4u o; o.x = pk2(v0[0], v0[1]); o.y = pk2(v0[2], v0[3]); o.z = pk2(v1[0], v1[1]); o.w = pk2(v1[2], v1[3]);
                        *(GAS v4u*)(y2 + (size_t)pair * D + pnl * 256 + bj * 128 + wc * 32 + 8 * fq) = o; } } }
    }
};
__device__ __forceinline__ void p10_final(Frame& F, const float* lnw, float* dst) {
    const int gw = F.vcu * NWAVES + F.wave, NGW = F.G * NWAVES, lane = F.lane;
    const bf16* y2 = (const bf16*)(F.ws + WS_Y2);
    f32x4 lw[4];
#pragma unroll
    for (int j = 0; j < 4; ++j) lw[j] = ((const f32x4*)lnw)[lane + 64 * j];
#pragma unroll 1
    for (int tok = gw; tok < T; tok += NGW) {
        GAS f32x4* xr = (GAS f32x4*)(F.out + (size_t)tok * D) + lane;
        const GAS v2u* ya = (const GAS v2u*)(y2 + (size_t)(2 * tok) * D) + lane; const GAS v2u* yb = (const GAS v2u*)(y2 + (size_t)(2 * tok + 1) * D) + lane;
        f32x4 v[4]; float s = 0.f;
#pragma unroll
        for (int j = 0; j < 4; ++j) { const f32x4 x = xr[64 * j]; const v2u a = ya[64 * j], b = yb[64 * j];
            v[j].x = x.x + (bf2f((unsigned short)(a.x & 0xffffu)) + bf2f((unsigned short)(b.x & 0xffffu))); v[j].y = x.y + (bf2f((unsigned short)(a.x >> 16)) + bf2f((unsigned short)(b.x >> 16)));
            v[j].z = x.z + (bf2f((unsigned short)(a.y & 0xffffu)) + bf2f((unsigned short)(b.y & 0xffffu))); v[j].w = x.w + (bf2f((unsigned short)(a.y >> 16)) + bf2f((unsigned short)(b.y >> 16)));
            s += (v[j].x * v[j].x + v[j].y * v[j].y) + (v[j].z * v[j].z + v[j].w * v[j].w); }
        const float r = rsqrtf(wave_sum(s) * (1.f / D) + EPS);
        GAS f32x4* xo = (GAS f32x4*)(dst + (size_t)tok * D) + lane;
#pragma unroll
        for (int j = 0; j < 4; ++j) __builtin_nontemporal_store(v[j] * r * lw[j], (f32x4*)(xo + 64 * j));
    }
}
struct EpiResF32 {
    static constexpr bool PERM = false, AFTER_DRAIN = false;
    const float* base; float* out; int ldc;
    __device__ __forceinline__ void operator()(const pg8::f32x4 (&acc)[2][2][4][2], const pg8::Unit& u, int wr, int wc, int fr, int fq) const {
        const int col0 = u.pn * 256 + wc * 32 + 4 * fq;
#pragma unroll
        for (int ai = 0; ai < 2; ++ai)
#pragma unroll
            for (int m = 0; m < 4; ++m) { const size_t off = (size_t)(u.pm * 256 + ai * 128 + wr * 64 + m * 16 + fr) * ldc + col0;
#pragma unroll
                for (int bj = 0; bj < 2; ++bj)
#pragma unroll
                    for (int n = 0; n < 2; ++n) { const pg8::f32x4 bs = *(const pg8::f32x4*)(base + off + bj * 128 + n * 16); *(pg8::f32x4*)(out + off + bj * 128 + n * 16) = bs + acc[ai][bj][m][n]; }
                if (m & 1) asm volatile("" ::: "memory"); }
    }
};
struct Args { const float* in[17]; float* out; unsigned char* ws; int ph_lo, ph_hi, li, pad; };
__global__ void __launch_bounds__(NTHR, 2) mk_fwd(Args args) {
    extern __shared__ __attribute__((aligned(16))) unsigned char lds[];
    Frame F;
    F.lds = (LAS unsigned char*)lds;
    F.MISC = (volatile LAS unsigned*)(F.lds + MISC_OFF);
    F.tid = threadIdx.x; F.lane = F.tid & 63; F.wave = __builtin_amdgcn_readfirstlane(F.tid >> 6);
    F.G = gridDim.x; { const int bx = blockIdx.x; F.vcu = (F.G % 8 == 0) ? (bx % 8) * (F.G / 8) + bx / 8 : bx; }
    F.ws = args.ws; F.out = args.out; F.li = args.li; F.ctl = (gu32*)(args.ws + WS_CTL);
    for (int u = F.tid; u < (LDS_BYTES - LDSCTL_OFF) / 4; u += NTHR) ((LAS unsigned*)(F.lds + LDSCTL_OFF))[u] = 0u;
    __syncthreads();
    XcdBarrier bar = xcd_barrier_post((unsigned*)(F.ctl + CW_BAR) + args.li * XCD_BAR_WORDS, F.MISC + 8);
    const int lo = args.ph_lo, hi = args.ph_hi;
#define IN(k) (lo <= (k) && (k) < hi)
#define BOTH(k) (IN(k) && IN((k) + 1))
#define GRID_BAR() xcd_barrier(bar)
#define PHASE_BEGIN() do { int t_ = threadIdx.x; asm volatile("" : "+v"(t_)); F.tid = t_; F.lane = t_ & 63; } while (0)
    if (IN(0)) { PHASE_BEGIN(); p0_prologue(F, args.in[I_X], args.in[I_LNMIX], args.in[I_WIN], args.in[I_WOUT], args.in[I_ALOG], args.in[I_DTB]); p0_rot_table(F); p0_router_weights(F, args.in[I_LNFFN], args.in[I_WG], args.in[I_WE]); if (BOTH(0)) GRID_BAR(); }
    if (IN(1)) { PHASE_BEGIN();
        pg8::Gemm g{(const bf16*)(F.ws + WS_HN), (const bf16*)(F.ws + WS_WIN), T, NPROJ, D}; pg8::StaticOrder S; S.init(T, NPROJ, F.G, (int)blockIdx.x);
        pg8::EpiBf16<0> E{(bf16*)(F.ws + WS_PROJ), NPROJ, nullptr, 0, 0, 1.f};
        pg8::gemm_phase<pg8::EpiBf16<0>, pg8::StaticOrder, true, true>(F.lds, g, S, E);
        if (BOTH(1)) GRID_BAR();
    }
    if (IN(2)) { PHASE_BEGIN();
#pragma unroll 1
        for (int g0 = blockIdx.x; g0 < 256; g0 += F.G) { const int grp = F.G == 256 ? (g0 & 7) * 32 + (g0 >> 3) : g0; p2_group(F, grp, args.in[I_CONV], (const float*)(F.ws + WS_BG)); }
        if (BOTH(2)) GRID_BAR();
    }
    if (IN(3) || IN(17) || IN(18)) { PHASE_BEGIN(); const int skipq = IN(17) ? 1 : IN(18) ? 3 : 0;
        const int x = blockIdx.x;
        if (x < 32) p3_scan(F, (x & 7) * 2 + ((x >> 3) & 1), (x >> 4) & 1, 0);
        {
            LAS int* wq = (LAS int*)(F.lds + LT_WQ);
#pragma unroll 1
            for (;;) {
                if (F.tid == 0) *wq = (int)atomicAdd((unsigned*)(F.ctl + CW_WQ + 64 * F.li), 1u);
                __syncthreads();
                const int it = *wq;
                __syncthreads();
                if (it >= 512 + 384 + 480 + 256) break;
                if (it < 384) { if (!(skipq & 1)) p3_moe_weight_items(F, it * 64 + F.wave, NWAVES, it * 64 + 64, args.in[I_WGU], args.in[I_WD]); }
                else if (it < 384 + 512) { if (!(skipq & 2)) p3_attn_unit(F, it - 384, args.in[I_SINK]); }
                else { const int ob = it - (512 + 384); if (ob < 480) p3_out_batch(F, ob * 8, 8, F.out); else p3_out_batch(F, 3840 + (ob - 480), 1, F.out); }
            }
        }
        if (BOTH(3)) GRID_BAR();
    }
    if (IN(4)) { PHASE_BEGIN(); p4_combine(F, F.out, args.in[I_DNNORM]); if (BOTH(4)) GRID_BAR(); }
    if (IN(5)) { PHASE_BEGIN();
        pg8::Gemm g{(const bf16*)(F.ws + WS_MIX), (const bf16*)(F.ws + WS_WOUT), T, D, D}; pg8::StaticOrder S; S.init(T, D, F.G, (int)blockIdx.x);
        EpiResF32 E{args.in[I_X], F.out, D};
        pg8::gemm_phase<EpiResF32, pg8::StaticOrder, true, true>(F.lds, g, S, E);
        if (BOTH(5)) GRID_BAR();
    }
    if (IN(6) || IN(12)) { PHASE_BEGIN(); p6_route(F, args.in[I_LNFFN], args.in[I_BG], args.in[I_BE], IN(12) ? 1 : 0); if (BOTH(6)) GRID_BAR(); }
    if (IN(8)) { PHASE_BEGIN();
        const int NP = moe_tables(F);
        pg8::Gemm g{(const bf16*)(F.ws + WS_HN), (const bf16*)(F.ws + WS_WGU), NP * 256, NEXP * 512, D};
        MoeGatherOrder S{NP * 2, F.G, (int)blockIdx.x, 1, (const LAS int*)(F.lds + LT_PTAB), (const int*)(F.ws + WS_LIST), (const unsigned*)(F.ctl + CW_CNT), (unsigned)(D * 2), (unsigned*)(F.ctl + CW_PAN), 1, -1};
        EpiSwiGLU E{(bf16*)(F.ws + WS_HMID), (const int*)(F.ws + WS_LIST), (const unsigned*)(F.ctl + CW_CNT), (const float*)(F.ws + RW_RSTD), (const LAS int*)(F.lds + LT_PTAB)};
        pg8::gemm_phase<EpiSwiGLU, MoeGatherOrder, true, true>(F.lds, g, S, E);
    }
    if (IN(9)) { PHASE_BEGIN();
        const int NP = moe_tables(F);
        pg8::Gemm g{(const bf16*)(F.ws + WS_HMID), (const bf16*)(F.ws + WS_WD), NP * 256, NEXP * D, EFF};
        int r8 = NP * 2 - F.G; r8 = (r8 < 0 || r8 >= F.G / 2 + 1) ? 0 : r8; const int pe4 = (NP < F.G / 2 ? NP : F.G / 2) * 4, bx = (int)blockIdx.x, GB = F.G - r8;
        int s_n = NP * 4, s_g = F.G, s_c = bx, s_x = -1;
        if (r8 > 0) { if (bx < r8) { s_n = 0; s_g = F.G; s_c = 0; s_x = pe4 + bx; }
                      else { const int bb = bx - r8; s_n = pe4; s_g = GB; s_c = bb; s_x = (GB - 1 - bb < r8) ? pe4 + r8 + (GB - 1 - bb) : -1; } }
        EpiDown E{(bf16*)(F.ws + WS_Y2), (const int*)(F.ws + WS_LIST), (const unsigned*)(F.ctl + CW_CNT), (const float*)(F.ws + RW_GATE), (const LAS int*)(F.lds + LT_PTAB)};
        s_n = __builtin_amdgcn_readfirstlane(s_n); s_g = __builtin_amdgcn_readfirstlane(s_g); s_c = __builtin_amdgcn_readfirstlane(s_c); s_x = __builtin_amdgcn_readfirstlane(s_x);
#pragma unroll 1
        for (int rep = 0; rep < 2; ++rep) {
            if (rep && s_x < 0) break;
            MoeOrder S{rep ? 0 : s_n, rep ? F.G : s_g, rep ? 0 : s_c, 2, (const LAS int*)(F.lds + LT_PTAB), nullptr, nullptr, 0u, (unsigned*)(F.ctl + CW_PAN), 0, rep ? s_x : -1};
            S.wait_panels();
            pg8::gemm_phase<EpiDown, MoeOrder, true, true>(F.lds, g, S, E);
        }
        if (BOTH(9)) GRID_BAR();
    }
#ifdef PROBE_PHASES
    if (IN(11) || IN(14) || IN(15) || IN(16)) { PHASE_BEGIN(); const int x = blockIdx.x; if (x < 32) p3_scan(F, (x & 7) + 8 * (x >> 4), (x >> 3) & 1, IN(14) ? 1 : IN(15) ? 3 : IN(16) ? 5 : 0); }
#endif
    if (IN(10) || IN(13)) { PHASE_BEGIN(); p10_final(F, args.in[I_LNF], IN(13) ? (float*)(F.ws + WS_PROJ) : F.out); }
#undef IN
#undef BOTH
}

__global__ void k_shim_proj(const bf16* __restrict__ pb, float* __restrict__ pf) {
    const size_t i = (size_t)blockIdx.x * blockDim.x + threadIdx.x; if (i >= (size_t)T * NPROJ) return;
    const int tok = (int)(i / NPROJ), c = (int)(i % NPROJ);
    pf[(size_t)tok * INW + (c < 2048 ? c : c + 16)] = bf2f(pb[i]);
}
}

extern "C" void kernel_launch(void* const* d_in, const int* in_sizes, int n_in, void* d_out, int out_size, void* d_ws, size_t ws_size, hipStream_t stream) {
    using namespace mk;
    static int grid = 0;
    if (grid == 0) {
        if (n_in != 17 || out_size != T * D || ws_size < 511 * MiB) { fprintf(stderr, "kernel_launch: unexpected sizes (n_in %d out %d ws %zu)\n", n_in, out_size, ws_size); grid = -1; return; }
        int dev = 0, cus = 0, per_cu = 0;
        if (hipGetDevice(&dev) != hipSuccess || hipDeviceGetAttribute(&cus, hipDeviceAttributeMultiprocessorCount, dev) != hipSuccess) { grid = -1; return; }
        if (hipFuncSetAttribute((const void*)mk_fwd, hipFuncAttributeMaxDynamicSharedMemorySize, LDS_BYTES) != hipSuccess) { fprintf(stderr, "kernel_launch: hipFuncSetAttribute failed\n"); grid = -1; return; }
        if (hipOccupancyMaxActiveBlocksPerMultiprocessor(&per_cu, (const void*)mk_fwd, NTHR, LDS_BYTES) != hipSuccess || per_cu < 1) { fprintf(stderr, "kernel_launch: occupancy query says %d blocks/CU\n", per_cu); grid = -1; (void)hipGetLastError(); return; }
        grid = cus;
    }
    if (grid < 0) return;
    (void)hipMemsetAsync((char*)d_ws + WS_CTL, 0, CTL_ZERO_BYTES, stream);
    Args a{};
    for (int i = 0; i < 17; ++i) a.in[i] = (const float*)d_in[i];
    a.out = (float*)d_out; a.ws = (unsigned char*)d_ws; a.pad = 0;
#ifndef LAUNCH_PLAN
#define LAUNCH_PLAN {0, 11}
#endif
    const int plan[] = LAUNCH_PLAN; const int nl = (int)(sizeof(plan) / sizeof(int)) / 2;
    for (int li = 0; li < nl; ++li) {
        a.ph_lo = plan[2 * li]; a.ph_hi = plan[2 * li + 1]; a.li = li;
        void* kargs[] = {&a};
        hipError_t e = hipLaunchCooperativeKernel((const void*)mk_fwd, dim3(grid), dim3(NTHR), kargs, LDS_BYTES, stream);
        if (e != hipSuccess) { fprintf(stderr, "cooperative launch failed: %s (grid %d)\n", hipGetErrorString(e), grid); return; }
    }
}
```
